# Optimizing an MI355X kernel written in HIP

```python
import math
import jax, jax.numpy as jnp
from jax import lax
import numpy as np

D_MODEL = 4096
BATCH = 2
SEQ = 8192
DEPTH = 1

HEAD_DIM = 128
N_HEADS_TOTAL = D_MODEL // HEAD_DIM
N_HEADS_SPARSE = N_HEADS_TOTAL // 2
N_KV_SPARSE = N_HEADS_SPARSE // 4
N_HEADS_SB = N_HEADS_TOTAL - N_HEADS_SPARSE
W_SPARSE = N_HEADS_SPARSE * HEAD_DIM
W_SPARSE_KV = N_KV_SPARSE * HEAD_DIM
W_SB = N_HEADS_SB * HEAD_DIM
MIX_WIDTH = W_SPARSE + W_SB
H_IDX = 32
D_IDX = 64
TOPK_MAX = 256
N_BUCKETS = 32
MAX_DISTANCE = 128
D_FF = 4 * D_MODEL
Q_BLOCK = 128
LN_EPS = 1e-5
COL_SIZES = (W_SPARSE, W_SPARSE_KV, W_SPARSE_KV, W_SB, W_SB, W_SB, H_IDX * D_IDX, D_IDX, H_IDX)
IN_COLS = W_SPARSE + 2 * W_SPARSE_KV + 3 * W_SB + H_IDX * D_IDX + D_IDX + H_IDX

kernel_name = "hybrid_dsa_stickbreak_deepnorm_adaln"


def layer_norm(x, g, b):
    xf = x.astype(jnp.float32)
    mu = jnp.mean(xf, axis=-1, keepdims=True)
    xc = xf - mu
    var = jnp.mean(xc * xc, axis=-1, keepdims=True)
    return (xc * lax.rsqrt(var + LN_EPS) * g + b).astype(x.dtype)


def rms_norm(x, g):
    xf = x.astype(jnp.float32)
    ms = jnp.mean(xf * xf, axis=-1, keepdims=True)
    return (xf * lax.rsqrt(ms + LN_EPS) * g).astype(x.dtype)


def t5_bucket(dist):
    n = jnp.maximum(dist, 0)
    max_exact = N_BUCKETS // 2
    nf = jnp.maximum(n, 1).astype(jnp.float32)
    large = max_exact + (jnp.log(nf / max_exact) / math.log(MAX_DISTANCE / max_exact)
                         * (N_BUCKETS - max_exact)).astype(jnp.int32)
    large = jnp.minimum(large, N_BUCKETS - 1)
    return jnp.where(n < max_exact, n, large)


def split_columns(proj):
    parts, start = [], 0
    for size in COL_SIZES:
        parts.append(proj[..., start:start + size])
        start += size
    return parts


def sparse_attention(q, k, v, iq, ik, iw, rel_bias, topk):
    B, S, H, Dh = q.shape
    G = k.shape[2]
    R = H // G
    pos = jnp.arange(S, dtype=jnp.int32)
    b_idx = jnp.arange(B)[:, None, None]

    def block(i):
        t0 = i * Q_BLOCK
        tq = t0 + jnp.arange(Q_BLOCK, dtype=jnp.int32)
        q_blk = lax.dynamic_slice_in_dim(q, t0, Q_BLOCK, axis=1)
        iq_blk = lax.dynamic_slice_in_dim(iq, t0, Q_BLOCK, axis=1)
        iw_blk = lax.dynamic_slice_in_dim(iw, t0, Q_BLOCK, axis=1)
        rel = jax.nn.relu(jnp.einsum('bqhd,bsd->bqhs', iq_blk, ik).astype(jnp.float32)
                          * (D_IDX ** -0.5))
        score = jnp.einsum('bqh,bqhs->bqs', iw_blk.astype(jnp.float32), rel)
        causal = pos[None, :] <= tq[:, None]
        score = jnp.where(causal[None], score, -jnp.inf)
        _, idx = lax.top_k(score, topk)
        valid = idx <= tq[None, :, None]
        k_sel = k[b_idx, idx]
        v_sel = v[b_idx, idx]
        qg = q_blk.reshape(B, Q_BLOCK, G, R, Dh)
        logits = jnp.einsum('bqgrd,bqkgd->bqgrk', qg, k_sel).astype(jnp.float32) * (Dh ** -0.5)
        bias = rel_bias[t5_bucket(tq[None, :, None] - idx)].astype(jnp.float32)
        bias = bias.reshape(B, Q_BLOCK, topk, G, R).transpose(0, 1, 3, 4, 2)
        logits = jnp.where(valid[:, :, None, None, :], logits + bias, -jnp.inf)
        p = jax.nn.softmax(logits, axis=-1).astype(v.dtype)
        o = jnp.einsum('bqgrk,bqkgd->bqgrd', p, v_sel)
        return o.reshape(B, Q_BLOCK, H * Dh)

    out = lax.map(block, jnp.arange(S // Q_BLOCK, dtype=jnp.int32))
    return out.transpose(1, 0, 2, 3).reshape(B, S, H * Dh)


def stick_breaking_attention(q, k, v):
    B, S, H, Dh = q.shape
    pos = jnp.arange(S, dtype=jnp.int32)

    def block(i):
        t0 = i * Q_BLOCK
        tq = t0 + jnp.arange(Q_BLOCK, dtype=jnp.int32)
        q_blk = lax.dynamic_slice_in_dim(q, t0, Q_BLOCK, axis=1)
        z = jnp.einsum('bqhd,bshd->bhqs', q_blk, k).astype(jnp.float32) * (Dh ** -0.5)
        strict = (pos[None, :] < tq[:, None])[None, None]
        log_beta = jax.nn.log_sigmoid(z)
        log_keep = jnp.where(strict, log_beta - z, 0.0)
        later = lax.cumsum(log_keep, axis=3, reverse=True) - log_keep
        a = jnp.where(strict, jnp.exp(log_beta + later), 0.0).astype(v.dtype)
        o = jnp.einsum('bhqs,bshd->bqhd', a, v)
        return o.reshape(B, Q_BLOCK, H * Dh)

    out = lax.map(block, jnp.arange(S // Q_BLOCK, dtype=jnp.int32))
    return out.transpose(1, 0, 2, 3).reshape(B, S, H * Dh)


def setup_inputs(seed: int = 0) -> dict:
    key = jax.random.key(seed)
    ks = jax.random.split(key, 20)
    f32 = jnp.float32
    beta_dn = (8.0 * DEPTH) ** -0.25
    nrm = lambda k, shape, s: jax.random.normal(k, shape, f32) * s
    gain = lambda k, shape: 1.0 + 0.02 * jax.random.normal(k, shape, f32)
    return {
        "x": nrm(ks[0], (BATCH, SEQ, D_MODEL), 1.0),
        "c": nrm(ks[1], (BATCH, D_MODEL), 1.0),
        "in_ln_g": gain(ks[2], (D_MODEL,)),
        "in_ln_b": nrm(ks[3], (D_MODEL,), 0.02),
        "rel_bias": nrm(ks[4], (N_BUCKETS, N_HEADS_SPARSE), 0.5),
        "w_ada": nrm(ks[5], (DEPTH, D_MODEL, 6 * D_MODEL), 0.5 * D_MODEL ** -0.5),
        "b_ada": nrm(ks[6], (DEPTH, 6 * D_MODEL), 0.02),
        "w_in": nrm(ks[7], (DEPTH, D_MODEL, IN_COLS), D_MODEL ** -0.5),
        "idx_kn_g": gain(ks[8], (DEPTH, D_IDX)),
        "idx_kn_b": nrm(ks[9], (DEPTH, D_IDX), 0.02),
        "gn_sparse_g": gain(ks[10], (DEPTH, W_SPARSE)),
        "gn_sb_g": gain(ks[11], (DEPTH, W_SB)),
        "w_out": nrm(ks[12], (DEPTH, MIX_WIDTH, D_MODEL), beta_dn * MIX_WIDTH ** -0.5),
        "ln1_g": gain(ks[13], (DEPTH, D_MODEL)),
        "ln1_b": nrm(ks[14], (DEPTH, D_MODEL), 0.02),
        "w_up": nrm(ks[15], (DEPTH, D_MODEL, D_FF), D_MODEL ** -0.5),
        "w_down": nrm(ks[16], (DEPTH, D_FF, D_MODEL), beta_dn * D_FF ** -0.5),
        "ln2_g": gain(ks[17], (DEPTH, D_MODEL)),
        "ln2_b": nrm(ks[18], (DEPTH, D_MODEL), 0.02),
    }


def reference(x, c, in_ln_g, in_ln_b, rel_bias, w_ada, b_ada, w_in, idx_kn_g, idx_kn_b,
              gn_sparse_g, gn_sb_g, w_out, ln1_g, ln1_b, w_up, w_down, ln2_g, ln2_b):
    B, S, _ = x.shape
    topk = min(TOPK_MAX, S // 4)
    alpha = (2.0 * DEPTH) ** 0.25
    h = layer_norm(x, in_ln_g, in_ln_b)
    cs = jax.nn.silu(c)
    for l in range(DEPTH):
        mod = cs @ w_ada[l] + b_ada[l]
        sh_m, sc_m, g_m, sh_f, sc_f, g_f = [m[:, None, :] for m in jnp.split(mod, 6, axis=-1)]
        u = h * (1.0 + sc_m) + sh_m
        proj = u @ w_in[l]
        aq, ak, av, bq, bk, bv, iq, ik, iw = split_columns(proj)
        aq = aq.reshape(B, S, N_HEADS_SPARSE, HEAD_DIM)
        ak = ak.reshape(B, S, N_KV_SPARSE, HEAD_DIM)
        av = av.reshape(B, S, N_KV_SPARSE, HEAD_DIM)
        bq = bq.reshape(B, S, N_HEADS_SB, HEAD_DIM)
        bk = bk.reshape(B, S, N_HEADS_SB, HEAD_DIM)
        bv = bv.reshape(B, S, N_HEADS_SB, HEAD_DIM)
        iq = iq.reshape(B, S, H_IDX, D_IDX)
        ik = layer_norm(ik, idx_kn_g[l], idx_kn_b[l])
        iw = iw * (H_IDX ** -0.5)
        o_a = sparse_attention(aq, ak, av, iq, ik, iw, rel_bias, topk)
        o_b = stick_breaking_attention(bq, bk, bv)
        mixed = jnp.concatenate([rms_norm(o_a, gn_sparse_g[l]), rms_norm(o_b, gn_sb_g[l])],
                                axis=-1) @ w_out[l]
        h = layer_norm(alpha * h + g_m * mixed, ln1_g[l], ln1_b[l])
        u = h * (1.0 + sc_f) + sh_f
        y = jnp.square(jax.nn.relu(u @ w_up[l])) @ w_down[l]
        h = layer_norm(alpha * h + g_f * y, ln2_g[l], ln2_b[l])
    return h
```

```cpp
#include <hip/hip_runtime.h>
#include <cstdio>
#include <cstdint>
#include <cmath>
namespace pg8 {
#define PG8_LAS __attribute__((address_space(3)))
typedef unsigned short bf16_t;
typedef short bf16x8 __attribute__((ext_vector_type(8)));
typedef float f32x4 __attribute__((ext_vector_type(4)));
typedef unsigned u32x4 __attribute__((ext_vector_type(4)));
constexpr int BM = 256, BK = 64, HALF = 128, HTB = HALF * BK * 2  , STAGE_BYTES = 8 * HTB, NXCD = 8, WGM = 8;

__host__ __device__ __forceinline__ int lds_byte(int r, int c) { const int st = (r >> 4) * 2 + (c >> 5), rr = r & 15, cc = c & 31, ob = rr * 64 + cc * 2; return st * 1024 + (ob ^ (((ob >> 9) & 1) << 5)); }
__host__ __device__ __forceinline__ void stage_rc(int b, int& R, int& C) { const int st = b / 1024, sb = b % 1024, swz = sb ^ (((sb >> 9) & 1) << 5); R = (st >> 1) * 16 + swz / 64; C = (st & 1) * 32 + (swz % 64) / 2; }
__host__ __device__ __forceinline__ int perm32(int rho) { const int n = rho >> 4, i = rho & 15; return 8 * (i >> 2) + 4 * n + (i & 3); }

struct Unit { int pm, pn; };
struct Gemm { const bf16_t* A; const bf16_t* Bt; int M, N, K; };

struct StaticOrder {
    int nM, nN, nwg, G, c;
    __host__ __device__ void init(int M, int N, int G_, int c_) { nM = M / BM; nN = N / BM; nwg = nM * nN; G = G_; c = c_; }
    __host__ __device__ bool next(int i, Unit& u) const {
        const long L = (long)i * G + c; if (L >= nwg) return false;
        int wgid = (int)L; { const int q = nwg / NXCD, r = nwg % NXCD, xcd = wgid % NXCD, off = wgid / NXCD; wgid = (xcd < r ? xcd * (q + 1) : r * (q + 1) + (xcd - r) * q) + off; }
        const int nig = WGM * nN, gid = wgid / nig, fm = gid * WGM, gsz = (nM - fm) < WGM ? (nM - fm) : WGM;
        u.pm = fm + ((wgid % nig) % gsz); u.pn = (wgid % nig) / gsz; return true;
    }
    __device__ __forceinline__ void a_ready(const Unit&) const {}
    __device__ __forceinline__ void done(const Unit&) const {}
};

__device__ __forceinline__ unsigned cvt_pk_bf16(float lo, float hi) { unsigned r; asm volatile("v_cvt_pk_bf16_f32 %0, %1, %2" : "=v"(r) : "v"(lo), "v"(hi)); return r; }
typedef _Float16 f16x8 __attribute__((ext_vector_type(8)));
typedef _Float16 f16x2 __attribute__((ext_vector_type(2)));
typedef unsigned u32x2 __attribute__((ext_vector_type(2)));
__device__ __forceinline__ unsigned cvt_pk_f16(float lo, float hi) { f16x2 h; h.x = (_Float16)lo; h.y = (_Float16)hi; return __builtin_bit_cast(unsigned, h); }
template <bool F16> __device__ __forceinline__ f32x4 mma16(bf16x8 a, bf16x8 b, f32x4 c) {
    if constexpr (F16) return __builtin_amdgcn_mfma_f32_16x16x32_f16(__builtin_bit_cast(f16x8, a), __builtin_bit_cast(f16x8, b), c, 0, 0, 0);
    else return __builtin_amdgcn_mfma_f32_16x16x32_bf16(a, b, c, 0, 0, 0);
}

template <int ACT  > struct EpiBf16 {
    static constexpr bool PERM = true, AFTER_DRAIN = false;
    bf16_t* O; int ldc;
    __device__ __forceinline__ void operator()(const f32x4 (&acc)[2][2][4][2], const Unit& u, int wr, int wc, int fr, int fq) const {
        const int row0 = u.pm * BM + wr * 64 + fr; const int col0 = u.pn * BM + wc * 32 + 8 * fq;
#pragma unroll
        for (int ai = 0; ai < 2; ++ai)
#pragma unroll
            for (int m = 0; m < 4; ++m) { bf16_t* rowp = O + (size_t)(row0 + ai * HALF + m * 16) * ldc + col0;
#pragma unroll
                for (int bj = 0; bj < 2; ++bj) { f32x4 v0 = acc[ai][bj][m][0], v1 = acc[ai][bj][m][1];
                    if (ACT == 1) {
#pragma unroll
                        for (int j = 0; j < 4; ++j) { const float a = fmaxf(v0[j], 0.f), b = fmaxf(v1[j], 0.f); v0[j] = a * a; v1[j] = b * b; } }
                    u32x4 w; w.x = cvt_pk_bf16(v0[0], v0[1]); w.y = cvt_pk_bf16(v0[2], v0[3]); w.z = cvt_pk_bf16(v1[0], v1[1]); w.w = cvt_pk_bf16(v1[2], v1[3]);
                    *(u32x4*)(rowp + bj * HALF) = w; } }
    }
};
struct EpiIdx {
    static constexpr bool PERM = true, AFTER_DRAIN = false;
    bf16_t* IQ; float* IKW;
    __device__ __forceinline__ void operator()(const f32x4 (&acc)[2][2][4][2], const Unit& u, int wr, int wc, int fr, int fq) const {
        const int row0 = u.pm * BM + wr * 64 + fr;
        if (u.pn < 8) {
            const int col0 = u.pn * BM + wc * 32 + 8 * fq;
#pragma unroll
            for (int ai = 0; ai < 2; ++ai)
#pragma unroll
                for (int m = 0; m < 4; ++m) { bf16_t* rowp = IQ + (size_t)(row0 + ai * HALF + m * 16) * 2048 + col0;
#pragma unroll
                    for (int bj = 0; bj < 2; ++bj) { const f32x4 v0 = acc[ai][bj][m][0], v1 = acc[ai][bj][m][1];
                        u32x4 w; w.x = cvt_pk_f16(v0[0], v0[1]); w.y = cvt_pk_f16(v0[2], v0[3]); w.z = cvt_pk_f16(v1[0], v1[1]); w.w = cvt_pk_f16(v1[2], v1[3]);
                        *(u32x4*)(rowp + bj * HALF) = w; } }
        } else {
            const int col0 = wc * 32 + 8 * fq;
#pragma unroll
            for (int ai = 0; ai < 2; ++ai)
#pragma unroll
                for (int m = 0; m < 4; ++m) { float* rowp = IKW + (size_t)(row0 + ai * HALF + m * 16) * 128 + col0;
                    *(f32x4*)(rowp) = acc[ai][0][m][0]; *(f32x4*)(rowp + 4) = acc[ai][0][m][1]; }
        }
    }
};
struct EpiOut {
    static constexpr bool PERM = false, AFTER_DRAIN = false;
    const float* x; const float* xst; const float* lng; const float* lnb; const float* gate;   int gstride; float* out; float alpha; int seq;
    __device__ __forceinline__ void operator()(const f32x4 (&acc)[2][2][4][2], const Unit& u, int wr, int wc, int fr, int fq) const {
        const int row0 = u.pm * BM + wr * 64 + fr, col0 = u.pn * BM + wc * 32 + 4 * fq;
        const float* gt = gate + (size_t)((u.pm * BM) / seq) * gstride;
        f32x4 gv[2][2], lg[2][2], lb[2][2];
#pragma unroll
        for (int bj = 0; bj < 2; ++bj)
#pragma unroll
            for (int n = 0; n < 2; ++n) { const int c = col0 + bj * HALF + n * 16; gv[bj][n] = *(const f32x4*)(gt + c); lg[bj][n] = *(const f32x4*)(lng + c); lb[bj][n] = *(const f32x4*)(lnb + c); }
#pragma unroll
        for (int ai = 0; ai < 2; ++ai)
#pragma unroll
            for (int m = 0; m < 4; ++m) { const int r = row0 + ai * HALF + m * 16; const float mean = xst[2 * r], rstd = xst[2 * r + 1]; const size_t off = (size_t)r * 4096 + col0;
#pragma unroll
                for (int bj = 0; bj < 2; ++bj)
#pragma unroll
                    for (int n = 0; n < 2; ++n) { const f32x4 xv = *(const f32x4*)(x + off + bj * HALF + n * 16);
                        const f32x4 h0 = (xv - mean) * rstd * lg[bj][n] + lb[bj][n];
                        *(f32x4*)(out + off + bj * HALF + n * 16) = h0 * alpha + gv[bj][n] * acc[ai][bj][m][n]; }
                if (m & 1) asm volatile("" ::: "memory"); }
    }
};
struct EpiDown {
    static constexpr bool PERM = false, AFTER_DRAIN = false;
    const float* gate; int gstride; float* out; float alpha; int seq;
    __device__ __forceinline__ void operator()(const f32x4 (&acc)[2][2][4][2], const Unit& u, int wr, int wc, int fr, int fq) const {
        const int row0 = u.pm * BM + wr * 64 + fr, col0 = u.pn * BM + wc * 32 + 4 * fq;
        const float* gt = gate + (size_t)((u.pm * BM) / seq) * gstride;
        f32x4 gv[2][2];
#pragma unroll
        for (int bj = 0; bj < 2; ++bj)
#pragma unroll
            for (int n = 0; n < 2; ++n) gv[bj][n] = *(const f32x4*)(gt + col0 + bj * HALF + n * 16);
#pragma unroll
        for (int ai = 0; ai < 2; ++ai)
#pragma unroll
            for (int m = 0; m < 4; ++m) { const size_t off = (size_t)(row0 + ai * HALF + m * 16) * 4096 + col0;
#pragma unroll
                for (int bj = 0; bj < 2; ++bj)
#pragma unroll
                    for (int n = 0; n < 2; ++n) { const f32x4 hv = *(const f32x4*)(out + off + bj * HALF + n * 16);
                        *(f32x4*)(out + off + bj * HALF + n * 16) = hv * alpha + gv[bj][n] * acc[ai][bj][m][n]; }
                if (m & 1) asm volatile("" ::: "memory"); }
    }
};

template <class Epi, class Sched, bool F16, bool ALIGN_EPI, bool SP2>
__device__ __forceinline__ void gemm_phase(PG8_LAS unsigned char* lds, const Gemm g, const Sched& S, const Epi& E) {
    const int tid = threadIdx.x, wid = __builtin_amdgcn_readfirstlane(tid >> 6), lane = tid & 63, wr = wid >> 2, wc = wid & 3, fr = lane & 15, fq = lane >> 4;
    const int K = g.K, nt = K / BK;
    unsigned voffA[2], voffB[2];
#pragma unroll
    for (int i = 0; i < 2; ++i) { int R, C; stage_rc(tid * 16 + i * 8192, R, C); const int Rb = Epi::PERM ? ((R & ~31) + perm32(R & 31)) : R;
        voffA[i] = (unsigned)(R * K + C) * 2u; voffB[i] = (unsigned)(Rb * K + C) * 2u; }
    const size_t kstep = (size_t)(BK * 2);
    const size_t hstep = (size_t)HALF * K * 2;
    const size_t tstep = 2 * hstep;
    const unsigned ldsw = (unsigned)wid * 1024u;
    const int aoff = lds_byte(wr * 64 + fr, fq * 8), boff = lds_byte(wc * 32 + fr, fq * 8);
#define PG8_SA(b, h) (((b) * 2 + (h)) * HTB)
#define PG8_SB(b, h) ((4 + (b) * 2 + (h)) * HTB)
#define PG8_STAGE(bufoff, gbase, voff) do { _Pragma("unroll") for (int _i = 0; _i < 2; ++_i) \
        __builtin_amdgcn_global_load_lds((const unsigned*)((const char*)(gbase) + (voff)[_i]), (PG8_LAS unsigned*)(lds + (bufoff) + ldsw + _i * 8192), 16, 0, 0); } while (0)
#define PG8_LDA(dst, b, h) do { _Pragma("unroll") for (int m = 0; m < 4; ++m) _Pragma("unroll") for (int k = 0; k < 2; ++k) dst[m][k] = *(const PG8_LAS bf16x8*)(lds + PG8_SA(b, h) + aoff + m * 2048 + k * 1024); } while (0)
#define PG8_LDB(dst, b, h) do { _Pragma("unroll") for (int n = 0; n < 2; ++n) _Pragma("unroll") for (int k = 0; k < 2; ++k) dst[n][k] = *(const PG8_LAS bf16x8*)(lds + PG8_SB(b, h) + boff + n * 2048 + k * 1024); } while (0)
#define PG8_MMA(ai, bj, At, Bt) do { __builtin_amdgcn_s_setprio(1); _Pragma("unroll") for (int m = 0; m < 4; ++m) _Pragma("unroll") for (int n = 0; n < 2; ++n) _Pragma("unroll") for (int k = 0; k < 2; ++k) \
        acc[ai][bj][m][n] = mma16<F16>(Bt[n][k], At[m][k], acc[ai][bj][m][n]); __builtin_amdgcn_s_setprio(0); } while (0)
#define PG8_WAIT_V(n) asm volatile("s_waitcnt vmcnt(" #n ")" ::: "memory")
#define PG8_WAIT_L(n) asm volatile("s_waitcnt lgkmcnt(" #n ")" ::: "memory")
#define PG8_BAR __builtin_amdgcn_s_barrier()
#define PG8_SCHED __builtin_amdgcn_sched_barrier(0)
    Unit cur, nxt; int ui = 0;
    if (!S.next(0, cur)) return;
    f32x4 acc[2][2][4][2];
#pragma unroll
    for (int a = 0; a < 2; ++a)
#pragma unroll
        for (int b = 0; b < 2; ++b)
#pragma unroll
            for (int m = 0; m < 4; ++m)
#pragma unroll
                for (int n = 0; n < 2; ++n) acc[a][b][m][n] = (f32x4){0.f, 0.f, 0.f, 0.f};
    bf16x8 At[4][2], B0[2][2], B1[2][2];
    const char* cA = (const char*)g.A + (size_t)cur.pm * tstep; const char* cB = (const char*)g.Bt + (size_t)cur.pn * tstep;
    S.a_ready(cur);
    if constexpr (SP2) {
        PG8_STAGE(PG8_SB(0, 0), cB, voffB); PG8_STAGE(PG8_SB(0, 1), cB + hstep, voffB); PG8_STAGE(PG8_SA(0, 0), cA, voffA); PG8_STAGE(PG8_SA(0, 1), cA + hstep, voffA);
        if (wr == 1) PG8_BAR;
        PG8_WAIT_V(2); PG8_BAR;
        PG8_STAGE(PG8_SB(1, 0), cB + kstep, voffB); PG8_STAGE(PG8_SA(1, 0), cA + kstep, voffA); PG8_STAGE(PG8_SB(1, 1), cB + hstep + kstep, voffB);
        PG8_WAIT_V(6); PG8_BAR;
    } else {
        PG8_STAGE(PG8_SB(0, 0), cB, voffB); PG8_STAGE(PG8_SA(0, 0), cA, voffA); PG8_STAGE(PG8_SB(0, 1), cB + hstep, voffB); PG8_STAGE(PG8_SA(0, 1), cA + hstep, voffA);
        if (wr == 1) PG8_BAR;
        PG8_WAIT_V(4); PG8_BAR;
        PG8_STAGE(PG8_SB(1, 0), cB + kstep, voffB); PG8_STAGE(PG8_SA(1, 0), cA + kstep, voffA); PG8_STAGE(PG8_SB(1, 1), cB + hstep + kstep, voffB);
        PG8_WAIT_V(6); PG8_BAR;
    }
    for (;;) {
        const bool has_next = S.next(ui + 1, nxt);
        const char* nA = has_next ? (const char*)g.A + (size_t)nxt.pm * tstep : cA; const char* nB = has_next ? (const char*)g.Bt + (size_t)nxt.pn * tstep : cB;
        for (int t = 0; t < nt; t += 2) {
            const bool last = (t == nt - 2);
            const char* a1 = cA + (size_t)(t + 1) * kstep;
            const char* a2 = last ? nA : cA + (size_t)(t + 2) * kstep; const char* b2 = last ? nB : cB + (size_t)(t + 2) * kstep;
            const char* a3 = a2 + kstep; const char* b3 = b2 + kstep;
            if (last && has_next) S.a_ready(nxt);
            if constexpr (SP2) {
            PG8_LDB(B0, 0, 0); PG8_LDB(B1, 0, 1); PG8_SCHED; PG8_LDA(At, 0, 0); PG8_STAGE(PG8_SA(1, 1), a1 + hstep, voffA);
            PG8_WAIT_V(8); PG8_WAIT_L(0); PG8_BAR; PG8_MMA(0, 0, At, B0); PG8_MMA(0, 1, At, B1); PG8_BAR; PG8_SCHED;
            PG8_LDA(At, 0, 1); PG8_STAGE(PG8_SB(0, 0), b2, voffB); PG8_STAGE(PG8_SB(0, 1), b2 + hstep, voffB); PG8_STAGE(PG8_SA(0, 0), a2, voffA);
            PG8_WAIT_V(8); PG8_WAIT_L(0); PG8_BAR; PG8_MMA(1, 0, At, B0); PG8_MMA(1, 1, At, B1); PG8_BAR; PG8_SCHED;
            PG8_LDB(B0, 1, 0); PG8_LDB(B1, 1, 1); PG8_SCHED; PG8_LDA(At, 1, 0); PG8_STAGE(PG8_SA(0, 1), a2 + hstep, voffA);
            PG8_WAIT_V(8); PG8_WAIT_L(0); PG8_BAR; PG8_MMA(0, 0, At, B0); PG8_MMA(0, 1, At, B1); PG8_BAR; PG8_SCHED;
            PG8_LDA(At, 1, 1); PG8_STAGE(PG8_SB(1, 0), b3, voffB); PG8_STAGE(PG8_SB(1, 1), b3 + hstep, voffB); PG8_STAGE(PG8_SA(1, 0), a3, voffA);
            PG8_WAIT_V(8); PG8_WAIT_L(0); PG8_BAR; PG8_MMA(1, 0, At, B0); PG8_MMA(1, 1, At, B1); PG8_BAR; PG8_SCHED;
            } else {
            PG8_LDB(B0, 0, 0); PG8_SCHED; PG8_LDA(At, 0, 0); PG8_STAGE(PG8_SA(1, 1), a1 + hstep, voffA);
            PG8_WAIT_L(8); PG8_BAR; PG8_WAIT_L(0); PG8_MMA(0, 0, At, B0); PG8_BAR; PG8_SCHED;
            PG8_LDB(B1, 0, 1); PG8_STAGE(PG8_SB(0, 0), b2, voffB);
            PG8_BAR; PG8_WAIT_L(0); PG8_MMA(0, 1, At, B1); PG8_BAR;
            PG8_LDA(At, 0, 1); PG8_STAGE(PG8_SA(0, 0), a2, voffA);
            PG8_BAR; PG8_WAIT_L(0); PG8_MMA(1, 0, At, B0); PG8_BAR; PG8_SCHED;
            PG8_STAGE(PG8_SB(0, 1), b2 + hstep, voffB);
            PG8_WAIT_V(6); PG8_BAR; PG8_MMA(1, 1, At, B1); PG8_BAR;
            PG8_LDB(B0, 1, 0); PG8_SCHED; PG8_LDA(At, 1, 0); PG8_STAGE(PG8_SA(0, 1), a2 + hstep, voffA);
            PG8_WAIT_L(8); PG8_BAR; PG8_WAIT_L(0); PG8_MMA(0, 0, At, B0); PG8_BAR; PG8_SCHED;
            PG8_LDB(B1, 1, 1); PG8_STAGE(PG8_SB(1, 0), b3, voffB);
            PG8_BAR; PG8_WAIT_L(0); PG8_MMA(0, 1, At, B1); PG8_BAR;
            PG8_LDA(At, 1, 1); PG8_STAGE(PG8_SA(1, 0), a3, voffA);
            PG8_BAR; PG8_WAIT_L(0); PG8_MMA(1, 0, At, B0); PG8_BAR; PG8_SCHED;
            PG8_STAGE(PG8_SB(1, 1), b3 + hstep, voffB);
            PG8_WAIT_V(6); PG8_BAR; PG8_MMA(1, 1, At, B1); PG8_BAR;
            }
        }
        if constexpr (ALIGN_EPI) { if (wr == 0) PG8_BAR; }
        if constexpr (!Epi::AFTER_DRAIN) { E(acc, cur, wr, wc, fr, fq); S.done(cur); }
        if (!has_next) break;
#pragma unroll
        for (int a = 0; a < 2; ++a)
#pragma unroll
            for (int b = 0; b < 2; ++b)
#pragma unroll
                for (int m = 0; m < 4; ++m)
#pragma unroll
                    for (int n = 0; n < 2; ++n) acc[a][b][m][n] = (f32x4){0.f, 0.f, 0.f, 0.f};
        cur = nxt; cA = nA; cB = nB; ++ui;
        if constexpr (ALIGN_EPI) { if (wr == 1) PG8_BAR; }
    }
    PG8_WAIT_V(0);
    if constexpr (!ALIGN_EPI) { if (wr == 0) PG8_BAR; }
    PG8_BAR;
    if constexpr (Epi::AFTER_DRAIN) { E.fused(acc, cur, wr, wc, fr, fq, lds, wid, lane); S.done(cur); }
#undef PG8_SA
#undef PG8_SB
#undef PG8_STAGE
#undef PG8_LDA
#undef PG8_LDB
#undef PG8_MMA
#undef PG8_WAIT_V
#undef PG8_WAIT_L
#undef PG8_BAR
#undef PG8_SCHED
}
}
#ifndef PG8_SP2
#define PG8_SP2 true
#endif
#ifndef PG8_ALIGN
#define PG8_ALIGN true
#endif
constexpr int NWAVES = 8;
#ifndef MK_N_LAUNCHES
#define MK_N_LAUNCHES 12
#endif
constexpr int N_PHASES = 12;
constexpr int N_LAUNCHES = MK_N_LAUNCHES;

constexpr int BATCH = 2, SEQ = 8192, DM = 4096, M = BATCH * SEQ, HD = 128, DFF = 16384, TOPK = 256;
constexpr int C_AQ = 0, C_AK = 2048, C_AV = 2560, C_BQ = 3072, C_BK = 5120, C_BV = 7168, C_IQ = 9216, C_IK = 11264, C_IW = 11328, IN_COLS = 11360;
constexpr int NP_BF = 9216;
constexpr int NP_H = 2304;
constexpr float LN_EPS = 1e-5f;
constexpr float ALPHA = 1.189207115002721f;

constexpr size_t MiB = 1u << 20;
constexpr size_t WS_CTL = 0, CTL_ZERO_BYTES = 1 * MiB;
constexpr size_t WS_MOD = 2 * MiB;
constexpr size_t WS_XST = 2 * MiB + 512 * 1024;
constexpr size_t WS_SSQ = 3 * MiB;
constexpr size_t WS_WIN_BF = 6 * MiB, WS_WIN_H = 78 * MiB, WS_WOUT = 96 * MiB, WS_WUP = 128 * MiB, WS_WDOWN = 256 * MiB;
constexpr size_t WS_U = 384 * MiB;
constexpr size_t WS_UH = 512 * MiB;
constexpr size_t WS_PROJ = 640 * MiB;
constexpr size_t WS_IQ = 928 * MiB;
constexpr size_t WS_IKW = 992 * MiB;
constexpr size_t WS_IKN = 1000 * MiB;
constexpr size_t WS_LIST = 1002 * MiB;
constexpr size_t WS_HID = 640 * MiB;
constexpr size_t WS_END = 1152 * MiB;
constexpr int CW_TMO = 0, CW_CODE = 1, CW_BAR = 4096;

constexpr int RING_OFF = 0, RING_BYTES = 131072;
constexpr int LDSCTL_OFF = RING_BYTES, MISC_OFF = LDSCTL_OFF + 320;
constexpr int LDS_BYTES = 147456;

#define GAS __attribute__((address_space(1)))
#define LAS __attribute__((address_space(3)))
typedef unsigned short u16;
typedef unsigned v4u __attribute__((ext_vector_type(4)));
typedef unsigned v2u __attribute__((ext_vector_type(2)));
typedef float f32x4 __attribute__((ext_vector_type(4)));
typedef GAS unsigned gu32;
#define RLX_AGENT __ATOMIC_RELAXED, __HIP_MEMORY_SCOPE_AGENT
#define LDS_WAIT() asm volatile("s_waitcnt lgkmcnt(0)" ::: "memory")
#define VM_WAIT() asm volatile("s_waitcnt vmcnt(0)" ::: "memory")
__device__ __forceinline__ unsigned f2bf(float f) { unsigned u = __builtin_bit_cast(unsigned, f); return (u + 0x7fffu + ((u >> 16) & 1u)) >> 16; }
__device__ __forceinline__ unsigned pk2(float lo, float hi) { return f2bf(lo) | (f2bf(hi) << 16); }
__device__ __forceinline__ unsigned pkh2(float lo, float hi) { return pg8::cvt_pk_f16(lo, hi); }
__device__ __forceinline__ float bflo(unsigned w) { return __builtin_bit_cast(float, w << 16); }
__device__ __forceinline__ float bfhi(unsigned w) { return __builtin_bit_cast(float, w & 0xffff0000u); }
__device__ __forceinline__ float hlo(unsigned w) { return (float)__builtin_bit_cast(pg8::f16x2, w).x; }
__device__ __forceinline__ float hhi(unsigned w) { return (float)__builtin_bit_cast(pg8::f16x2, w).y; }

#define XB_TMO      128
#define XB_XCNT(j)  (256  + 64 * (j))
#define XB_XSUB(j)  (1280 + 64 * (j))
#define XB_XGEN(j)  (2304 + 64 * (j))
#define XB_TOP      3328
#define XB_TOPGEN   3392
#define XCD_BAR_WORDS 3456
#define XB_SPIN_CAP (1u << 18)

__device__ __forceinline__ unsigned xb_ld(unsigned* p)              { return __hip_atomic_load(p, __ATOMIC_RELAXED, __HIP_MEMORY_SCOPE_AGENT); }
__device__ __forceinline__ unsigned xb_add(unsigned* p, unsigned v) { return __hip_atomic_fetch_add(p, v, __ATOMIC_RELAXED, __HIP_MEMORY_SCOPE_AGENT); }
__device__ __forceinline__ unsigned xb_xcc_id() { return (unsigned)__builtin_amdgcn_s_getreg((3 << 11) | 20) & 0xFu; }
#define XB_SPIN(cond, bar) do { unsigned _sp = 0; while (cond) { __builtin_amdgcn_s_sleep(1); \
    if ((++_sp & 255u) == 0u) { if (xb_ld(&(bar)[XB_TMO])) break; if (_sp > XB_SPIN_CAP) { atomicAdd(&(bar)[XB_TMO], 1u); break; } } } } while (0)

struct XcdBarrier {
    unsigned* bar; unsigned x;
    volatile LAS unsigned* st;
};

__device__ __forceinline__ XcdBarrier xcd_barrier_post(unsigned* bar, volatile LAS unsigned* st) {
    XcdBarrier b; b.bar = bar; b.x = xb_xcc_id(); b.st = st;
    if (threadIdx.x == 0) (void)xb_add(&bar[XB_XCNT(b.x)], 1u);
    return b;
}
__device__ __forceinline__ void xcd_barrier_complete(unsigned* bar, unsigned x, unsigned& nloc, unsigned& nx) {
    const unsigned G = gridDim.x * gridDim.y * gridDim.z;
    unsigned sum, cnt, mine, sp = 0u;
    for (;;) {
        sum = 0u; cnt = 0u; mine = 0u;
#pragma unroll
        for (unsigned j = 0; j < 16; ++j) { const unsigned c = xb_ld(&bar[XB_XCNT(j)]); sum += c; cnt += (c > 0u) ? 1u : 0u; mine = (j == x) ? c : mine; }
        if (sum == G) break;
        __builtin_amdgcn_s_sleep(1);
        if ((++sp & 255u) == 0u) { if (xb_ld(&bar[XB_TMO])) break; if (sp > XB_SPIN_CAP) { atomicAdd(&bar[XB_TMO], 1u); break; } }
    }
    nloc = mine > 0u ? mine : 1u; nx = cnt > 0u ? cnt : 1u;
}

__device__ __forceinline__ void xcd_barrier(const XcdBarrier& b) {
    asm volatile("s_waitcnt vmcnt(0)" ::: "memory");
    __syncthreads();
    if (threadIdx.x == 0) {
        unsigned* bar = b.bar;
        __builtin_amdgcn_s_waitcnt(0);
        unsigned nloc = b.st[0], nx = b.st[1];
        if (nloc == 0u) { xcd_barrier_complete(bar, b.x, nloc, nx); b.st[0] = nloc; b.st[1] = nx; }
        const unsigned old = xb_add(&bar[XB_XSUB(b.x)], 1u);
        const unsigned gen = old / nloc;
        if (old + 1u == (gen + 1u) * nloc) {
            __builtin_amdgcn_fence(__ATOMIC_RELEASE, "agent");
            asm volatile("s_waitcnt vmcnt(0)" ::: "memory");
            const unsigned og = xb_add(&bar[XB_TOP], 1u);
            const unsigned tg = og / nx;
            if (og + 1u == (tg + 1u) * nx) xb_add(&bar[XB_TOPGEN], 1u);
            else XB_SPIN(xb_ld(&bar[XB_TOPGEN]) == tg, bar);
            __builtin_amdgcn_fence(__ATOMIC_ACQUIRE, "agent");
            xb_add(&bar[XB_XGEN(b.x)], 1u);
            asm volatile("s_waitcnt vmcnt(0)" ::: "memory");
        } else {
            XB_SPIN(xb_ld(&bar[XB_XGEN(b.x)]) == gen, bar);
            __builtin_amdgcn_fence(__ATOMIC_ACQUIRE, "agent");
            asm volatile("s_waitcnt vmcnt(0)" ::: "memory");
        }
    }
    __syncthreads();
}
struct Frame {
    LAS unsigned char* lds;
    volatile LAS unsigned* MISC;
    gu32* ctl;
    int tid, lane, wave;
    int vcu, G;
    const float *x, *c, *in_g, *in_b, *relb, *w_ada, *b_ada, *w_in, *kn_g, *kn_b, *gn_a, *gn_b, *w_out, *ln1_g, *ln1_b, *w_up, *w_down, *ln2_g, *ln2_b;
    float* out;
    float *MOD, *XST, *SSQ, *IKW;
    u16 *WIN_BF, *WIN_H, *WOUT, *WUP, *WDOWN, *U, *UH, *PROJ, *IQ, *IKN, *HID;
    unsigned* LIST;
};

__device__ __forceinline__ float wave_sum(float v) {
#pragma unroll
    for (int o = 1; o < 64; o <<= 1) v += __shfl_xor(v, o);
    return v;
}
__device__ __forceinline__ float wave_max(float v) {
#pragma unroll
    for (int o = 1; o < 64; o <<= 1) v = fmaxf(v, __shfl_xor(v, o));
    return v;
}
__device__ __forceinline__ int wave_sum_i(int v) {
#pragma unroll
    for (int o = 1; o < 64; o <<= 1) v += __shfl_xor(v, o);
    return v;
}
__device__ __forceinline__ unsigned t5_bucket(int n) {
    if (n < 16) return (unsigned)n;
    const float nf = (float)n;
    int large = 16 + (int)(logf(nf / 16.0f) / 2.0794415416798357f * 16.0f);
    return (unsigned)(large < 31 ? large : 31);
}

__device__ __forceinline__ void p0_transpose_item(const float* W, int K, int ldw, int k0, int n0, u16* WT, int drow, bool f16, LAS float* scr, int lane) {
#pragma unroll 8
    for (int i = 0; i < 32; ++i) { const int kk = 2 * i + (lane >> 5); scr[kk * 33 + (lane & 31)] = W[(size_t)(k0 + kk) * ldw + n0 + (lane & 31)]; }
    LDS_WAIT(); asm volatile("" ::: "memory");
    const int c = lane & 7;
#pragma unroll
    for (int j = 0; j < 4; ++j) { const int n = (lane >> 3) + 8 * j; const LAS float* s = scr + (8 * c) * 33 + n;
        v4u o;
        if (f16) { o.x = pkh2(s[0 * 33], s[1 * 33]); o.y = pkh2(s[2 * 33], s[3 * 33]); o.z = pkh2(s[4 * 33], s[5 * 33]); o.w = pkh2(s[6 * 33], s[7 * 33]); }
        else     { o.x = pk2(s[0 * 33], s[1 * 33]);  o.y = pk2(s[2 * 33], s[3 * 33]);  o.z = pk2(s[4 * 33], s[5 * 33]);  o.w = pk2(s[6 * 33], s[7 * 33]); }
        *(GAS v4u*)(WT + (size_t)(drow + n) * K + k0 + 8 * c) = o; }
    LDS_WAIT(); asm volatile("" ::: "memory");
}
__device__ __forceinline__ void p0a_prologue(Frame& F) {
    {
        LAS float* cs = (LAS float*)(F.lds + RING_OFF);
        LAS float* red = cs + 8192;
        for (int i = F.tid; i < 2 * DM; i += NWAVES * 64) { const float v = F.c[i]; cs[i] = v / (1.0f + __expf(-v)); }
        __syncthreads();
        const int rg = F.tid / 24, cl = F.tid % 24;
        for (int cb = blockIdx.x; cb < 256; cb += F.G) {
            f32x4 a0 = {0.f, 0.f, 0.f, 0.f}, a1 = {0.f, 0.f, 0.f, 0.f};
            if (rg < 21) {
                const float* wp = F.w_ada + 96 * cb + 4 * cl;
#pragma unroll 4
                for (int k = rg; k < DM; k += 21) { const f32x4 w = *(const GAS f32x4*)(wp + (size_t)k * (6 * DM)); a0 += w * cs[k]; a1 += w * cs[DM + k]; }
                LAS float* r = red + (rg * 24 + cl) * 8;
                *(LAS f32x4*)r = a0; *(LAS f32x4*)(r + 4) = a1;
            }
            __syncthreads();
            if (F.tid < 192) { const int b = F.tid / 96, col = F.tid % 96; float s = 0.f;
                for (int r = 0; r < 21; ++r) s += red[(r * 24 + (col >> 2)) * 8 + b * 4 + (col & 3)];
                F.MOD[b * (6 * DM) + 96 * cb + col] = s + F.b_ada[96 * cb + col]; }
            __syncthreads();
        }
    }
    {
        LAS float* scr = (LAS float*)(F.lds + RING_OFF + F.wave * 16384);
        const int gw = F.vcu * NWAVES + F.wave, NGW = F.G * NWAVES;
        constexpr int NB_IN = IN_COLS / 32;
        constexpr int I_IN = (DM / 64) * NB_IN, I_OUT = (DM / 64) * (DM / 32), I_UP = (DM / 64) * (DFF / 32), I_DN = (DFF / 64) * (DM / 32);
        constexpr int NITEMS = I_IN + I_OUT + I_UP + I_DN;
        for (int it = gw; it < NITEMS; it += NGW) {
            int r = it;
            if (r < I_IN) { const int kb = r / NB_IN, nb = r % NB_IN, n0 = 32 * nb;
                if (n0 < NP_BF) p0_transpose_item(F.w_in, DM, IN_COLS, 64 * kb, n0, F.WIN_BF, n0, false, scr, F.lane);
                else            p0_transpose_item(F.w_in, DM, IN_COLS, 64 * kb, n0, F.WIN_H, n0 - NP_BF, true, scr, F.lane);
                continue; } r -= I_IN;
            if (r < I_OUT) { const int kb = r / (DM / 32), nb = r % (DM / 32); p0_transpose_item(F.w_out, DM, DM, 64 * kb, 32 * nb, F.WOUT, 32 * nb, false, scr, F.lane); continue; } r -= I_OUT;
            if (r < I_UP) { const int kb = r / (DFF / 32), nb = r % (DFF / 32); p0_transpose_item(F.w_up, DM, DFF, 64 * kb, 32 * nb, F.WUP, 32 * nb, false, scr, F.lane); continue; } r -= I_UP;
            { const int kb = r / (DM / 32), nb = r % (DM / 32); p0_transpose_item(F.w_down, DFF, DM, 64 * kb, 32 * nb, F.WDOWN, 32 * nb, false, scr, F.lane); }
        }
        { constexpr int R0 = IN_COLS - NP_BF; GAS v4u* z = (GAS v4u*)(F.WIN_H + (size_t)R0 * DM); const size_t n16 = (size_t)(NP_H - R0) * DM * 2 / 16;
          for (size_t i = (size_t)gw * 64 + F.lane; i < n16; i += (size_t)NGW * 64) z[i] = (v4u){0u, 0u, 0u, 0u}; }
    }
}
__device__ __forceinline__ void p0b_rows(Frame& F) {
    const int gw = F.vcu * NWAVES + F.wave, NGW = F.G * NWAVES;
    for (int m = gw; m < M; m += NGW) {
        const GAS f32x4* xr = (const GAS f32x4*)(F.x + (size_t)m * DM) + F.lane;
        f32x4 v[16]; float s = 0.f;
#pragma unroll
        for (int j = 0; j < 16; ++j) { v[j] = xr[64 * j]; s += (v[j].x + v[j].y) + (v[j].z + v[j].w); }
        const float mean = wave_sum(s) * (1.f / DM); float s2 = 0.f;
#pragma unroll
        for (int j = 0; j < 16; ++j) { v[j] = v[j] - mean; s2 += (v[j].x * v[j].x + v[j].y * v[j].y) + (v[j].z * v[j].z + v[j].w * v[j].w); }
        const float rstd = 1.f / sqrtf(wave_sum(s2) * (1.f / DM) + LN_EPS);
        if (F.lane == 0) { F.XST[2 * m] = mean; F.XST[2 * m + 1] = rstd; }
        const float* mod = F.MOD + (size_t)(m / SEQ) * (6 * DM);
        GAS v2u* ob = (GAS v2u*)(F.U + (size_t)m * DM) + F.lane; GAS v2u* oh = (GAS v2u*)(F.UH + (size_t)m * DM) + F.lane;
#pragma unroll
        for (int j = 0; j < 16; ++j) { const int col = 4 * (F.lane + 64 * j);
            const f32x4 g = *(const f32x4*)(F.in_g + col), bb = *(const f32x4*)(F.in_b + col), sh = *(const f32x4*)(mod + col), sc = *(const f32x4*)(mod + DM + col);
            const f32x4 h0 = v[j] * rstd * g + bb; const f32x4 u = h0 * (sc + 1.0f) + sh;
            v2u wb, wh; wb.x = pk2(u.x, u.y); wb.y = pk2(u.z, u.w); wh.x = pkh2(u.x, u.y); wh.y = pkh2(u.z, u.w);
            ob[64 * j] = wb; oh[64 * j] = wh; }
    }
}
__device__ __forceinline__ void p1b_ikn(Frame& F) {
    const int gt = (F.vcu * NWAVES + F.wave) * 64 + F.lane, NGT = F.G * NWAVES * 64;
    for (int m = gt; m < M; m += NGT) {
        const f32x4* r = (const f32x4*)(F.IKW + (size_t)m * 128);
        f32x4 v[16]; float s = 0.f;
#pragma unroll
        for (int j = 0; j < 16; ++j) { v[j] = r[j]; s += (v[j].x + v[j].y) + (v[j].z + v[j].w); }
        const float mean = s * (1.f / 64.f); float s2 = 0.f;
#pragma unroll
        for (int j = 0; j < 16; ++j) { v[j] = v[j] - mean; s2 += (v[j].x * v[j].x + v[j].y * v[j].y) + (v[j].z * v[j].z + v[j].w * v[j].w); }
        const float rstd = 1.f / sqrtf(s2 * (1.f / 64.f) + LN_EPS);
        v2u* o = (v2u*)(F.IKN + (size_t)m * 64);
#pragma unroll
        for (int j = 0; j < 16; ++j) { const f32x4 g = *(const f32x4*)(F.kn_g + 4 * j), bb = *(const f32x4*)(F.kn_b + 4 * j); const f32x4 y = v[j] * rstd * g + bb;
            v2u w; w.x = pkh2(y.x, y.y); w.y = pkh2(y.z, y.w); o[j] = w; }
    }
}
constexpr float SB_EXIT = -40.0f;
__device__ __forceinline__ void sb_simple(Frame& F) {
    LAS float* qs = (LAS float*)(F.lds + RING_OFF + F.wave * 1024);
    const int gw = F.vcu * NWAVES + F.wave, NGW = F.G * NWAVES;
    const int lane = F.lane;
    for (int task = gw; task < M * 16; task += NGW) {
        const int m = task >> 4, h = task & 15, b = m / SEQ, t = m % SEQ;
        { const unsigned qq = *(const unsigned*)(F.PROJ + (size_t)m * NP_BF + C_BQ + h * HD + 2 * lane); qs[2 * lane] = bflo(qq); qs[2 * lane + 1] = bfhi(qq); }
        LDS_WAIT(); __builtin_amdgcn_wave_barrier();
        float o0 = 0.f, o1 = 0.f, carry = 0.f;
        for (int s_hi = t - 1; s_hi >= 0; s_hi -= 64) {
            const int s = s_hi - lane; const bool valid = s >= 0;
            const u16* krow = F.PROJ + (size_t)(b * SEQ + (valid ? s : 0)) * NP_BF + C_BK + h * HD;
            float dot = 0.f;
#pragma unroll
            for (int c = 0; c < 16; ++c) { const v4u kv = *(const v4u*)(krow + 8 * c); const f32x4 qa = *(const LAS f32x4*)(qs + 8 * c), qb = *(const LAS f32x4*)(qs + 8 * c + 4);
                dot += bflo(kv.x) * qa.x + bfhi(kv.x) * qa.y + bflo(kv.y) * qa.z + bfhi(kv.y) * qa.w + bflo(kv.z) * qb.x + bfhi(kv.z) * qb.y + bflo(kv.w) * qb.z + bfhi(kv.w) * qb.w; }
            const float z = dot * 0.08838834764831845f;
            const float sp = fmaxf(z, 0.f) + __logf(1.0f + __expf(-fabsf(z)));
            const float lk = valid ? -sp : 0.f, lb = z - sp;
            float inc = lk;
#pragma unroll
            for (int o = 1; o < 64; o <<= 1) { const float v = __shfl_up(inc, o); if (lane >= o) inc += v; }
            const float later = carry + inc - lk;
            const float A = valid ? __expf(lb + later) : 0.f;
            carry += __shfl(inc, 63);
            const int nk = (s_hi + 1) < 64 ? (s_hi + 1) : 64;
            const u16* vbase = F.PROJ + (size_t)(b * SEQ + s_hi) * NP_BF + C_BV + h * HD + 2 * lane;
#pragma unroll 8
            for (int j = 0; j < nk; ++j) { const float a = __builtin_bit_cast(float, __builtin_amdgcn_readlane(__builtin_bit_cast(int, A), j));
                const unsigned vv = *(const unsigned*)(vbase - (size_t)j * NP_BF); o0 += a * bflo(vv); o1 += a * bfhi(vv); }
            if (carry < SB_EXIT) break;
        }
        *(unsigned*)(F.U + (size_t)m * DM + 2048 + h * HD + 2 * lane) = pk2(o0, o1);
        const float ss = wave_sum(o0 * o0 + o1 * o1);
        if (lane == 0) F.SSQ[m * 32 + 16 + h] = ss;
        __builtin_amdgcn_wave_barrier();
    }
}
__device__ __forceinline__ unsigned mono_key(float f) { const unsigned u = __builtin_bit_cast(unsigned, f); return (u & 0x80000000u) ? ~u : (u | 0x80000000u); }
__device__ __forceinline__ void idx_simple(Frame& F) {
    LAS float* iqs = (LAS float*)(F.lds + RING_OFF);
    LAS float* ws = iqs + 2048;
    volatile LAS int* red = (volatile LAS int*)(ws + 32);
    const int tid = F.tid, lane = F.lane, wave = F.wave;
    for (int m = F.vcu; m < M; m += F.G) {
        const int b = m / SEQ, t = m % SEQ, n = t + 1;
        unsigned* list = F.LIST + (size_t)m * TOPK;
        if (n <= TOPK) { if (tid < TOPK) list[tid] = tid < n ? ((unsigned)tid | (t5_bucket(t - tid) << 16)) : 0u; continue; }
        for (int i = tid; i < 1024; i += NWAVES * 64) { const unsigned w = *(const unsigned*)(F.IQ + (size_t)m * 2048 + 2 * i); iqs[2 * i] = hlo(w); iqs[2 * i + 1] = hhi(w); }
        if (tid < 32) ws[tid] = F.IKW[(size_t)m * 128 + 64 + tid] * 0.17677669529663687f;
        __syncthreads();
        unsigned key[16];
#pragma unroll
        for (int j = 0; j < 16; ++j) {
            const int s = tid + 512 * j; key[j] = 0u;
            if (512 * j <= t) {
                const int sc = s <= t ? s : t;
                const v4u* kp = (const v4u*)(F.IKN + (size_t)(b * SEQ + sc) * 64);
                float kf[64];
#pragma unroll
                for (int c = 0; c < 8; ++c) { const v4u kv = kp[c]; kf[8 * c] = hlo(kv.x); kf[8 * c + 1] = hhi(kv.x); kf[8 * c + 2] = hlo(kv.y); kf[8 * c + 3] = hhi(kv.y); kf[8 * c + 4] = hlo(kv.z); kf[8 * c + 5] = hhi(kv.z); kf[8 * c + 6] = hlo(kv.w); kf[8 * c + 7] = hhi(kv.w); }
                float score = 0.f;
#pragma unroll 1
                for (int h = 0; h < 32; ++h) { float d = 0.f;
#pragma unroll
                    for (int c = 0; c < 16; ++c) { const f32x4 q = *(const LAS f32x4*)(iqs + h * 64 + 4 * c); d += q.x * kf[4 * c] + q.y * kf[4 * c + 1] + q.z * kf[4 * c + 2] + q.w * kf[4 * c + 3]; }
                    score += ws[h] * fmaxf(d * 0.125f, 0.f); }
                if (s <= t) key[j] = mono_key(score);
            }
        }
        unsigned T = 0u;
        for (int bit = 31; bit >= 0; --bit) {
            const unsigned cand = T | (1u << bit); int c = 0;
#pragma unroll
            for (int j = 0; j < 16; ++j) c += key[j] >= cand ? 1 : 0;
            c = wave_sum_i(c); if (lane == 0) red[wave] = c;
            __syncthreads();
            int tot = 0;
#pragma unroll
            for (int w = 0; w < 8; ++w) tot += red[w];
            __syncthreads();
            if (tot >= TOPK) T = cand;
        }
        int cgt = 0;
#pragma unroll
        for (int j = 0; j < 16; ++j) cgt += key[j] > T ? 1 : 0;
        cgt = wave_sum_i(cgt); if (lane == 0) red[wave] = cgt;
        __syncthreads();
        int need = TOPK;
#pragma unroll
        for (int w = 0; w < 8; ++w) need -= red[w];
        __syncthreads();
        int base = 0, eqbase = 0;
#pragma unroll
        for (int j = 0; j < 16; ++j) {
            if (512 * j <= t) {
                const bool gt = key[j] > T, eq = key[j] == T;
                const unsigned long long meq = __ballot(eq);
                const int eq_in = __popcll(meq & ((1ull << lane) - 1ull));
                if (lane == 0) red[wave] = __popcll(meq);
                __syncthreads();
                int eqpre = eqbase, eqtot = 0;
#pragma unroll
                for (int w = 0; w < 8; ++w) { const int v = red[w]; eqtot += v; if (w < wave) eqpre += v; }
                __syncthreads();
                const bool sel = gt || (eq && (eqpre + eq_in) < need);
                const unsigned long long ms = __ballot(sel);
                const int s_in = __popcll(ms & ((1ull << lane) - 1ull));
                if (lane == 0) red[8 + wave] = __popcll(ms);
                __syncthreads();
                int pre = base, tot = 0;
#pragma unroll
                for (int w = 0; w < 8; ++w) { const int v = red[8 + w]; tot += v; if (w < wave) pre += v; }
                __syncthreads();
                if (sel) { const int s = tid + 512 * j; const int pos = pre + s_in; if (pos < TOPK) list[pos] = (unsigned)s | (t5_bucket(t - s) << 16); }
                base += tot; eqbase += eqtot;
            }
        }
        __syncthreads();
    }
}
__device__ __forceinline__ void sparse_simple(Frame& F) {
    LAS float* qs = (LAS float*)(F.lds + RING_OFF + F.wave * 1024);
    LAS float* rb = (LAS float*)(F.lds + RING_OFF + 16384);
    for (int i = F.tid; i < 512; i += NWAVES * 64) rb[i] = F.relb[i];
    __syncthreads();
    const int gw = F.vcu * NWAVES + F.wave, NGW = F.G * NWAVES;
    const int lane = F.lane;
    for (int task = gw; task < M * 16; task += NGW) {
        const int m = task >> 4, h = task & 15, g = h >> 2, b = m / SEQ, t = m % SEQ;
        const int cnt = (t + 1) < TOPK ? (t + 1) : TOPK;
        { const unsigned qq = *(const unsigned*)(F.PROJ + (size_t)m * NP_BF + C_AQ + h * HD + 2 * lane); qs[2 * lane] = bflo(qq); qs[2 * lane + 1] = bfhi(qq); }
        LDS_WAIT(); __builtin_amdgcn_wave_barrier();
        unsigned e[4]; float lg[4];
#pragma unroll
        for (int j = 0; j < 4; ++j) {
            const bool valid = (64 * j + lane) < cnt;
            e[j] = valid ? F.LIST[(size_t)m * TOPK + 64 * j + lane] : 0u;
            const int idx = (int)(e[j] & 0xffffu), bk = (int)(e[j] >> 16);
            const u16* krow = F.PROJ + (size_t)(b * SEQ + idx) * NP_BF + C_AK + g * HD;
            float dot = 0.f;
#pragma unroll
            for (int c = 0; c < 16; ++c) { const v4u kv = *(const v4u*)(krow + 8 * c); const f32x4 qa = *(const LAS f32x4*)(qs + 8 * c), qb = *(const LAS f32x4*)(qs + 8 * c + 4);
                dot += bflo(kv.x) * qa.x + bfhi(kv.x) * qa.y + bflo(kv.y) * qa.z + bfhi(kv.y) * qa.w + bflo(kv.z) * qb.x + bfhi(kv.z) * qb.y + bflo(kv.w) * qb.z + bfhi(kv.w) * qb.w; }
            lg[j] = valid ? dot * 0.08838834764831845f + rb[bk * 16 + h] : -INFINITY;
        }
        const float mx = wave_max(fmaxf(fmaxf(lg[0], lg[1]), fmaxf(lg[2], lg[3])));
        float p[4]; float ps = 0.f;
#pragma unroll
        for (int j = 0; j < 4; ++j) { p[j] = __expf(lg[j] - mx); ps += p[j]; }
        const float inv = 1.0f / wave_sum(ps);
        float o0 = 0.f, o1 = 0.f;
        const u16* vb = F.PROJ + (size_t)(b * SEQ) * NP_BF + C_AV + g * HD + 2 * lane;
#pragma unroll
        for (int j = 0; j < 4; ++j) {
            const int nk = (cnt - 64 * j) < 64 ? (cnt - 64 * j) : 64;
#pragma unroll 8
            for (int l = 0; l < nk; ++l) {
                const float a = __builtin_bit_cast(float, __builtin_amdgcn_readlane(__builtin_bit_cast(int, p[j]), l));
                const int idx = __builtin_amdgcn_readlane((int)e[j], l) & 0xffff;
                const unsigned vv = *(const unsigned*)(vb + (size_t)idx * NP_BF); o0 += a * bflo(vv); o1 += a * bfhi(vv); }
        }
        o0 *= inv; o1 *= inv;
        *(unsigned*)(F.U + (size_t)m * DM + h * HD + 2 * lane) = pk2(o0, o1);
        const float ss = wave_sum(o0 * o0 + o1 * o1);
        if (lane == 0) F.SSQ[m * 32 + h] = ss;
        __builtin_amdgcn_wave_barrier();
    }
}
__device__ __forceinline__ void p2c_norm(Frame& F) {
    const int gw = F.vcu * NWAVES + F.wave, NGW = F.G * NWAVES;
    for (int m = gw; m < M; m += NGW) {
        const float sv = F.lane < 32 ? F.SSQ[m * 32 + F.lane] : 0.f;
        float sa = F.lane < 16 ? sv : 0.f, sb = (F.lane >= 16 && F.lane < 32) ? sv : 0.f;
        sa = wave_sum(sa); sb = wave_sum(sb);
        const float ra = 1.f / sqrtf(sa * (1.f / 2048.f) + LN_EPS), rb = 1.f / sqrtf(sb * (1.f / 2048.f) + LN_EPS);
        const GAS v4u* src = (const GAS v4u*)(F.U + (size_t)m * DM) + F.lane; GAS v4u* dst = (GAS v4u*)(F.UH + (size_t)m * DM) + F.lane;
#pragma unroll
        for (int j = 0; j < 8; ++j) { const int col = 8 * (F.lane + 64 * j); const v4u w = src[64 * j];
            const float r = col < 2048 ? ra : rb; const float* gp = col < 2048 ? F.gn_a + col : F.gn_b + (col - 2048);
            const f32x4 g0 = *(const f32x4*)gp, g1 = *(const f32x4*)(gp + 4);
            v4u o; o.x = pk2(bflo(w.x) * r * g0.x, bfhi(w.x) * r * g0.y); o.y = pk2(bflo(w.y) * r * g0.z, bfhi(w.y) * r * g0.w);
            o.z = pk2(bflo(w.z) * r * g1.x, bfhi(w.z) * r * g1.y); o.w = pk2(bflo(w.w) * r * g1.z, bfhi(w.w) * r * g1.w);
            dst[64 * j] = o; }
    }
}
template <bool WITH_U> __device__ __forceinline__ void ln_rows(Frame& F, const float* g, const float* bta) {
    const int gw = F.vcu * NWAVES + F.wave, NGW = F.G * NWAVES;
    for (int m = gw; m < M; m += NGW) {
        GAS f32x4* xr = (GAS f32x4*)(F.out + (size_t)m * DM) + F.lane;
        f32x4 v[16]; float s = 0.f;
#pragma unroll
        for (int j = 0; j < 16; ++j) { v[j] = xr[64 * j]; s += (v[j].x + v[j].y) + (v[j].z + v[j].w); }
        const float mean = wave_sum(s) * (1.f / DM); float s2 = 0.f;
#pragma unroll
        for (int j = 0; j < 16; ++j) { v[j] = v[j] - mean; s2 += (v[j].x * v[j].x + v[j].y * v[j].y) + (v[j].z * v[j].z + v[j].w * v[j].w); }
        const float rstd = 1.f / sqrtf(wave_sum(s2) * (1.f / DM) + LN_EPS);
        const float* mod = F.MOD + (size_t)(m / SEQ) * (6 * DM);
        GAS v2u* ob = (GAS v2u*)(F.U + (size_t)m * DM) + F.lane;
#pragma unroll
        for (int j = 0; j < 16; ++j) { const int col = 4 * (F.lane + 64 * j);
            const f32x4 gg = *(const f32x4*)(g + col), bb = *(const f32x4*)(bta + col);
            const f32x4 h = v[j] * rstd * gg + bb;
            xr[64 * j] = h;
            if (WITH_U) { const f32x4 sh = *(const f32x4*)(mod + 3 * DM + col), sc = *(const f32x4*)(mod + 4 * DM + col); const f32x4 u = h * (sc + 1.0f) + sh;
                v2u wb; wb.x = pk2(u.x, u.y); wb.y = pk2(u.z, u.w); ob[64 * j] = wb; } }
    }
}

struct Args { const float* in[19]; float* out; unsigned char* ws; int ph_lo, ph_hi, li, pad; };
__global__ void __launch_bounds__(NWAVES * 64, 2) hybrid_fwd(Args args) {
    extern __shared__ __attribute__((aligned(16))) unsigned char lds[];
    Frame F;
    F.lds = (LAS unsigned char*)lds;
    F.MISC = (volatile LAS unsigned*)(F.lds + MISC_OFF);
    F.tid = threadIdx.x; F.lane = F.tid & 63; F.wave = __builtin_amdgcn_readfirstlane(F.tid >> 6);
    F.G = gridDim.x; { const int bx = blockIdx.x; F.vcu = (F.G % 8 == 0) ? (bx % 8) * (F.G / 8) + bx / 8 : bx; }
    unsigned char* ws = args.ws;
    F.ctl = (gu32*)(ws + WS_CTL);
    F.x = args.in[0]; F.c = args.in[1]; F.in_g = args.in[2]; F.in_b = args.in[3]; F.relb = args.in[4]; F.w_ada = args.in[5]; F.b_ada = args.in[6]; F.w_in = args.in[7];
    F.kn_g = args.in[8]; F.kn_b = args.in[9]; F.gn_a = args.in[10]; F.gn_b = args.in[11]; F.w_out = args.in[12]; F.ln1_g = args.in[13]; F.ln1_b = args.in[14];
    F.w_up = args.in[15]; F.w_down = args.in[16]; F.ln2_g = args.in[17]; F.ln2_b = args.in[18]; F.out = args.out;
    F.MOD = (float*)(ws + WS_MOD); F.XST = (float*)(ws + WS_XST); F.SSQ = (float*)(ws + WS_SSQ); F.IKW = (float*)(ws + WS_IKW);
    F.WIN_BF = (u16*)(ws + WS_WIN_BF); F.WIN_H = (u16*)(ws + WS_WIN_H); F.WOUT = (u16*)(ws + WS_WOUT); F.WUP = (u16*)(ws + WS_WUP); F.WDOWN = (u16*)(ws + WS_WDOWN);
    F.U = (u16*)(ws + WS_U); F.UH = (u16*)(ws + WS_UH); F.PROJ = (u16*)(ws + WS_PROJ); F.IQ = (u16*)(ws + WS_IQ); F.IKN = (u16*)(ws + WS_IKN); F.HID = (u16*)(ws + WS_HID);
    F.LIST = (unsigned*)(ws + WS_LIST);
    for (int u = F.tid; u < (LDS_BYTES - LDSCTL_OFF) / 4; u += NWAVES * 64) ((LAS unsigned*)(F.lds + LDSCTL_OFF))[u] = 0u;
    __syncthreads();
    XcdBarrier bar; bar.bar = (unsigned*)(F.ctl + CW_BAR); bar.x = 0; bar.st = nullptr;
    if (N_LAUNCHES == 1) bar = xcd_barrier_post((unsigned*)(F.ctl + CW_BAR), F.MISC + 8);
#define GRID_BAR() do { if (N_LAUNCHES == 1) xcd_barrier(bar); } while (0)
    const int lo = args.ph_lo, hi = args.ph_hi;
#define IN(k) (lo <= (k) && (k) < hi)
#define BOTH(k) (IN(k) && IN((k) + 1))

    if (IN(0)) { p0a_prologue(F); if (BOTH(0)) GRID_BAR(); }
    if (IN(1)) { p0b_rows(F); if (BOTH(1)) GRID_BAR(); }
    if (IN(2)) {
        { pg8::Gemm g{F.U, F.WIN_BF, M, NP_BF, DM}; pg8::StaticOrder S; S.init(M, NP_BF, F.G, (int)blockIdx.x);
          pg8::EpiBf16<0> E{F.PROJ, NP_BF};
          pg8::gemm_phase<pg8::EpiBf16<0>, pg8::StaticOrder, false, PG8_ALIGN, PG8_SP2>(F.lds + RING_OFF, g, S, E); }
        { pg8::Gemm g{F.UH, F.WIN_H, M, NP_H, DM}; pg8::StaticOrder S; S.init(M, NP_H, F.G, (int)blockIdx.x);
          pg8::EpiIdx E{F.IQ, F.IKW};
          pg8::gemm_phase<pg8::EpiIdx, pg8::StaticOrder, true, PG8_ALIGN, PG8_SP2>(F.lds + RING_OFF, g, S, E); }
        if (BOTH(2)) GRID_BAR();
    }
    if (IN(3)) { p1b_ikn(F); sb_simple(F); if (BOTH(3)) GRID_BAR(); }
    if (IN(4)) { idx_simple(F); if (BOTH(4)) GRID_BAR(); }
    if (IN(5)) { sparse_simple(F); if (BOTH(5)) GRID_BAR(); }
    if (IN(6)) { p2c_norm(F); if (BOTH(6)) GRID_BAR(); }
    if (IN(7)) {
        pg8::Gemm g{F.UH, F.WOUT, M, DM, DM}; pg8::StaticOrder S; S.init(M, DM, F.G, (int)blockIdx.x);
        pg8::EpiOut E{F.x, F.XST, F.in_g, F.in_b, F.MOD + 2 * DM, 6 * DM, F.out, ALPHA, SEQ};
        pg8::gemm_phase<pg8::EpiOut, pg8::StaticOrder, false, PG8_ALIGN, PG8_SP2>(F.lds + RING_OFF, g, S, E);
        if (BOTH(7)) GRID_BAR();
    }
    if (IN(8)) { ln_rows<true>(F, F.ln1_g, F.ln1_b); if (BOTH(8)) GRID_BAR(); }
    if (IN(9)) {
        pg8::Gemm g{F.U, F.WUP, M, DFF, DM}; pg8::StaticOrder S; S.init(M, DFF, F.G, (int)blockIdx.x);
        pg8::EpiBf16<1> E{F.HID, DFF};
        pg8::gemm_phase<pg8::EpiBf16<1>, pg8::StaticOrder, false, PG8_ALIGN, PG8_SP2>(F.lds + RING_OFF, g, S, E);
        if (BOTH(9)) GRID_BAR();
    }
    if (IN(10)) {
        pg8::Gemm g{F.HID, F.WDOWN, M, DM, DFF}; pg8::StaticOrder S; S.init(M, DM, F.G, (int)blockIdx.x);
        pg8::EpiDown E{F.MOD + 5 * DM, 6 * DM, F.out, ALPHA, SEQ};
        pg8::gemm_phase<pg8::EpiDown, pg8::StaticOrder, false, PG8_ALIGN, PG8_SP2>(F.lds + RING_OFF, g, S, E);
        if (BOTH(10)) GRID_BAR();
    }
    if (IN(11)) { ln_rows<false>(F, F.ln2_g, F.ln2_b); }
#undef IN
#undef BOTH
}

extern "C" void kernel_launch(void* const* d_in, const int* in_sizes, int n_in, void* d_out, int out_size, void* d_ws, size_t ws_size, hipStream_t stream) {
    static int grid = 0;
    if (grid == 0) {
        if (n_in != 19 || in_sizes[0] != M * DM || out_size != M * DM || ws_size < WS_END) { fprintf(stderr, "kernel_launch: unexpected shapes (n_in %d, in0 %d, out %d, ws %zu, need %zu); nothing launched\n", n_in, n_in > 0 ? in_sizes[0] : -1, out_size, ws_size, (size_t)WS_END); grid = -1; return; }
        int dev = 0, cus = 0, per_cu = 0;
        if (hipGetDevice(&dev) != hipSuccess || hipDeviceGetAttribute(&cus, hipDeviceAttributeMultiprocessorCount, dev) != hipSuccess) { fprintf(stderr, "kernel_launch: device query failed\n"); grid = -1; return; }
        if (hipFuncSetAttribute((const void*)hybrid_fwd, hipFuncAttributeMaxDynamicSharedMemorySize, LDS_BYTES) != hipSuccess) { fprintf(stderr, "kernel_launch: hipFuncSetAttribute failed\n"); grid = -1; return; }
        if (hipOccupancyMaxActiveBlocksPerMultiprocessor(&per_cu, (const void*)hybrid_fwd, NWAVES * 64, LDS_BYTES) != hipSuccess || per_cu < 1)
            fprintf(stderr, "kernel_launch: note: occupancy query reports %d workgroups per CU\n", per_cu);
        (void)hipGetLastError();
        grid = cus;
    }
    if (grid < 0) return;
    if (hipMemsetAsync((char*)d_ws + WS_CTL, 0, CTL_ZERO_BYTES, stream) != hipSuccess) { fprintf(stderr, "kernel_launch: memset failed\n"); return; }
    Args a{};
    for (int i = 0; i < 19; ++i) a.in[i] = (const float*)d_in[i];
    a.out = (float*)d_out; a.ws = (unsigned char*)d_ws;
    for (int li = 0; li < N_LAUNCHES; ++li) {
        a.ph_lo = (N_LAUNCHES == 1) ? 0 : li; a.ph_hi = (N_LAUNCHES == 1) ? N_PHASES : li + 1; a.li = li; a.pad = 0;
        hipLaunchKernelGGL(hybrid_fwd, dim3(grid), dim3(NWAVES * 64), LDS_BYTES, stream, a);
        const hipError_t le = hipPeekAtLastError();
        if (le != hipSuccess) { fprintf(stderr, "kernel_launch: launch %d failed: %s\n", li, hipGetErrorName(le)); break; }
    }
}
```

```cpp
#include <hip/hip_runtime.h>
#include <cstdio>
#include <cstdint>
#include <cmath>
namespace pg8 {
#define PG8_LAS __attribute__((address_space(3)))
typedef unsigned short bf16_t;
typedef short bf16x8 __attribute__((ext_vector_type(8)));
typedef float f32x4 __attribute__((ext_vector_type(4)));
typedef unsigned u32x4 __attribute__((ext_vector_type(4)));
constexpr int BM = 256, BK = 64, HALF = 128, HTB = HALF * BK * 2  , STAGE_BYTES = 8 * HTB, NXCD = 8, WGM = 8;

__host__ __device__ __forceinline__ int lds_byte(int r, int c) { const int st = (r >> 4) * 2 + (c >> 5), rr = r & 15, cc = c & 31, ob = rr * 64 + cc * 2; return st * 1024 + (ob ^ (((ob >> 9) & 1) << 5)); }
__host__ __device__ __forceinline__ void stage_rc(int b, int& R, int& C) { const int st = b / 1024, sb = b % 1024, swz = sb ^ (((sb >> 9) & 1) << 5); R = (st >> 1) * 16 + swz / 64; C = (st & 1) * 32 + (swz % 64) / 2; }
__host__ __device__ __forceinline__ int perm32(int rho) { const int n = rho >> 4, i = rho & 15; return 8 * (i >> 2) + 4 * n + (i & 3); }

struct Unit { int pm, pn; };
struct Gemm { const bf16_t* A; const bf16_t* Bt; int M, N, K, ld; };

struct StaticOrder {
    int nM, nN, nwg, G, c;
    __host__ __device__ void init(int M, int N, int G_, int c_) { nM = M / BM; nN = N / BM; nwg = nM * nN; G = G_; c = c_; }
    __host__ __device__ bool next(int i, Unit& u) const {
        const long L = (long)i * G + c; if (L >= nwg) return false;
        int wgid = (int)L; { const int q = nwg / NXCD, r = nwg % NXCD, xcd = wgid % NXCD, off = wgid / NXCD; wgid = (xcd < r ? xcd * (q + 1) : r * (q + 1) + (xcd - r) * q) + off; }
        const int nig = WGM * nN, gid = wgid / nig, fm = gid * WGM, gsz = (nM - fm) < WGM ? (nM - fm) : WGM;
        u.pm = fm + ((wgid % nig) % gsz); u.pn = (wgid % nig) / gsz; return true;
    }
    __device__ __forceinline__ void a_ready(const Unit&) const {}
    __device__ __forceinline__ void done(const Unit&) const {}
};

typedef float cvt_f2 __attribute__((ext_vector_type(2)));
typedef __bf16 cvt_b2 __attribute__((ext_vector_type(2)));
__device__ __forceinline__ unsigned cvt_pk_bf16(float lo, float hi) { const cvt_f2 v = {lo, hi}; const cvt_b2 r = __builtin_convertvector(v, cvt_b2); return __builtin_bit_cast(unsigned, r); }
constexpr float EPI_ALPHA = 1.189207115002721f;
constexpr long long EPI_BQ_OFF = 640ll << 20, EPI_BK_OFF = -(128ll << 20), EPI_BV_OFF = -(64ll << 20);
constexpr int EPI_SEQ = 8192, EPI_GSTRIDE = 6 * 4096;
typedef _Float16 f16x8 __attribute__((ext_vector_type(8)));
typedef _Float16 f16x2 __attribute__((ext_vector_type(2)));
typedef unsigned u32x2 __attribute__((ext_vector_type(2)));
__device__ __forceinline__ unsigned cvt_pk_f16(float lo, float hi) { f16x2 h; h.x = (_Float16)lo; h.y = (_Float16)hi; return __builtin_bit_cast(unsigned, h); }
typedef int i32x4 __attribute__((ext_vector_type(4)));
template <int MODE> __device__ __forceinline__ f32x4 mma16(bf16x8 a, bf16x8 b, f32x4 c) {
    if constexpr (MODE == 1) return __builtin_amdgcn_mfma_f32_16x16x32_f16(__builtin_bit_cast(f16x8, a), __builtin_bit_cast(f16x8, b), c, 0, 0, 0);
    else if constexpr (MODE == 2) return __builtin_bit_cast(f32x4, __builtin_amdgcn_mfma_i32_16x16x64_i8(__builtin_bit_cast(i32x4, a), __builtin_bit_cast(i32x4, b), __builtin_bit_cast(i32x4, c), 0, 0, 0));
    else return __builtin_amdgcn_mfma_f32_16x16x32_bf16(a, b, c, 0, 0, 0);
}
typedef int i32x8 __attribute__((ext_vector_type(8)));
__device__ __forceinline__ f32x4 mma_f8(bf16x8 a0, bf16x8 a1, bf16x8 b0, bf16x8 b1, f32x4 c) {
    const i32x4 x0 = __builtin_bit_cast(i32x4, a0), x1 = __builtin_bit_cast(i32x4, a1), y0 = __builtin_bit_cast(i32x4, b0), y1 = __builtin_bit_cast(i32x4, b1);
    const i32x8 a = {x0[0], x0[1], x0[2], x0[3], x1[0], x1[1], x1[2], x1[3]}, b = {y0[0], y0[1], y0[2], y0[3], y1[0], y1[1], y1[2], y1[3]};
    const int sc1 = 0x7f7f7f7f;
    asm volatile("v_mfma_scale_f32_16x16x128_f8f6f4 %0, %1, %2, %0, %3, %3 op_sel_hi:[0,0,0]" : "+v"(c) : "v"(a), "v"(b), "v"(sc1));
    return c;
}
__device__ __forceinline__ f32x4 acc_i2f(const f32x4 a) { return __builtin_convertvector(__builtin_bit_cast(i32x4, a), f32x4); }

template <int ACT  > struct EpiBf16 {
    static constexpr bool PERM = true, AFTER_DRAIN = false;
    bf16_t* O; int ldc;
    __device__ __forceinline__ void operator()(const f32x4 (&acc)[2][2][4][2], const Unit& u, int wr, int wc, int fr, int fq) const {
        const int row0 = u.pm * BM + wr * 64 + fr; const int col0 = u.pn * BM + wc * 32 + 8 * fq;
#pragma unroll
        for (int ai = 0; ai < 2; ++ai)
#pragma unroll
            for (int m = 0; m < 4; ++m) { bf16_t* rowp = O + (size_t)(row0 + ai * HALF + m * 16) * ldc + col0;
#pragma unroll
                for (int bj = 0; bj < 2; ++bj) { f32x4 v0 = acc[ai][bj][m][0], v1 = acc[ai][bj][m][1];
                    if (ACT == 1) {
#pragma unroll
                        for (int j = 0; j < 4; ++j) { const float a = fmaxf(v0[j], 0.f), b = fmaxf(v1[j], 0.f); v0[j] = a * a; v1[j] = b * b; } }
                    u32x4 w; w.x = cvt_pk_bf16(v0[0], v0[1]); w.y = cvt_pk_bf16(v0[2], v0[3]); w.z = cvt_pk_bf16(v1[0], v1[1]); w.w = cvt_pk_bf16(v1[2], v1[3]);
                    *(u32x4*)(rowp + bj * HALF) = w; } }
    }
};
struct EpiIdx {
    static constexpr bool PERM = true, AFTER_DRAIN = false;
    bf16_t* IQ;
    __device__ __forceinline__ void operator()(const f32x4 (&acc)[2][2][4][2], const Unit& u, int wr, int wc, int fr, int fq) const {
        const int row0 = u.pm * BM + wr * 64 + fr; const int col0 = u.pn * BM + wc * 32 + 8 * fq;
#pragma unroll
        for (int ai = 0; ai < 2; ++ai)
#pragma unroll
            for (int m = 0; m < 4; ++m) { bf16_t* rowp = IQ + (size_t)(row0 + ai * HALF + m * 16) * 2048 + col0;
#pragma unroll
                for (int bj = 0; bj < 2; ++bj) { const f32x4 v0 = acc[ai][bj][m][0], v1 = acc[ai][bj][m][1];
                    u32x4 w; w.x = cvt_pk_f16(v0[0], v0[1]); w.y = cvt_pk_f16(v0[2], v0[3]); w.z = cvt_pk_f16(v1[0], v1[1]); w.w = cvt_pk_f16(v1[2], v1[3]);
                    *(u32x4*)(rowp + bj * HALF) = w; } }
    }
};
struct EpiTail {
    static constexpr bool PERM = true, AFTER_DRAIN = false;
    float* IKWP; size_t qstride;
    __device__ __forceinline__ void operator()(const f32x4 (&acc)[2][2][4][2], const Unit& u, int wr, int wc, int fr, int fq) const {
        const int row0 = u.pm * BM + wr * 64 + fr; const int col0 = wc * 32 + 8 * fq;
        float* base = IKWP + (size_t)u.pn * qstride;
#pragma unroll
        for (int ai = 0; ai < 2; ++ai)
#pragma unroll
            for (int m = 0; m < 4; ++m) { float* rowp = base + (size_t)(row0 + ai * HALF + m * 16) * 128 + col0;
                *(f32x4*)(rowp) = acc[ai][0][m][0]; *(f32x4*)(rowp + 4) = acc[ai][0][m][1]; }
    }
};
template <int ACT  > struct EpiQBf16 {
    static constexpr bool PERM = true, AFTER_DRAIN = false;
    bf16_t* O; int ldc; const float* sa; const float* sb;
    __device__ __forceinline__ void operator()(const f32x4 (&acc)[2][2][4][2], const Unit& u, int wr, int wc, int fr, int fq) const {
        const int row0 = u.pm * BM + wr * 64 + fr; const int col0 = u.pn * BM + wc * 32 + 8 * fq;
        f32x4 sbv[2][2];
#pragma unroll
        for (int bj = 0; bj < 2; ++bj)
#pragma unroll
            for (int n = 0; n < 2; ++n) sbv[bj][n] = *(const f32x4*)(sb + col0 + bj * HALF + 4 * n);
#pragma unroll
        for (int ai = 0; ai < 2; ++ai)
#pragma unroll
            for (int m = 0; m < 4; ++m) { const int r = row0 + ai * HALF + m * 16; const float sr = sa[r]; bf16_t* rowp = O + (size_t)r * ldc + col0;
                if (u.pn >= 12) {
                    const int cb = u.pn * BM - 3072, wh = cb >> 11, hd = (cb & 2047) >> 7;
                    bf16_t* hbp = (bf16_t*)((char*)O + (wh == 0 ? EPI_BQ_OFF : (wh == 1 ? EPI_BK_OFF : EPI_BV_OFF)));
                    rowp = hbp + ((size_t)((r / EPI_SEQ) * 16 + hd) * EPI_SEQ + (r % EPI_SEQ)) * 128 + (col0 & 127); }
#pragma unroll
                for (int bj = 0; bj < 2; ++bj) { f32x4 v0 = acc_i2f(acc[ai][bj][m][0]) * sr * sbv[bj][0], v1 = acc_i2f(acc[ai][bj][m][1]) * sr * sbv[bj][1];
                    if (ACT == 1) {
#pragma unroll
                        for (int j = 0; j < 4; ++j) { const float a = fmaxf(v0[j], 0.f), b = fmaxf(v1[j], 0.f); v0[j] = a * a; v1[j] = b * b; } }
                    u32x4 w; w.x = cvt_pk_bf16(v0[0], v0[1]); w.y = cvt_pk_bf16(v0[2], v0[3]); w.z = cvt_pk_bf16(v1[0], v1[1]); w.w = cvt_pk_bf16(v1[2], v1[3]);
                    *(u32x4*)(rowp + (u.pn >= 12 ? bj * (EPI_SEQ * 128) : bj * HALF)) = w; } }
    }
};
constexpr float EPI_HSCALE = 8.0f;
struct EpiQF8 {
    static constexpr bool PERM = true, AFTER_DRAIN = false;
    unsigned char* O; int ldc; const float* sa; const float* sb;
    __device__ __forceinline__ void operator()(const f32x4 (&acc)[2][2][4][2], const Unit& u, int wr, int wc, int fr, int fq) const {
        const int row0 = u.pm * BM + wr * 64 + fr; const int col0 = u.pn * BM + wc * 32 + 8 * fq;
        f32x4 sbv[2][2];
#pragma unroll
        for (int bj = 0; bj < 2; ++bj)
#pragma unroll
            for (int n = 0; n < 2; ++n) sbv[bj][n] = *(const f32x4*)(sb + col0 + bj * HALF + 4 * n) * __builtin_sqrtf(EPI_HSCALE);
        const int colw = u.pn * BM + wc * 32 + 8 * (fq & ~1);
#pragma unroll
        for (int ai = 0; ai < 2; ++ai)
#pragma unroll
            for (int mp = 0; mp < 4; mp += 2) { const int ra = row0 + ai * HALF + mp * 16, rb = ra + 16; const float sra = sa[ra], srb = sa[rb];
                unsigned char* rowp = O + (size_t)((fq & 1) ? rb : ra) * ldc + colw;
#pragma unroll
                for (int bj = 0; bj < 2; ++bj) { u32x2 wab[2];
#pragma unroll
                    for (int h = 0; h < 2; ++h) { const float sr = h ? srb : sra;
                        f32x4 v0 = acc_i2f(acc[ai][bj][mp + h][0]) * sr * sbv[bj][0], v1 = acc_i2f(acc[ai][bj][mp + h][1]) * sr * sbv[bj][1];
#pragma unroll
                        for (int j = 0; j < 4; ++j) { v0[j] = __builtin_amdgcn_fmed3f(v0[j], 0.f, 20.976176963403f); v1[j] = __builtin_amdgcn_fmed3f(v1[j], 0.f, 20.976176963403f); }
                        v0 = v0 * v0; v1 = v1 * v1;
                        int w0 = 0, w1 = 0;
                        w0 = __builtin_amdgcn_cvt_pk_fp8_f32(v0[0], v0[1], w0, false); w0 = __builtin_amdgcn_cvt_pk_fp8_f32(v0[2], v0[3], w0, true);
                        w1 = __builtin_amdgcn_cvt_pk_fp8_f32(v1[0], v1[1], w1, false); w1 = __builtin_amdgcn_cvt_pk_fp8_f32(v1[2], v1[3], w1, true);
                        wab[h].x = (unsigned)w0; wab[h].y = (unsigned)w1; }
                    const auto sx = __builtin_amdgcn_permlane16_swap(wab[0].x, wab[1].x, false, false); const auto sy = __builtin_amdgcn_permlane16_swap(wab[0].y, wab[1].y, false, false);
                    const unsigned sx0 = sx[0], sx1 = sx[1], sy0 = sy[0], sy1 = sy[1];
                    u32x4 w; w.x = sx0; w.y = sy0; w.z = sx1; w.w = sy1; *(u32x4*)(rowp + bj * HALF) = w; } }
    }
};
struct EpiOut {
    static constexpr bool PERM = true, AFTER_DRAIN = false;
    const bf16_t* h0; const float* gate; bf16_t* v1; const float* sa; const float* sb;
    __device__ __forceinline__ void operator()(const f32x4 (&acc)[2][2][4][2], const Unit& u, int wr, int wc, int fr, int fq) const {
        const int row0 = u.pm * BM + wr * 64 + fr, col0 = u.pn * BM + wc * 32 + 8 * fq;
        const float* gt = gate + (size_t)((u.pm * BM) / EPI_SEQ) * EPI_GSTRIDE;
        f32x4 gv[2][2];
#pragma unroll
        for (int bj = 0; bj < 2; ++bj)
#pragma unroll
            for (int n = 0; n < 2; ++n) { const int c = col0 + bj * HALF + 4 * n; gv[bj][n] = *(const f32x4*)(gt + c) * *(const f32x4*)(sb + c); }
#pragma unroll
        for (int ai = 0; ai < 2; ++ai)
#pragma unroll
            for (int m = 0; m < 4; ++m) { const int r = row0 + ai * HALF + m * 16; const float sr = sa[r]; const size_t off = (size_t)r * 4096 + col0;
#pragma unroll
                for (int bj = 0; bj < 2; ++bj) { const u32x4 hw = *(const u32x4*)(h0 + off + bj * HALF);
                    const f32x4 ha = {__builtin_bit_cast(float, hw.x << 16), __builtin_bit_cast(float, hw.x & 0xffff0000u), __builtin_bit_cast(float, hw.y << 16), __builtin_bit_cast(float, hw.y & 0xffff0000u)};
                    const f32x4 hb = {__builtin_bit_cast(float, hw.z << 16), __builtin_bit_cast(float, hw.z & 0xffff0000u), __builtin_bit_cast(float, hw.w << 16), __builtin_bit_cast(float, hw.w & 0xffff0000u)};
                    const f32x4 v0 = ha * EPI_ALPHA + gv[bj][0] * (acc_i2f(acc[ai][bj][m][0]) * sr), vb = hb * EPI_ALPHA + gv[bj][1] * (acc_i2f(acc[ai][bj][m][1]) * sr);
                    u32x4 w; w.x = cvt_pk_bf16(v0[0], v0[1]); w.y = cvt_pk_bf16(v0[2], v0[3]); w.z = cvt_pk_bf16(vb[0], vb[1]); w.w = cvt_pk_bf16(vb[2], vb[3]);
                    *(u32x4*)(v1 + off + bj * HALF) = w; }
                if (m == 3) asm volatile("" ::: "memory"); }
    }
};
struct EpiDown {
    static constexpr bool PERM = true, AFTER_DRAIN = false;
    const float* gate; bf16_t* v2; const float* st1; const float* lng; const float* lnb; const float* sb; const bf16_t* v1;
    __device__ __forceinline__ void operator()(const f32x4 (&acc)[2][2][4][2], const Unit& u, int wr, int wc, int fr, int fq) const {
        const int row0 = u.pm * BM + wr * 64 + fr, col0 = u.pn * BM + wc * 32 + 8 * fq;
        const float* gt = gate + (size_t)((u.pm * BM) / EPI_SEQ) * EPI_GSTRIDE;
#pragma unroll
        for (int bj = 0; bj < 2; ++bj) {
            asm volatile("" ::: "memory");
            f32x4 gv[2], lg[2], lb[2];
#pragma unroll
            for (int n = 0; n < 2; ++n) { const int c = col0 + bj * HALF + 4 * n; gv[n] = *(const f32x4*)(gt + c) * *(const f32x4*)(sb + c) * (1.0f / EPI_HSCALE); lg[n] = *(const f32x4*)(lng + c); lb[n] = *(const f32x4*)(lnb + c); }
#pragma unroll
            for (int ai = 0; ai < 2; ++ai)
#pragma unroll
                for (int m = 0; m < 4; ++m) { const int r = row0 + ai * HALF + m * 16; const float mean = st1[2 * r], rstd = st1[2 * r + 1]; const size_t off = (size_t)r * 4096 + col0 + bj * HALF;
                    const u32x4 hw = *(const u32x4*)(v1 + off);
                    const f32x4 ha = {__builtin_bit_cast(float, hw.x << 16), __builtin_bit_cast(float, hw.x & 0xffff0000u), __builtin_bit_cast(float, hw.y << 16), __builtin_bit_cast(float, hw.y & 0xffff0000u)};
                    const f32x4 hb = {__builtin_bit_cast(float, hw.z << 16), __builtin_bit_cast(float, hw.z & 0xffff0000u), __builtin_bit_cast(float, hw.w << 16), __builtin_bit_cast(float, hw.w & 0xffff0000u)};
                    const f32x4 o0 = ((ha - mean) * rstd * lg[0] + lb[0]) * EPI_ALPHA + gv[0] * acc[ai][bj][m][0], o1 = ((hb - mean) * rstd * lg[1] + lb[1]) * EPI_ALPHA + gv[1] * acc[ai][bj][m][1];
                    u32x4 w; w.x = cvt_pk_bf16(o0[0], o0[1]); w.y = cvt_pk_bf16(o0[2], o0[3]); w.z = cvt_pk_bf16(o1[0], o1[1]); w.w = cvt_pk_bf16(o1[2], o1[3]);
                    *(u32x4*)(v2 + off) = w;
                    if (m & 1) asm volatile("" ::: "memory"); }
        }
    }
};

template <class Epi, class Sched, int MODE, bool KS, bool ALIGN_EPI, bool SP2>
__device__ __forceinline__ void gemm_phase(PG8_LAS unsigned char* lds, const Gemm g, const Sched& S, const Epi& E, const int tid  ) {
    const int wid = __builtin_amdgcn_readfirstlane(tid >> 6), lane = tid & 63, wr = wid >> 2, wc = wid & 3, fr = lane & 15, fq = lane >> 4;
    const int K = g.K, nt = K / BK, LD = g.ld;
    unsigned voffA[2], voffB[2];
#pragma unroll
    for (int i = 0; i < 2; ++i) { int R, C; stage_rc(tid * 16 + i * 8192, R, C); const int Rb = Epi::PERM ? ((R & ~31) + perm32(R & 31)) : R;
        voffA[i] = (unsigned)(R * LD + C) * 2u; voffB[i] = (unsigned)(Rb * LD + C) * 2u; }
    const size_t kstep = (size_t)(BK * 2);
    const size_t hstep = (size_t)HALF * LD * 2;
    const size_t tstep = 2 * hstep;
    const unsigned ldsw = (unsigned)wid * 1024u;
    const int aoff = lds_byte(wr * 64 + fr, fq * 8), boff = lds_byte(wc * 32 + fr, fq * 8);
#define PG8_SA(b, h) (((b) * 2 + (h)) * HTB)
#define PG8_SB(b, h) ((4 + (b) * 2 + (h)) * HTB)
#define PG8_STAGE(bufoff, gbase, voff) do { _Pragma("unroll") for (int _i = 0; _i < 2; ++_i) \
        __builtin_amdgcn_global_load_lds((const unsigned*)((const char*)(gbase) + (voff)[_i]), (PG8_LAS unsigned*)(lds + (bufoff) + ldsw + _i * 8192), 16, 0, 0); } while (0)
#define PG8_LDA(dst, b, h) do { _Pragma("unroll") for (int m = 0; m < 4; ++m) _Pragma("unroll") for (int k = 0; k < 2; ++k) dst[m][k] = *(const PG8_LAS bf16x8*)(lds + PG8_SA(b, h) + aoff + m * 2048 + k * 1024); } while (0)
#define PG8_LDB(dst, b, h) do { _Pragma("unroll") for (int n = 0; n < 2; ++n) _Pragma("unroll") for (int k = 0; k < 2; ++k) dst[n][k] = *(const PG8_LAS bf16x8*)(lds + PG8_SB(b, h) + boff + n * 2048 + k * 1024); } while (0)
#define PG8_MMA(ai, bj, At, Bt) do { __builtin_amdgcn_s_setprio(1); \
        if constexpr (MODE == 3) { _Pragma("unroll") for (int m = 0; m < 4; ++m) _Pragma("unroll") for (int n = 0; n < 2; ++n) acc[ai][bj][m][n] = mma_f8(Bt[n][0], Bt[n][1], At[m][0], At[m][1], acc[ai][bj][m][n]); } \
        else { _Pragma("unroll") for (int m = 0; m < 4; ++m) _Pragma("unroll") for (int n = 0; n < 2; ++n) _Pragma("unroll") for (int k = 0; k < 2; ++k) \
        acc[ai][bj][m][n] = mma16<MODE>(Bt[n][k], At[m][k], acc[ai][bj][m][n]); } __builtin_amdgcn_s_setprio(0); } while (0)
#define PG8_WAIT_V(n) asm volatile("s_waitcnt vmcnt(" #n ")" ::: "memory")
#define PG8_WAIT_L(n) asm volatile("s_waitcnt lgkmcnt(" #n ")" ::: "memory")
#define PG8_BAR __builtin_amdgcn_s_barrier()
#define PG8_SCHED __builtin_amdgcn_sched_barrier(0)
    Unit cur, nxt; int ui = 0;
    if (!S.next(0, cur)) return;
    f32x4 acc[2][2][4][2];
#pragma unroll
    for (int a = 0; a < 2; ++a)
#pragma unroll
        for (int b = 0; b < 2; ++b)
#pragma unroll
            for (int m = 0; m < 4; ++m)
#pragma unroll
                for (int n = 0; n < 2; ++n) acc[a][b][m][n] = (f32x4){0.f, 0.f, 0.f, 0.f};
    bf16x8 At[4][2], B0[2][2], B1[2][2];
#define PG8_APTR(u) ((const char*)g.A + (size_t)(u).pm * tstep + (KS ? (size_t)(u).pn * K * 2 : (size_t)0))
#define PG8_BPTR(u) ((const char*)g.Bt + (KS ? (size_t)(u).pn * K * 2 : (size_t)(u).pn * tstep))
    const char* cA = PG8_APTR(cur); const char* cB = PG8_BPTR(cur);
    S.a_ready(cur);
    if constexpr (SP2) {
        PG8_STAGE(PG8_SB(0, 0), cB, voffB); PG8_STAGE(PG8_SB(0, 1), cB + hstep, voffB); PG8_STAGE(PG8_SA(0, 0), cA, voffA); PG8_STAGE(PG8_SA(0, 1), cA + hstep, voffA);
        if (wr == 1) PG8_BAR;
        PG8_WAIT_V(2); PG8_BAR;
        PG8_STAGE(PG8_SB(1, 0), cB + kstep, voffB); PG8_STAGE(PG8_SA(1, 0), cA + kstep, voffA); PG8_STAGE(PG8_SB(1, 1), cB + hstep + kstep, voffB);
        PG8_WAIT_V(6); PG8_BAR;
    } else {
        PG8_STAGE(PG8_SB(0, 0), cB, voffB); PG8_STAGE(PG8_SA(0, 0), cA, voffA); PG8_STAGE(PG8_SB(0, 1), cB + hstep, voffB); PG8_STAGE(PG8_SA(0, 1), cA + hstep, voffA);
        if (wr == 1) PG8_BAR;
        PG8_WAIT_V(4); PG8_BAR;
        PG8_STAGE(PG8_SB(1, 0), cB + kstep, voffB); PG8_STAGE(PG8_SA(1, 0), cA + kstep, voffA); PG8_STAGE(PG8_SB(1, 1), cB + hstep + kstep, voffB);
        PG8_WAIT_V(6); PG8_BAR;
    }
    for (;;) {
        const bool has_next = S.next(ui + 1, nxt);
        const char* nA = has_next ? PG8_APTR(nxt) : cA; const char* nB = has_next ? PG8_BPTR(nxt) : cB;
        for (int t = 0; t < nt; t += 2) {
            const bool last = (t == nt - 2);
            const char* a1 = cA + (size_t)(t + 1) * kstep;
            const char* a2 = last ? nA : cA + (size_t)(t + 2) * kstep; const char* b2 = last ? nB : cB + (size_t)(t + 2) * kstep;
            const char* a3 = a2 + kstep; const char* b3 = b2 + kstep;
            if (last && has_next) S.a_ready(nxt);
            if constexpr (SP2) {
            PG8_LDB(B0, 0, 0); PG8_LDB(B1, 0, 1); PG8_SCHED; PG8_LDA(At, 0, 0); PG8_STAGE(PG8_SA(1, 1), a1 + hstep, voffA);
            PG8_WAIT_V(8); PG8_WAIT_L(0); PG8_BAR; PG8_MMA(0, 0, At, B0); PG8_MMA(0, 1, At, B1); PG8_BAR; PG8_SCHED;
            PG8_LDA(At, 0, 1); PG8_STAGE(PG8_SB(0, 0), b2, voffB); PG8_STAGE(PG8_SB(0, 1), b2 + hstep, voffB); PG8_STAGE(PG8_SA(0, 0), a2, voffA);
            PG8_WAIT_V(8); PG8_WAIT_L(0); PG8_BAR; PG8_MMA(1, 0, At, B0); PG8_MMA(1, 1, At, B1); PG8_BAR; PG8_SCHED;
            PG8_LDB(B0, 1, 0); PG8_LDB(B1, 1, 1); PG8_SCHED; PG8_LDA(At, 1, 0); PG8_STAGE(PG8_SA(0, 1), a2 + hstep, voffA);
            PG8_WAIT_V(8); PG8_WAIT_L(0); PG8_BAR; PG8_MMA(0, 0, At, B0); PG8_MMA(0, 1, At, B1); PG8_BAR; PG8_SCHED;
            PG8_LDA(At, 1, 1); PG8_STAGE(PG8_SB(1, 0), b3, voffB); PG8_STAGE(PG8_SB(1, 1), b3 + hstep, voffB); PG8_STAGE(PG8_SA(1, 0), a3, voffA);
            PG8_WAIT_V(8); PG8_WAIT_L(0); PG8_BAR; PG8_MMA(1, 0, At, B0); PG8_MMA(1, 1, At, B1); PG8_BAR; PG8_SCHED;
            } else {
            PG8_LDB(B0, 0, 0); PG8_SCHED; PG8_LDA(At, 0, 0); PG8_STAGE(PG8_SA(1, 1), a1 + hstep, voffA);
            PG8_WAIT_L(8); PG8_BAR; PG8_WAIT_L(0); PG8_MMA(0, 0, At, B0); PG8_BAR; PG8_SCHED;
            PG8_LDB(B1, 0, 1); PG8_STAGE(PG8_SB(0, 0), b2, voffB);
            PG8_BAR; PG8_WAIT_L(0); PG8_MMA(0, 1, At, B1); PG8_BAR;
            PG8_LDA(At, 0, 1); PG8_STAGE(PG8_SA(0, 0), a2, voffA);
            PG8_BAR; PG8_WAIT_L(0); PG8_MMA(1, 0, At, B0); PG8_BAR; PG8_SCHED;
            PG8_STAGE(PG8_SB(0, 1), b2 + hstep, voffB);
            PG8_WAIT_V(6); PG8_BAR; PG8_MMA(1, 1, At, B1); PG8_BAR;
            PG8_LDB(B0, 1, 0); PG8_SCHED; PG8_LDA(At, 1, 0); PG8_STAGE(PG8_SA(0, 1), a2 + hstep, voffA);
            PG8_WAIT_L(8); PG8_BAR; PG8_WAIT_L(0); PG8_MMA(0, 0, At, B0); PG8_BAR; PG8_SCHED;
            PG8_LDB(B1, 1, 1); PG8_STAGE(PG8_SB(1, 0), b3, voffB);
            PG8_BAR; PG8_WAIT_L(0); PG8_MMA(0, 1, At, B1); PG8_BAR;
            PG8_LDA(At, 1, 1); PG8_STAGE(PG8_SA(1, 0), a3, voffA);
            PG8_BAR; PG8_WAIT_L(0); PG8_MMA(1, 0, At, B0); PG8_BAR; PG8_SCHED;
            PG8_STAGE(PG8_SB(1, 1), b3 + hstep, voffB);
            PG8_WAIT_V(6); PG8_BAR; PG8_MMA(1, 1, At, B1); PG8_BAR;
            }
        }
        if constexpr (ALIGN_EPI) { if (wr == 0) PG8_BAR; }
        if constexpr (!Epi::AFTER_DRAIN) { E(acc, cur, wr, wc, fr, fq); S.done(cur); }
        if (!has_next) break;
#pragma unroll
        for (int a = 0; a < 2; ++a)
#pragma unroll
            for (int b = 0; b < 2; ++b)
#pragma unroll
                for (int m = 0; m < 4; ++m)
#pragma unroll
                    for (int n = 0; n < 2; ++n) acc[a][b][m][n] = (f32x4){0.f, 0.f, 0.f, 0.f};
        cur = nxt; cA = nA; cB = nB; ++ui;
        if constexpr (ALIGN_EPI) { if (wr == 1) PG8_BAR; }
    }
    PG8_WAIT_V(0);
    if constexpr (!ALIGN_EPI) { if (wr == 0) PG8_BAR; }
    PG8_BAR;
    if constexpr (Epi::AFTER_DRAIN) { E.fused(acc, cur, wr, wc, fr, fq, lds, wid, lane); S.done(cur); }
#undef PG8_APTR
#undef PG8_BPTR
#undef PG8_SA
#undef PG8_SB
#undef PG8_STAGE
#undef PG8_LDA
#undef PG8_LDB
#undef PG8_MMA
#undef PG8_WAIT_V
#undef PG8_WAIT_L
#undef PG8_BAR
#undef PG8_SCHED
}
}
#ifndef PG8_SP2
#define PG8_SP2 true
#endif
#ifndef PG8_ALIGN
#define PG8_ALIGN true
#endif
constexpr int NWAVES = 8;
#ifndef MK_N_LAUNCHES
#define MK_N_LAUNCHES 1
#endif
constexpr int N_PHASES = 12;
constexpr int N_LAUNCHES = MK_N_LAUNCHES;

constexpr int BATCH = 2, SEQ = 8192, DM = 4096, M = BATCH * SEQ, HD = 128, DFF = 16384, TOPK = 256;
constexpr int C_AQ = 0, C_AK = 2048, C_AV = 2560, C_BQ = 3072, C_BK = 5120, C_BV = 7168, C_IQ = 9216, C_IK = 11264, C_IW = 11328, IN_COLS = 11360;
constexpr int NP_BF = 9216;
constexpr int NP_H = 2304;
constexpr float LN_EPS = 1e-5f;
constexpr float ALPHA = 1.189207115002721f;

constexpr size_t MiB = 1u << 20;
constexpr size_t WS_CTL = 0, CTL_ZERO_BYTES = 64 * 1024;
constexpr size_t WS_MOD = 2 * MiB;
constexpr size_t WS_XST = 2 * MiB + 512 * 1024;
constexpr size_t WS_SSQ = 3 * MiB;
constexpr size_t WS_SCL = 5 * MiB;
constexpr size_t WS_WIN_Q = 6 * MiB;
constexpr size_t WS_WIN_H = 42 * MiB;
constexpr size_t WS_WOUT_Q = 60 * MiB;
constexpr size_t WS_WUP_Q = 76 * MiB;
constexpr size_t WS_WDOWN = 140 * MiB;
constexpr size_t WS_UQ = 268 * MiB;
constexpr size_t WS_Q8 = 268 * MiB;
constexpr size_t WS_QS = 300 * MiB;
constexpr size_t WS_UH = 332 * MiB;
constexpr size_t WS_O = 460 * MiB;
constexpr size_t WS_ONQ = 588 * MiB;
constexpr size_t WS_U1Q = 652 * MiB;
constexpr size_t WS_PROJ = 716 * MiB;
constexpr size_t WS_IQ = 1004 * MiB;
constexpr size_t WS_IKWP = 1068 * MiB;
constexpr size_t WS_IKN = 1100 * MiB;
constexpr size_t WS_IWS = 1102 * MiB;
constexpr size_t WS_LIST = 1104 * MiB;
constexpr size_t WS_HID = 716 * MiB;
constexpr size_t WS_H0B = 1228 * MiB;
constexpr size_t WS_V1B = 1356 * MiB;
constexpr size_t WS_KQ8 = 1492 * MiB;
constexpr size_t WS_KS = 1500 * MiB;
constexpr size_t WS_VQ8 = 1501 * MiB;
constexpr size_t WS_VS = 1509 * MiB;
constexpr size_t WS_MODP = 1484 * MiB;
constexpr size_t WS_BQ = WS_V1B, WS_BK = WS_ONQ, WS_BV = WS_U1Q;
static_assert((long long)WS_BQ - (long long)WS_PROJ == pg8::EPI_BQ_OFF && (long long)WS_BK - (long long)WS_PROJ == pg8::EPI_BK_OFF && (long long)WS_BV - (long long)WS_PROJ == pg8::EPI_BV_OFF, "head-major buffer offsets");
constexpr size_t WS_END = 1510 * MiB;
constexpr int CW_TMO = 0, CW_CODE = 1, CW_BAR = 4096;
constexpr int NQ_COLS = NP_BF + DM + DFF + DM;
constexpr int CW_QHEAD = 2048;
static_assert((CW_BAR + 3456) * 4 <= (int)CTL_ZERO_BYTES && (CW_QHEAD + 64) * 4 <= CW_BAR * 4, "control words inside the memset region");

constexpr int RING_OFF = 0, RING_BYTES = 131072;
constexpr int LDSCTL_OFF = RING_BYTES, MISC_OFF = LDSCTL_OFF + 320;
constexpr int LDS_BYTES = 155648;
constexpr int TAIL_OFF = LDSCTL_OFF + 1024;

#define GAS __attribute__((address_space(1)))
#define LAS __attribute__((address_space(3)))
typedef unsigned short u16;
typedef unsigned v4u __attribute__((ext_vector_type(4)));
typedef unsigned v2u __attribute__((ext_vector_type(2)));
typedef float f32x4 __attribute__((ext_vector_type(4)));
typedef GAS unsigned gu32;
#define RLX_AGENT __ATOMIC_RELAXED, __HIP_MEMORY_SCOPE_AGENT
#define LDS_WAIT() asm volatile("s_waitcnt lgkmcnt(0)" ::: "memory")
#define VM_WAIT() asm volatile("s_waitcnt vmcnt(0)" ::: "memory")
__device__ __forceinline__ unsigned f2bf(float f) { unsigned u = __builtin_bit_cast(unsigned, f); return (u + 0x7fffu + ((u >> 16) & 1u)) >> 16; }
__device__ __forceinline__ unsigned pk2(float lo, float hi) { return pg8::cvt_pk_bf16(lo, hi); }
__device__ __forceinline__ unsigned pkh2(float lo, float hi) { return pg8::cvt_pk_f16(lo, hi); }
__device__ __forceinline__ float bflo(unsigned w) { return __builtin_bit_cast(float, w << 16); }
__device__ __forceinline__ float bfhi(unsigned w) { return __builtin_bit_cast(float, w & 0xffff0000u); }
__device__ __forceinline__ float hlo(unsigned w) { return (float)__builtin_bit_cast(pg8::f16x2, w).x; }
__device__ __forceinline__ float hhi(unsigned w) { return (float)__builtin_bit_cast(pg8::f16x2, w).y; }

#define XB_TMO      128
#define XB_XCNT(j)  (256  + 64 * (j))
#define XB_XSUB(j)  (1280 + 64 * (j))
#define XB_XGEN(j)  (2304 + 64 * (j))
#define XB_TOP      3328
#define XB_TOPGEN   3392
#define XCD_BAR_WORDS 3456
#define XB_SPIN_CAP (1u << 18)

__device__ __forceinline__ unsigned xb_ld(unsigned* p)              { return __hip_atomic_load(p, __ATOMIC_RELAXED, __HIP_MEMORY_SCOPE_AGENT); }
__device__ __forceinline__ unsigned xb_add(unsigned* p, unsigned v) { return __hip_atomic_fetch_add(p, v, __ATOMIC_RELAXED, __HIP_MEMORY_SCOPE_AGENT); }
__device__ __forceinline__ unsigned xb_xcc_id() { return (unsigned)__builtin_amdgcn_s_getreg((3 << 11) | 20) & 0xFu; }
#define XB_SPIN(cond, bar) do { unsigned _sp = 0; while (cond) { __builtin_amdgcn_s_sleep(1); \
    if ((++_sp & 255u) == 0u) { if (xb_ld(&(bar)[XB_TMO])) break; if (_sp > XB_SPIN_CAP) { atomicAdd(&(bar)[XB_TMO], 1u); break; } } } } while (0)

struct XcdBarrier {
    unsigned* bar; unsigned x;
    volatile LAS unsigned* st;
};

__device__ __forceinline__ XcdBarrier xcd_barrier_post(unsigned* bar, volatile LAS unsigned* st, bool t0  ) {
    XcdBarrier b; b.bar = bar; b.x = xb_xcc_id(); b.st = st;
    if (t0) (void)xb_add(&bar[XB_XCNT(b.x)], 1u);
    return b;
}
__device__ __forceinline__ void xcd_barrier_complete(unsigned* bar, unsigned x, unsigned& nloc, unsigned& nx) {
    const unsigned G = gridDim.x * gridDim.y * gridDim.z;
    unsigned sum, cnt, mine, sp = 0u;
    for (;;) {
        sum = 0u; cnt = 0u; mine = 0u;
#pragma unroll
        for (unsigned j = 0; j < 16; ++j) { const unsigned c = xb_ld(&bar[XB_XCNT(j)]); sum += c; cnt += (c > 0u) ? 1u : 0u; mine = (j == x) ? c : mine; }
        if (sum == G) break;
        __builtin_amdgcn_s_sleep(1);
        if ((++sp & 255u) == 0u) { if (xb_ld(&bar[XB_TMO])) break; if (sp > XB_SPIN_CAP) { atomicAdd(&bar[XB_TMO], 1u); break; } }
    }
    nloc = mine > 0u ? mine : 1u; nx = cnt > 0u ? cnt : 1u;
}

__device__ __forceinline__ void xcd_barrier(const XcdBarrier& b, bool t0  ) {
    asm volatile("s_waitcnt vmcnt(0)" ::: "memory");
    __syncthreads();
    if (t0) {
        unsigned* bar = b.bar;
        __builtin_amdgcn_s_waitcnt(0);
        unsigned nloc = b.st[0], nx = b.st[1];
        if (nloc == 0u) { xcd_barrier_complete(bar, b.x, nloc, nx); b.st[0] = nloc; b.st[1] = nx; }
        const unsigned old = xb_add(&bar[XB_XSUB(b.x)], 1u);
        const unsigned gen = old / nloc;
        if (old + 1u == (gen + 1u) * nloc) {
            __builtin_amdgcn_fence(__ATOMIC_RELEASE, "agent");
            asm volatile("s_waitcnt vmcnt(0)" ::: "memory");
            const unsigned og = xb_add(&bar[XB_TOP], 1u);
            const unsigned tg = og / nx;
            if (og + 1u == (tg + 1u) * nx) xb_add(&bar[XB_TOPGEN], 1u);
            else XB_SPIN(xb_ld(&bar[XB_TOPGEN]) == tg, bar);
            __builtin_amdgcn_fence(__ATOMIC_ACQUIRE, "agent");
            xb_add(&bar[XB_XGEN(b.x)], 1u);
            asm volatile("s_waitcnt vmcnt(0)" ::: "memory");
        } else {
            XB_SPIN(xb_ld(&bar[XB_XGEN(b.x)]) == gen, bar);
            __builtin_amdgcn_fence(__ATOMIC_ACQUIRE, "agent");
            asm volatile("s_waitcnt vmcnt(0)" ::: "memory");
        }
    }
    __syncthreads();
}
struct Args { const float* in[19]; float* out; unsigned char* ws; int ph_lo, ph_hi, li, pad; };
#define CAS __attribute__((address_space(4)))
__device__ __forceinline__ const unsigned char CAS* karg_base() { const unsigned char CAS* p = (const unsigned char CAS*)__builtin_amdgcn_kernarg_segment_ptr(); asm volatile("" : "+s"(p)); return p; }
__device__ __forceinline__ const float* karg_in(int k) { return ((const float* const CAS*)karg_base())[k]; }
__device__ __forceinline__ float* karg_out() { return ((float* const CAS*)karg_base())[19]; }
struct Frame {
    LAS unsigned char* lds;
    volatile LAS unsigned* MISC;
    gu32* ctl;
    int tid, lane, wave;
    int vcu, G;
    __device__ __forceinline__ const float* x() const { return karg_in(0); }
    __device__ __forceinline__ const float* c() const { return karg_in(1); }
    __device__ __forceinline__ const float* in_g() const { return karg_in(2); }
    __device__ __forceinline__ const float* in_b() const { return karg_in(3); }
    __device__ __forceinline__ const float* relb() const { return karg_in(4); }
    __device__ __forceinline__ const float* w_ada() const { return karg_in(5); }
    __device__ __forceinline__ const float* b_ada() const { return karg_in(6); }
    __device__ __forceinline__ const float* w_in() const { return karg_in(7); }
    __device__ __forceinline__ const float* kn_g() const { return karg_in(8); }
    __device__ __forceinline__ const float* kn_b() const { return karg_in(9); }
    __device__ __forceinline__ const float* gn_a() const { return karg_in(10); }
    __device__ __forceinline__ const float* gn_b() const { return karg_in(11); }
    __device__ __forceinline__ const float* w_out() const { return karg_in(12); }
    __device__ __forceinline__ const float* ln1_g() const { return karg_in(13); }
    __device__ __forceinline__ const float* ln1_b() const { return karg_in(14); }
    __device__ __forceinline__ const float* w_up() const { return karg_in(15); }
    __device__ __forceinline__ const float* w_down() const { return karg_in(16); }
    __device__ __forceinline__ const float* ln2_g() const { return karg_in(17); }
    __device__ __forceinline__ const float* ln2_b() const { return karg_in(18); }
    __device__ __forceinline__ float* out() const { return karg_out(); }
    unsigned char* ws;
    __device__ __forceinline__ float* MOD() const { return (float*)(ws + WS_MOD); }
    __device__ __forceinline__ float* XST() const { return (float*)(ws + WS_XST); }
    __device__ __forceinline__ float* SSQ() const { return (float*)(ws + WS_SSQ); }
    __device__ __forceinline__ float* IKWP() const { return (float*)(ws + WS_IKWP); }
    __device__ __forceinline__ float* IWS() const { return (float*)(ws + WS_IWS); }
    __device__ __forceinline__ float* SA_U() const { return (float*)(ws + WS_SCL); }
    __device__ __forceinline__ float* SA_ON() const { return (float*)(ws + WS_SCL + (size_t)M * 4); }
    __device__ __forceinline__ float* SA_U1() const { return (float*)(ws + WS_SCL + (size_t)M * 8); }
    __device__ __forceinline__ float* ST1() const { return (float*)(ws + WS_SCL + (size_t)M * 12); }
    __device__ __forceinline__ float* SW() const { return (float*)(ws + WS_SCL + (size_t)M * 20); }
    __device__ __forceinline__ u16* WIN_H() const { return (u16*)(ws + WS_WIN_H); }
    __device__ __forceinline__ unsigned char* WDOWN8() const { return (unsigned char*)(ws + WS_WDOWN); }
    __device__ __forceinline__ u16* UH() const { return (u16*)(ws + WS_UH); }
    __device__ __forceinline__ u16* O() const { return (u16*)(ws + WS_O); }
    __device__ __forceinline__ u16* PROJ() const { return (u16*)(ws + WS_PROJ); }
    __device__ __forceinline__ u16* IQ() const { return (u16*)(ws + WS_IQ); }
    __device__ __forceinline__ u16* IKN() const { return (u16*)(ws + WS_IKN); }
    __device__ __forceinline__ unsigned char* HID8() const { return (unsigned char*)(ws + WS_HID); }
    __device__ __forceinline__ unsigned char* WIN_Q() const { return (unsigned char*)(ws + WS_WIN_Q); }
    __device__ __forceinline__ unsigned char* WOUT_Q() const { return (unsigned char*)(ws + WS_WOUT_Q); }
    __device__ __forceinline__ unsigned char* WUP_Q() const { return (unsigned char*)(ws + WS_WUP_Q); }
    __device__ __forceinline__ unsigned char* UQ() const { return (unsigned char*)(ws + WS_UQ); }
    __device__ __forceinline__ unsigned char* Q8() const { return (unsigned char*)(ws + WS_Q8); }
    __device__ __forceinline__ float* QS() const { return (float*)(ws + WS_QS); }
    __device__ __forceinline__ u16* BQ() const { return (u16*)(ws + WS_BQ); }
    __device__ __forceinline__ u16* BK() const { return (u16*)(ws + WS_BK); }
    __device__ __forceinline__ u16* BV() const { return (u16*)(ws + WS_BV); }
    __device__ __forceinline__ unsigned char* ONQ() const { return (unsigned char*)(ws + WS_ONQ); }
    __device__ __forceinline__ unsigned char* U1Q() const { return (unsigned char*)(ws + WS_U1Q); }
    __device__ __forceinline__ unsigned char* KQ8() const { return (unsigned char*)(ws + WS_KQ8); }
    __device__ __forceinline__ u16* KS() const { return (u16*)(ws + WS_KS); }
    __device__ __forceinline__ unsigned char* VQ8() const { return (unsigned char*)(ws + WS_VQ8); }
    __device__ __forceinline__ u16* VS() const { return (u16*)(ws + WS_VS); }
    __device__ __forceinline__ float* MODP() const { return (float*)(ws + WS_MODP); }
    __device__ __forceinline__ u16* H0B() const { return (u16*)(ws + WS_H0B); }
    __device__ __forceinline__ u16* V1B() const { return (u16*)(ws + WS_V1B); }
    __device__ __forceinline__ unsigned* LIST() const { return (unsigned*)(ws + WS_LIST); }
};

__device__ __forceinline__ int lane_now() { unsigned ones = ~0u; asm volatile("" : "+v"(ones)); return (int)__builtin_amdgcn_mbcnt_hi(ones, __builtin_amdgcn_mbcnt_lo(ones, 0u)); }
__device__ __forceinline__ void rethread(Frame& F) { F.lane = lane_now(); F.tid = F.wave * 64 + F.lane; }
template <int K> __device__ __forceinline__ float xshf(float v) {
    if constexpr (K == 32) { auto r = __builtin_amdgcn_permlane32_swap(__float_as_uint(v), __float_as_uint(v), false, false); const unsigned a = r[0], b = r[1];
        return __uint_as_float(a ^ b ^ __float_as_uint(v)); }
    else return __int_as_float(__builtin_amdgcn_ds_swizzle(__float_as_int(v), (K << 10) | 0x1f));
}
__device__ __forceinline__ float wave_sum(float v) {
    v += xshf<1>(v); v += xshf<2>(v); v += xshf<4>(v); v += xshf<8>(v); v += xshf<16>(v); v += xshf<32>(v);
    return v;
}
__device__ __forceinline__ float wave_max(float v) {
    v = fmaxf(v, xshf<1>(v)); v = fmaxf(v, xshf<2>(v)); v = fmaxf(v, xshf<4>(v)); v = fmaxf(v, xshf<8>(v)); v = fmaxf(v, xshf<16>(v)); v = fmaxf(v, xshf<32>(v));
    return v;
}
__device__ __forceinline__ unsigned q4(const f32x4 v, float inv) {
    const int a = __float2int_rn(v.x * inv), b = __float2int_rn(v.y * inv), c = __float2int_rn(v.z * inv), d = __float2int_rn(v.w * inv);
    return (unsigned)(a & 255) | ((unsigned)(b & 255) << 8) | ((unsigned)(c & 255) << 16) | ((unsigned)d << 24);
}
__device__ __forceinline__ float amax4(const f32x4 v) { return fmaxf(fmaxf(fabsf(v.x), fabsf(v.y)), fmaxf(fabsf(v.z), fabsf(v.w))); }
__device__ __forceinline__ unsigned wave_max_u(unsigned v) {
    unsigned t;
    t = __float_as_uint(xshf<1>(__uint_as_float(v))); v = t > v ? t : v; t = __float_as_uint(xshf<2>(__uint_as_float(v))); v = t > v ? t : v; t = __float_as_uint(xshf<4>(__uint_as_float(v))); v = t > v ? t : v;
    t = __float_as_uint(xshf<8>(__uint_as_float(v))); v = t > v ? t : v; t = __float_as_uint(xshf<16>(__uint_as_float(v))); v = t > v ? t : v; t = __float_as_uint(xshf<32>(__uint_as_float(v))); v = t > v ? t : v;
    return v;
}
__device__ __forceinline__ int wave_sum_i(int v) {
    v += __float_as_int(xshf<1>(__int_as_float(v))); v += __float_as_int(xshf<2>(__int_as_float(v))); v += __float_as_int(xshf<4>(__int_as_float(v))); v += __float_as_int(xshf<8>(__int_as_float(v))); v += __float_as_int(xshf<16>(__int_as_float(v))); v += __float_as_int(xshf<32>(__int_as_float(v)));
    return v;
}
__device__ __forceinline__ unsigned t5_bucket(int n) {
    if (n < 16) return (unsigned)n;
    const float nf = (float)n;
    int large = 16 + (int)(logf(nf / 16.0f) / 2.0794415416798357f * 16.0f);
    return (unsigned)(large < 31 ? large : 31);
}

__device__ __forceinline__ f32x4 ldp(const float* base, unsigned lane_bytes, int const_floats) { return *(const f32x4*)((const char*)(base + const_floats) + lane_bytes); }
__device__ __forceinline__ f32x4 ldl(LAS float* base, unsigned lane_bytes, int const_floats) { return *(const LAS f32x4*)((const LAS char*)(base + const_floats) + lane_bytes); }
__device__ __forceinline__ void lds_fill(LAS float* dst, const float* src, int nfloats, int tid) {
    for (int i = 4 * tid; i < nfloats; i += 4 * NWAVES * 64) *(LAS f32x4*)(dst + i) = *(const GAS f32x4*)(src + i);
}
__device__ __forceinline__ void p0_transpose_item(const float* W, int K, int ldw, int k0, int n0, u16* WT, int drow, bool f16, LAS float* scr, int lane) {
#pragma unroll 8
    for (int i = 0; i < 32; ++i) { const int kk = 2 * i + (lane >> 5); scr[kk * 33 + (lane & 31)] = W[(size_t)(k0 + kk) * ldw + n0 + (lane & 31)]; }
    LDS_WAIT(); asm volatile("" ::: "memory");
    const int c = lane & 7;
#pragma unroll
    for (int j = 0; j < 4; ++j) { const int n = (lane >> 3) + 8 * j; const LAS float* s = scr + (8 * c) * 33 + n;
        v4u o;
        if (f16) { o.x = pkh2(s[0 * 33], s[1 * 33]); o.y = pkh2(s[2 * 33], s[3 * 33]); o.z = pkh2(s[4 * 33], s[5 * 33]); o.w = pkh2(s[6 * 33], s[7 * 33]); }
        else     { o.x = pk2(s[0 * 33], s[1 * 33]);  o.y = pk2(s[2 * 33], s[3 * 33]);  o.z = pk2(s[4 * 33], s[5 * 33]);  o.w = pk2(s[6 * 33], s[7 * 33]); }
        *(GAS v4u*)(WT + (size_t)(drow + n) * K + k0 + 8 * c) = o; }
    LDS_WAIT(); asm volatile("" ::: "memory");
}
__device__ __forceinline__ void p0_absmax_item(const float* W, int ldw, int k0, int n0, unsigned* colmax, int lane) {
    float mx = 0.f;
    const float* wp = W + (size_t)(k0 + (lane >> 5)) * ldw + n0 + (lane & 31);
#pragma unroll 1
    for (int i = 0; i < 128; i += 8) {
        float t[8];
#pragma unroll
        for (int j = 0; j < 8; ++j) t[j] = wp[(size_t)(2 * j) * ldw];
#pragma unroll
        for (int j = 0; j < 8; ++j) mx = fmaxf(mx, fabsf(t[j]));
        wp += (size_t)16 * ldw; }
    mx = fmaxf(mx, xshf<32>(mx));
    if (lane < 32) atomicMax(colmax + lane, __float_as_uint(mx));
}
__device__ __forceinline__ unsigned f8x4(const f32x4 v, float inv) {
    int w = 0; w = __builtin_amdgcn_cvt_pk_fp8_f32(v.x * inv, v.y * inv, w, false); w = __builtin_amdgcn_cvt_pk_fp8_f32(v.z * inv, v.w * inv, w, true); return (unsigned)w;
}
template <bool FP8> __device__ __forceinline__ void p1_quant_item(const float* W, int K, int ldw, int k0, int n0, unsigned char* WT, const float am  , float* sw, LAS float* scr, int lane) {
    constexpr float QMAX = FP8 ? 224.0f : 127.0f;
#pragma unroll 16
    for (int i = 0; i < 32; ++i) { const int kk = 2 * i + (lane >> 5); scr[kk * 33 + (lane & 31)] = W[(size_t)(k0 + kk) * ldw + n0 + (lane & 31)]; }
    LDS_WAIT(); asm volatile("" ::: "memory");
    const int n = lane >> 1, hf = lane & 1;
    const float inv = am > 0.f ? QMAX / am : 0.f;
    if (k0 == 0 && hf == 0) sw[n] = am * (1.0f / QMAX);
    const LAS float* sp = scr + (32 * hf) * 33 + n;
    v4u o0, o1;
#pragma unroll
    for (int j = 0; j < 4; ++j) { const f32x4 a = {sp[(4 * j) * 33], sp[(4 * j + 1) * 33], sp[(4 * j + 2) * 33], sp[(4 * j + 3) * 33]}; o0[j] = FP8 ? f8x4(a, inv) : q4(a, inv);
        const f32x4 b = {sp[(16 + 4 * j) * 33], sp[(16 + 4 * j + 1) * 33], sp[(16 + 4 * j + 2) * 33], sp[(16 + 4 * j + 3) * 33]}; o1[j] = FP8 ? f8x4(b, inv) : q4(b, inv); }
    GAS v4u* dst = (GAS v4u*)(WT + (size_t)(n0 + n) * K + k0 + 32 * hf);
    dst[0] = o0; dst[1] = o1;
    LDS_WAIT(); asm volatile("" ::: "memory");
}
__device__ __forceinline__ void p0_prologue(Frame& F0) {
    Frame F = F0; rethread(F);
    const float* const c_p = F.c();
    const float* const w_ada_p = F.w_ada();
    const float* const b_ada_p = F.b_ada();
    const float* const w_in_p = F.w_in();
    const float* const w_out_p = F.w_out();
    const float* const w_up_p = F.w_up();
    const float* const w_down_p = F.w_down();
#ifndef PROBE_SUB
#define PROBE_SUB 0
#endif
    for (int ps_ = 0; ps_ < (PROBE_SUB == 1 ? 2 : 1); ++ps_)
    {
        LAS float* cs = (LAS float*)(F.lds + RING_OFF);
        for (int i = F.tid; i < 2 * DM; i += NWAVES * 64) { const float v = c_p[i]; cs[i] = v / (1.0f + __expf(-v)); }
        __syncthreads();
        for (int it = blockIdx.x; it < 256; it += F.G) {
            const int kg = it >> 3, cp = it & 7;
            if (F.tid < 384) {
                const float* wp = w_ada_p + (size_t)(128 * kg) * (6 * DM) + 3072 * cp + 4 * F.tid;
                f32x4 a0 = {0.f, 0.f, 0.f, 0.f}, a1 = a0, b0 = a0, b1 = a0;
#pragma unroll 8
                for (int k = 0; k < 128; ++k) { const f32x4 wa = *(const GAS f32x4*)(wp + (size_t)k * (6 * DM)), wb = *(const GAS f32x4*)(wp + (size_t)k * (6 * DM) + 1536);
                    const float s0 = cs[128 * kg + k], s1 = cs[DM + 128 * kg + k]; a0 += wa * s0; a1 += wa * s1; b0 += wb * s0; b1 += wb * s1; }
                float* pp = F.MODP() + (size_t)kg * (2 * 6 * DM) + 3072 * cp + 4 * F.tid;
                *(f32x4*)(pp) = a0; *(f32x4*)(pp + 1536) = b0; *(f32x4*)(pp + 6 * DM) = a1; *(f32x4*)(pp + 6 * DM + 1536) = b1;
            }
        }
        __syncthreads();
    }
    for (int ps2_ = 0; ps2_ < (PROBE_SUB == 2 ? 2 : 1); ++ps2_)
    {
        LAS float* scr = (LAS float*)(F.lds + RING_OFF + F.wave * 16384);
        const int gw = F.vcu * NWAVES + F.wave, NGW = F.G * NWAVES;
        constexpr int NB_H = (IN_COLS - NP_BF) / 32;
        constexpr int I_H = (DM / 64) * NB_H;
        for (int it = gw; it < I_H; it += NGW) { const int kb = it / NB_H, nb = it % NB_H; p0_transpose_item(w_in_p, DM, IN_COLS, 64 * kb, NP_BF + 32 * nb, F.WIN_H(), 32 * nb, true, scr, F.lane); }
        { constexpr int R0 = IN_COLS - NP_BF; GAS v4u* z = (GAS v4u*)(F.WIN_H() + (size_t)R0 * DM); const size_t n16 = (size_t)(NP_H - R0) * DM * 2 / 16;
          for (size_t i = (size_t)gw * 64 + F.lane; i < n16; i += (size_t)NGW * 64) z[i] = (v4u){0u, 0u, 0u, 0u}; }
    }
    {
        LAS float* scr = (LAS float*)(F.lds + RING_OFF + F.wave * 16384);
        LAS float* cmx = (LAS float*)(F.lds + RING_OFF + 12288);
        volatile LAS int* qslot = (volatile LAS int*)(cmx + 256);
        constexpr int S_DN = DM / 32, S_UP = DFF / 32, S_IN = NP_BF / 32, S_OUT = DM / 32, NSTRIPS = S_DN + S_UP + S_IN + S_OUT;
        unsigned* qhead = (unsigned*)F.ctl + CW_QHEAD;
        for (;;) {
            __syncthreads();
            if (F.tid == 0) *qslot = (int)atomicAdd(qhead, 1u);
            __syncthreads();
            int r = *qslot; if (r >= NSTRIPS) break;
            const float* W; int K, ldw, n0; unsigned char* WT; float* sw; bool fp8 = false;
            if (r < S_DN) { W = w_down_p; K = DFF; ldw = DM; n0 = 32 * r; WT = F.WDOWN8(); sw = F.SW() + NP_BF + DM + DFF; fp8 = true; }
            else if ((r -= S_DN) < S_UP) { W = w_up_p; K = DM; ldw = DFF; n0 = 32 * r; WT = F.WUP_Q(); sw = F.SW() + NP_BF + DM; }
            else if ((r -= S_UP) < S_IN) { W = w_in_p; K = DM; ldw = IN_COLS; n0 = 32 * r; WT = F.WIN_Q(); sw = F.SW(); }
            else { r -= S_IN; W = w_out_p; K = DM; ldw = DM; n0 = 32 * r; WT = F.WOUT_Q(); sw = F.SW() + NP_BF; }
            const int ntile = K / 64;
            float mx = 0.f;
            for (int kb = F.wave; kb < ntile; kb += NWAVES) {
                const float* wp = W + (size_t)(64 * kb + (F.lane >> 5)) * ldw + n0 + (F.lane & 31);
#pragma unroll 1
                for (int i = 0; i < 32; i += 16) { float t[16];
#pragma unroll
                    for (int q = 0; q < 16; ++q) t[q] = wp[(size_t)(2 * q) * ldw];
#pragma unroll
                    for (int q = 0; q < 16; ++q) mx = fmaxf(mx, fabsf(t[q]));
                    wp += (size_t)32 * ldw; } }
            mx = fmaxf(mx, xshf<32>(mx));
            if (F.lane < 32) cmx[F.wave * 32 + F.lane] = mx;
            __syncthreads();
            float am = 0.f;
#pragma unroll
            for (int w = 0; w < NWAVES; ++w) am = fmaxf(am, cmx[w * 32 + (F.lane >> 1)]);
            for (int kb = ntile - NWAVES + F.wave; kb >= 0; kb -= NWAVES) {
                if (fp8) p1_quant_item<true>(W, K, ldw, 64 * kb, n0, WT, am, sw + n0, scr, F.lane);
                else p1_quant_item<false>(W, K, ldw, 64 * kb, n0, WT, am, sw + n0, scr, F.lane);
            }
        }
    }
}
__device__ __forceinline__ void p1a_modsum(Frame& F0) {
    Frame F = F0; rethread(F);
    const float* const b_ada_p = F.b_ada();
    const int gt = (F.vcu * NWAVES + F.wave) * 64 + F.lane, NGT = F.G * NWAVES * 64;
    for (int i = gt; i < 2 * 6 * DM; i += NGT) { float s = b_ada_p[i % (6 * DM)];
#pragma unroll 8
        for (int g = 0; g < 32; ++g) s += F.MODP()[(size_t)g * (2 * 6 * DM) + i];
        F.MOD()[i] = s; }
}
__device__ __forceinline__ void p1_rows(Frame& F0) {
    Frame F = F0; rethread(F);
    const float* const x_p = F.x();
    const float* const in_g_p = F.in_g();
    const float* const in_b_p = F.in_b();
    const int gw = F.vcu * NWAVES + F.wave, NGW = F.G * NWAVES;
    LAS float* pl = (LAS float*)(F.lds + RING_OFF);
    lds_fill(pl, in_g_p, DM, F.tid); lds_fill(pl + DM, in_b_p, DM, F.tid);
    lds_fill(pl + 2 * DM, F.MOD(), 2 * DM, F.tid); lds_fill(pl + 4 * DM, F.MOD() + 6 * DM, 2 * DM, F.tid);
    __syncthreads();
    for (int m = gw; m < M; m += NGW) {
        const GAS f32x4* xr = (const GAS f32x4*)(x_p + (size_t)m * DM) + F.lane;
        f32x4 v[16]; float s = 0.f;
#pragma unroll
        for (int j = 0; j < 16; ++j) { v[j] = xr[64 * j]; s += (v[j].x + v[j].y) + (v[j].z + v[j].w); }
        const float mean = wave_sum(s) * (1.f / DM); float s2 = 0.f;
#pragma unroll
        for (int j = 0; j < 16; ++j) { v[j] = v[j] - mean; s2 += (v[j].x * v[j].x + v[j].y * v[j].y) + (v[j].z * v[j].z + v[j].w * v[j].w); }
        const float rstd = 1.f / sqrtf(wave_sum(s2) * (1.f / DM) + LN_EPS);
        if (F.lane == 0) { F.XST()[2 * m] = mean; F.XST()[2 * m + 1] = rstd; }
        LAS float* mod = pl + 2 * DM + (m / SEQ) * (2 * DM);
        GAS v2u* oh = (GAS v2u*)(F.UH() + (size_t)m * DM) + F.lane; GAS v2u* o0 = (GAS v2u*)(F.H0B() + (size_t)m * DM) + F.lane;
        float am = 0.f;
#pragma unroll
        for (int j = 0; j < 16; ++j) { if ((j & 3) == 0) asm volatile("" ::: "memory");
            const unsigned lb = 16u * (unsigned)F.lane; const int cj = 256 * j;
            const f32x4 g = ldl(pl, lb, cj), bb = ldl(pl, lb, DM + cj), sh = ldl(mod, lb, cj), sc = ldl(mod, lb, DM + cj);
            const f32x4 h0 = v[j] * rstd * g + bb; const f32x4 u = h0 * (sc + 1.0f) + sh; v[j] = u; am = fmaxf(am, amax4(u));
            v2u wh; wh.x = pkh2(u.x, u.y); wh.y = pkh2(u.z, u.w); oh[64 * j] = wh;
            v2u w0; w0.x = pk2(h0.x, h0.y); w0.y = pk2(h0.z, h0.w); o0[64 * j] = w0; }
        am = wave_max(am); const float inv = am > 0.f ? 127.0f / am : 0.f;
        if (F.lane == 0) F.SA_U()[m] = am * (1.0f / 127.0f);
        GAS unsigned* oq = (GAS unsigned*)(F.UQ() + (size_t)m * DM) + F.lane;
#pragma unroll
        for (int j = 0; j < 16; ++j) oq[64 * j] = q4(v[j], inv);
    }
}
__device__ __forceinline__ void p3_kq8(Frame& F0) {
    Frame F = F0; rethread(F);
    const int gw = F.vcu * NWAVES + F.wave, NGW = F.G * NWAVES;
#define KQ8_LOAD(wv, mm) do { const u16* pr_ = F.PROJ() + (size_t)(mm) * NP_BF + 8 * F.lane; wv[0] = *(const GAS v4u*)(pr_ + C_AK); wv[1] = *(const GAS v4u*)(pr_ + C_AV); \
        _Pragma("unroll") for (int j_ = 0; j_ < 4; ++j_) wv[2 + j_] = *(const GAS v4u*)(pr_ + C_AQ + 512 * j_); } while (0)
    v4u nw[6];
    if (gw < M) KQ8_LOAD(nw, gw);
    for (int m = gw; m < M; m += NGW) {
        v4u cw[6];
#pragma unroll
        for (int i = 0; i < 6; ++i) cw[i] = nw[i];
        if (m + NGW < M) KQ8_LOAD(nw, m + NGW);
#pragma unroll
        for (int i = 0; i < 6; ++i) {
            const v4u w = cw[i];
            const f32x4 a = {bflo(w.x), bfhi(w.x), bflo(w.y), bfhi(w.y)}, c = {bflo(w.z), bfhi(w.z), bflo(w.w), bfhi(w.w)};
            float am = fmaxf(amax4(a), amax4(c));
            am = fmaxf(am, xshf<1>(am)); am = fmaxf(am, xshf<2>(am)); am = fmaxf(am, xshf<4>(am)); am = fmaxf(am, xshf<8>(am));
            const float inv = am > 0.f ? 127.0f / am : 0.f;
            v2u o; o.x = q4(a, inv); o.y = q4(c, inv);
            if (i < 2) { *(GAS v2u*)((i == 0 ? F.KQ8() : F.VQ8()) + (size_t)m * 512 + 8 * F.lane) = o;
                if ((F.lane & 15) == 0) (i == 0 ? F.KS() : F.VS())[(size_t)((m / SEQ) * 4 + (F.lane >> 4)) * SEQ + (m % SEQ)] = (u16)pkh2(am * (1.0f / 127.0f), 0.f); }
            else { *(GAS v2u*)(F.Q8() + (size_t)m * 2048 + 512 * (i - 2) + 8 * F.lane) = o;
                if ((F.lane & 15) == 0) F.QS()[(size_t)m * 16 + 4 * (i - 2) + (F.lane >> 4)] = am * (1.0f / 127.0f); }
        }
    }
#undef KQ8_LOAD
}
__device__ __forceinline__ void p3_ikn(Frame& F0) {
    Frame F = F0; rethread(F);
    const float* const kn_g_p = F.kn_g();
    const float* const kn_b_p = F.kn_b();
    const int gw = F.vcu * NWAVES + F.wave, NGW = F.G * NWAVES, sub = F.lane & 15;
    const size_t qs = (size_t)M * 128 / 4;
    for (int m4 = gw; m4 < M / 4; m4 += NGW) {
        const int m = 4 * m4 + (F.lane >> 4);
        const GAS f32x4* r0 = (const GAS f32x4*)(F.IKWP() + (size_t)m * 128);
        f32x4 v = r0[sub], wv = r0[16 + (sub & 7)];
#pragma unroll
        for (int q = 1; q < 4; ++q) { v += r0[(size_t)q * qs + sub]; wv += r0[(size_t)q * qs + 16 + (sub & 7)]; }
        float s = (v.x + v.y) + (v.z + v.w);
        s += xshf<1>(s); s += xshf<2>(s); s += xshf<4>(s); s += xshf<8>(s);
        const float mean = s * (1.f / 64.f); v = v - mean;
        float s2 = (v.x * v.x + v.y * v.y) + (v.z * v.z + v.w * v.w);
        s2 += xshf<1>(s2); s2 += xshf<2>(s2); s2 += xshf<4>(s2); s2 += xshf<8>(s2);
        const float rstd = 1.f / sqrtf(s2 * (1.f / 64.f) + LN_EPS);
        const f32x4 g = *(const f32x4*)(kn_g_p + 4 * sub), bb = *(const f32x4*)(kn_b_p + 4 * sub); const f32x4 y = v * rstd * g + bb;
        v2u w; w.x = pkh2(y.x, y.y); w.y = pkh2(y.z, y.w); *(GAS v2u*)(F.IKN() + (size_t)m * 64 + 4 * sub) = w;
        if (sub < 8) *(GAS f32x4*)(F.IWS() + (size_t)m * 32 + 4 * sub) = wv;
    }
}
constexpr float SB_EXIT = -40.0f * 1.4426950408889634f;
typedef short bf8v __attribute__((ext_vector_type(8)));
typedef float f32x16 __attribute__((ext_vector_type(16)));
template <int O1, int O2> __device__ __forceinline__ void tr_read2(v2u& a, v2u& b, unsigned addr) {
    asm volatile("ds_read_b64_tr_b16 %0, %2 offset:%3\n\tds_read_b64_tr_b16 %1, %2 offset:%4" : "=&v"(a), "=&v"(b) : "v"(addr), "i"(O1), "i"(O2) : "memory");
}
constexpr int SB_VST = 320;
constexpr int SB_WAVE_LDS = 32 * SB_VST;
__device__ __forceinline__ void sb_fast(Frame& F0) {
    Frame F = F0; rethread(F);
    LAS unsigned char* vimg = F.lds + RING_OFF + F.wave * SB_WAVE_LDS;
    const int lane = F.lane, c = lane & 31, hi = lane >> 5;
    const unsigned tr_base = (unsigned)(size_t)vimg + (unsigned)((4 * hi + ((lane & 15) >> 2)) * SB_VST + (16 * ((lane >> 4) & 1) + 4 * (lane & 3)) * 2);
    const int gw = F.vcu * NWAVES + F.wave, NGW = F.G * NWAVES;
    for (int task = gw; task < BATCH * 16 * (SEQ / 32); task += NGW) {
        const int qt = task % (SEQ / 32), bh = task / (SEQ / 32), h = bh & 15, b = bh >> 4;
        const int q0 = 32 * qt;
        const size_t hoff = (size_t)(b * 16 + h) * SEQ * HD;
        const u16* const qb = F.BQ() + hoff; const u16* const kb = F.BK() + hoff; const u16* const vb = F.BV() + hoff;
        bf8v qf[8];
        { const u16* qp = qb + (size_t)(q0 + c) * HD + 8 * hi;
#pragma unroll
          for (int st = 0; st < 8; ++st) qf[st] = __builtin_bit_cast(bf8v, *(const v4u*)(qp + 16 * st)); }
        f32x16 oacc[4];
#pragma unroll
        for (int dt = 0; dt < 4; ++dt)
#pragma unroll
            for (int r = 0; r < 16; ++r) oacc[dt][r] = 0.f;
        float carry = 0.f;
        v4u kf[8];
        { const u16* kp = kb + (size_t)(q0 + c) * HD + 8 * hi;
#pragma unroll
          for (int st = 0; st < 8; ++st) kf[st] = *(const v4u*)(kp + 16 * st); }
        for (int k0 = q0; k0 >= 0; k0 -= 32) {
            f32x16 acc;
#pragma unroll
            for (int r = 0; r < 16; ++r) acc[r] = 0.f;
#pragma unroll
            for (int st = 0; st < 8; ++st) acc = __builtin_amdgcn_mfma_f32_32x32x16_bf16(__builtin_bit_cast(bf8v, kf[st]), qf[st], acc, 0, 0, 0);
            __builtin_amdgcn_sched_barrier(0);
            if (k0 >= 32) { const u16* kp = kb + (size_t)(k0 - 32 + c) * HD + 8 * hi;
#pragma unroll
                for (int st = 0; st < 8; ++st) kf[st] = *(const v4u*)(kp + 16 * st); }
            __builtin_amdgcn_sched_barrier(0);
            { v4u vr[8];
              const u16* vp = vb + (size_t)(k0 + (lane >> 4)) * HD + 8 * (lane & 15);
#pragma unroll
              for (int i = 0; i < 8; ++i) vr[i] = *(const v4u*)(vp + (size_t)(4 * i) * HD);
#pragma unroll
              for (int i = 0; i < 8; ++i) *(LAS v4u*)(vimg + (4 * i + (lane >> 4)) * SB_VST + (lane & 15) * 16) = vr[i]; }
            float lk[16], lb[16]; float tot = 0.f;
#pragma unroll
            for (int r = 0; r < 16; ++r) { const int kap = 8 * (r >> 2) + 4 * hi + (r & 3);
                const float z = acc[r] * (0.08838834764831845f * 1.4426950408889634f);
                const float sp = fmaxf(z, 0.f) + __builtin_amdgcn_logf(1.0f + __builtin_amdgcn_exp2f(-fabsf(z)));
                const bool valid = (k0 + kap) < (q0 + c);
                lk[r] = valid ? -sp : 0.f; lb[r] = valid ? (z - sp) : -INFINITY; tot += lk[r]; }
            tot += xshf<32>(tot);
            bf8v tm[2];
            { int cc = c; asm volatile("" : "+v"(cc));
#pragma unroll
              for (int j = 0; j < 2; ++j) { v4u w;
#pragma unroll
                for (int i2 = 0; i2 < 4; ++i2) { const int ia = 2 * i2, ib = 2 * i2 + 1; const int ka = 16 * j + 8 * (ia >> 2) + 4 * hi + (ia & 3), kb = 16 * j + 8 * (ib >> 2) + 4 * hi + (ib & 3);
                    w[i2] = (ka > cc ? 0x3f80u : 0u) | (kb > cc ? 0x3f800000u : 0u); }
                tm[j] = __builtin_bit_cast(bf8v, w); } }
            f32x16 lat;
#pragma unroll
            for (int r = 0; r < 16; ++r) lat[r] = 0.f;
#pragma unroll
            for (int j = 0; j < 2; ++j) { v4u whi, wlo;
#pragma unroll
                for (int i2 = 0; i2 < 4; ++i2) { const float x0 = lk[8 * j + 2 * i2], x1 = lk[8 * j + 2 * i2 + 1];
                    const unsigned ph = pg8::cvt_pk_bf16(x0, x1); whi[i2] = ph;
                    wlo[i2] = pg8::cvt_pk_bf16(x0 - bflo(ph), x1 - bfhi(ph)); }
                lat = __builtin_amdgcn_mfma_f32_32x32x16_bf16(tm[j], __builtin_bit_cast(bf8v, whi), lat, 0, 0, 0);
                lat = __builtin_amdgcn_mfma_f32_32x32x16_bf16(tm[j], __builtin_bit_cast(bf8v, wlo), lat, 0, 0, 0); }
            v4u pw[2];
#pragma unroll
            for (int j = 0; j < 2; ++j)
#pragma unroll
                for (int i2 = 0; i2 < 4; ++i2) { const int ra = 8 * j + 2 * i2;
                    const float pa = __builtin_amdgcn_exp2f(lb[ra] + lat[ra] + carry), pb = __builtin_amdgcn_exp2f(lb[ra + 1] + lat[ra + 1] + carry);
                    pw[j][i2] = pg8::cvt_pk_bf16(pa, pb); }
            carry += tot;
#pragma unroll
            for (int j = 0; j < 2; ++j) {
                v2u fa[4], fb[4];
                if (j == 0) { tr_read2<0, 8 * SB_VST>(fa[0], fb[0], tr_base); tr_read2<64, 8 * SB_VST + 64>(fa[1], fb[1], tr_base);
                              tr_read2<128, 8 * SB_VST + 128>(fa[2], fb[2], tr_base); tr_read2<192, 8 * SB_VST + 192>(fa[3], fb[3], tr_base); }
                else { tr_read2<16 * SB_VST, 24 * SB_VST>(fa[0], fb[0], tr_base); tr_read2<16 * SB_VST + 64, 24 * SB_VST + 64>(fa[1], fb[1], tr_base);
                       tr_read2<16 * SB_VST + 128, 24 * SB_VST + 128>(fa[2], fb[2], tr_base); tr_read2<16 * SB_VST + 192, 24 * SB_VST + 192>(fa[3], fb[3], tr_base); }
                asm volatile("s_waitcnt lgkmcnt(0)" : "+v"(fa[0]), "+v"(fb[0]), "+v"(fa[1]), "+v"(fb[1]), "+v"(fa[2]), "+v"(fb[2]), "+v"(fa[3]), "+v"(fb[3]) :: "memory");
#pragma unroll
                for (int dt = 0; dt < 4; ++dt) { v4u vw; vw.x = fa[dt].x; vw.y = fa[dt].y; vw.z = fb[dt].x; vw.w = fb[dt].y;
                    oacc[dt] = __builtin_amdgcn_mfma_f32_32x32x16_bf16(__builtin_bit_cast(bf8v, vw), __builtin_bit_cast(bf8v, pw[j]), oacc[dt], 0, 0, 0); }
            }
            if (__all(carry < SB_EXIT)) break;
        }
        float ss = 0.f;
        u16* orow = F.O() + (size_t)(b * SEQ + q0 + c) * DM + 2048 + h * HD + 4 * hi;
#pragma unroll
        for (int dt = 0; dt < 4; ++dt)
#pragma unroll
            for (int r4 = 0; r4 < 4; ++r4) { const float o0 = oacc[dt][4 * r4], o1 = oacc[dt][4 * r4 + 1], o2 = oacc[dt][4 * r4 + 2], o3 = oacc[dt][4 * r4 + 3];
                ss += (o0 * o0 + o1 * o1) + (o2 * o2 + o3 * o3);
                v2u w; w.x = pk2(o0, o1); w.y = pk2(o2, o3); *(v2u*)(orow + 32 * dt + 8 * r4) = w; }
        ss += xshf<32>(ss);
        if (hi == 0) F.SSQ()[(b * SEQ + q0 + c) * 32 + 16 + h] = ss;
    }
}
__device__ __forceinline__ unsigned mono_key(float f) { const unsigned u = __builtin_bit_cast(unsigned, f); return (u & 0x80000000u) ? ~u : (u | 0x80000000u); }
typedef unsigned u32x16 __attribute__((ext_vector_type(16)));
typedef float f32x2 __attribute__((ext_vector_type(2)));
typedef _Float16 h8v __attribute__((ext_vector_type(8)));
__device__ __forceinline__ int mbcnt64(unsigned long long m) { return (int)__builtin_amdgcn_mbcnt_hi((unsigned)(m >> 32), __builtin_amdgcn_mbcnt_lo((unsigned)m, 0u)); }
__device__ __forceinline__ float relu_i(float x) { const int i = __float_as_int(x); return __int_as_float(i > 0 ? i : 0); }
constexpr int IDX_CMAX = 1024;
constexpr int IDX_KST = 144, IDX_RK = 128, IDX_BUFB = IDX_RK * IDX_KST;
#define IDX_LDF(f, base, tt, k) do { f = *(const LAS h8v*)((base) + (tt) * 32 * IDX_KST + 32 * (k)); asm volatile("" ::: "memory"); } while (0)
#define IDX_MF(acc, a, f) acc = __builtin_amdgcn_mfma_f32_32x32x16_f16(a, f, acc, 0, 0, 0)
#define IDX_Z(acc) acc = (f32x16){0.f, 0.f, 0.f, 0.f, 0.f, 0.f, 0.f, 0.f, 0.f, 0.f, 0.f, 0.f, 0.f, 0.f, 0.f, 0.f}
#define IDX_RED(acc, pp) do { f32x2 sA_ = {0.f, 0.f}, sB_ = {0.f, 0.f}; \
        _Pragma("unroll") for (int q2 = 0; q2 < 8; q2 += 2) { \
            const f32x2 ra_ = {relu_i(acc[2 * q2]), relu_i(acc[2 * q2 + 1])}, rb_ = {relu_i(acc[2 * q2 + 2]), relu_i(acc[2 * q2 + 3])}; \
            sA_ = __builtin_elementwise_fma(wrp[q2], ra_, sA_); sB_ = __builtin_elementwise_fma(wrp[q2 + 1], rb_, sB_); } \
        const f32x2 st_ = sA_ + sB_; pp = st_.x + st_.y; } while (0)
#define IDX_OUT(kc, el, koff) do { auto sw = __builtin_amdgcn_permlane32_swap(__float_as_uint(pp0), __float_as_uint(pp1), false, false); \
        const unsigned sw0 = sw[0], sw1 = sw[1]; const float sc = __uint_as_float(sw0) + __uint_as_float(sw1); \
        const unsigned su_ = __float_as_uint(sc); const unsigned mk_ = su_ ^ ((unsigned)((int)su_ >> 31) | 0x80000000u);     \
        kc[el] = lane <= (t - (koff)) ? mk_ : 0u; } while (0)
#define IDX_CHUNK(kc, kp, ch) \
    if (8 * (ch) < nr) { \
        _Pragma("unroll") for (int rr_ = 0; rr_ < 8; ++rr_) { const int r = 8 * (ch) + rr_; \
            if (r < nr) { \
                const LAS unsigned char* curl = kl0 + (r & 1) * IDX_BUFB; LAS unsigned char* nxt = kbuf + ((r + 1) & 1) * IDX_BUFB; \
                const bool more = (r + 1) < nr; \
                if (more && stg) { pf0 = *(const GAS v4u*)(pfp); pf1 = *(const GAS v4u*)(pfp + 64 * 64); pfp += IDX_RK * 64; asm volatile("" : "+v"(pfp)); } \
                IDX_Z(accA); \
                IDX_LDF(fC, curl, 0, 2); IDX_MF(accA, a0, fA); \
                IDX_LDF(fA, curl, 0, 3); IDX_MF(accA, a1, fB); \
                if (r > 0) { IDX_RED(accB, pp1); if (rr_ > 0) IDX_OUT(kc, (rr_ > 0 ? 2 * rr_ - 1 : 0), (r - 1) * IDX_RK + 64); else IDX_OUT(kp, 15, (r - 1) * IDX_RK + 64); } \
                IDX_LDF(fB, curl, 1, 0); IDX_MF(accA, a2, fC); \
                IDX_LDF(fC, curl, 1, 1); IDX_MF(accA, a3, fA); \
                IDX_Z(accB); \
                IDX_LDF(fA, curl, 1, 2); IDX_MF(accB, a0, fB); \
                IDX_LDF(fB, curl, 1, 3); IDX_MF(accB, a1, fC); \
                IDX_RED(accA, pp0); \
                IDX_LDF(fC, curl, 2, 0); IDX_MF(accB, a2, fA); \
                IDX_LDF(fA, curl, 2, 1); IDX_MF(accB, a3, fB); \
                IDX_Z(accA); \
                IDX_LDF(fB, curl, 2, 2); IDX_MF(accA, a0, fC); \
                IDX_LDF(fC, curl, 2, 3); IDX_MF(accA, a1, fA); \
                IDX_RED(accB, pp1); IDX_OUT(kc, 2 * rr_, r * IDX_RK); \
                IDX_LDF(fA, curl, 3, 0); IDX_MF(accA, a2, fB); \
                IDX_LDF(fB, curl, 3, 1); IDX_MF(accA, a3, fC); \
                IDX_Z(accB); \
                IDX_LDF(fC, curl, 3, 2); IDX_MF(accB, a0, fA); \
                IDX_LDF(fA, curl, 3, 3); IDX_MF(accB, a1, fB); \
                IDX_RED(accA, pp0); \
                IDX_MF(accB, a2, fC); IDX_MF(accB, a3, fA); \
                if (more && stg) { *(LAS v4u*)(nxt + srow * IDX_KST + sch * 16) = pf0; *(LAS v4u*)(nxt + (srow + 64) * IDX_KST + sch * 16) = pf1; } \
                if (stg) __syncthreads(); \
                if (more) { const LAS unsigned char* nl_ = kl0 + ((r + 1) & 1) * IDX_BUFB; IDX_LDF(fA, nl_, 0, 0); IDX_LDF(fB, nl_, 0, 1); } \
                else { IDX_RED(accB, pp1); IDX_OUT(kc, 2 * rr_ + 1, r * IDX_RK + 64); } \
            } } }
#define IDX_COUNT_GE(kc, ch) if (16 * (ch) < nreg) { _Pragma("unroll") for (int i_ = 0; i_ < 16; ++i_) cv += kc[i_] >= cand ? 1 : 0; }
#define IDX_MAX(kc, ch) if (16 * (ch) < nreg) { _Pragma("unroll") for (int i_ = 0; i_ < 16; ++i_) km = kc[i_] > km ? kc[i_] : km; }
#define IDX_COMPACT(kc, ch) if (16 * (ch) < nreg) { _Pragma("unroll") for (int i_ = 0; i_ < 16; ++i_) { const unsigned kk_ = kc[i_]; const bool f_ = kk_ >= T; const unsigned long long mf_ = __ballot(f_); \
                if (mf_ != 0ull) { const int p_ = cb + mbcnt64(mf_); int ln_ = lane; asm volatile("" : "+v"(ln_)); if (f_ && p_ < IDX_CMAX) { cmk[p_] = kk_; cmi[p_] = (unsigned)(64 * (16 * (ch) + i_) + ln_); } cb += (int)__popcll(mf_); } } }
#define IDX_COUNT_GT(kc, ch) if (16 * (ch) < nreg) { _Pragma("unroll") for (int i_ = 0; i_ < 16; ++i_) cv += kc[i_] > T ? 1 : 0; }
#define IDX_EMIT(kc, ch) if (16 * (ch) < nreg) { _Pragma("unroll") for (int i_ = 0; i_ < 16; ++i_) { \
                const int rg = 16 * (ch) + i_; const unsigned kk = kc[i_]; \
                const bool gt = kk > T, eq = kk == T; \
                const unsigned long long meq = __ballot(eq); \
                const bool sel = gt || (eq && (eqbase + mbcnt64(meq)) < need); \
                const unsigned long long ms = __ballot(sel); \
                if (ms != 0ull) { \
                    const int pos = base + mbcnt64(ms); \
                    int ln_ = lane; asm volatile("" : "+v"(ln_));     \
                    const int s = 64 * rg + ln_, d = t - s; \
                    const unsigned bk = d < 128 ? tbl[d < 0 ? 0 : d] : 31u; \
                    if (sel && pos < TOPK) list[pos] = (unsigned)s | (bk << 16); \
                    base += (int)__popcll(ms); \
                } \
                eqbase += (int)__popcll(meq); } }
__device__ __forceinline__ void idx_fast(Frame& F0) {
    Frame F = F0; rethread(F);
    LAS unsigned char* kbuf = F.lds + RING_OFF;
    LAS unsigned* tbl = (LAS unsigned*)(F.lds + RING_OFF + 2 * IDX_BUFB);
    LAS unsigned* cmk = (LAS unsigned*)(F.lds + RING_OFF + 40960 + F.wave * 8192);
    LAS unsigned* cmi = cmk + IDX_CMAX;
    const int tid = F.tid, lane = F.lane, wave = F.wave, hi = lane >> 5, c32 = lane & 31;
    if (tid < 128) tbl[tid] = t5_bucket(tid);
    __syncthreads();
    const int srow = tid >> 3, sch = tid & 7;
    for (int item = F.vcu; item < 2048; item += F.G) {
        const int kq = item >> 8, w = item & 255, b = kq & 1, q = kq >> 1;
        const int gi = q == 0 ? w : (q == 1 ? 511 - w : (q == 2 ? 512 + w : 1023 - w));
        const int t0 = gi * 8, t = t0 + wave, m = b * SEQ + t;
        unsigned* list = F.LIST() + (size_t)m * TOPK;
        if (t0 + 8 <= TOPK) {
#pragma unroll
            for (int j = 0; j < 4; ++j) { const int i = lane + 64 * j; const int d = t - i; list[i] = i <= t ? ((unsigned)i | (t5_bucket(d < 0 ? 0 : d) << 16)) : 0u; }
            continue;
        }
        const u16* iqp = F.IQ() + (size_t)m * 2048 + c32 * 64 + hi * 8;
        const h8v a0 = *(const h8v*)(iqp), a1 = *(const h8v*)(iqp + 16), a2 = *(const h8v*)(iqp + 32), a3 = *(const h8v*)(iqp + 48);
        f32x16 wr;
#pragma unroll
        for (int r = 0; r < 16; ++r) wr[r] = F.IWS()[(size_t)m * 32 + 8 * (r >> 2) + 4 * hi + (r & 3)] * (0.17677669529663687f * 0.125f);
        f32x2 wrp[8];
#pragma unroll
        for (int r = 0; r < 8; ++r) wrp[r] = (f32x2){wr[2 * r], wr[2 * r + 1]};
        const u32x16 kz = {0u, 0u, 0u, 0u, 0u, 0u, 0u, 0u, 0u, 0u, 0u, 0u, 0u, 0u, 0u, 0u};
        u32x16 k0 = kz, k1 = kz, k2 = kz, k3 = kz, k4 = kz, k5 = kz, k6 = kz, k7 = kz;
        const int nr = (t0 + 8 + IDX_RK - 1) / IDX_RK;
        const u16* kg = F.IKN() + (size_t)b * SEQ * 64;
#if defined(PROBE_IDX) && (PROBE_IDX == 4 || PROBE_IDX == 5)
        { const LAS unsigned char* kl0p = kbuf + c32 * IDX_KST + hi * 16; float dm = 0.f;
          for (int r = 0; r < nr; ++r) {
#pragma unroll
              for (int tt = 0; tt < 4; ++tt) { const LAS unsigned char* kp = kl0p + (r & 1) * IDX_BUFB + tt * 32 * IDX_KST;
                  f32x16 acc = {0.f, 0.f, 0.f, 0.f, 0.f, 0.f, 0.f, 0.f, 0.f, 0.f, 0.f, 0.f, 0.f, 0.f, 0.f, 0.f};
                  acc = __builtin_amdgcn_mfma_f32_32x32x16_f16(a0, *(const LAS h8v*)(kp), acc, 0, 0, 0); acc = __builtin_amdgcn_mfma_f32_32x32x16_f16(a1, *(const LAS h8v*)(kp + 32), acc, 0, 0, 0);
                  acc = __builtin_amdgcn_mfma_f32_32x32x16_f16(a2, *(const LAS h8v*)(kp + 64), acc, 0, 0, 0); acc = __builtin_amdgcn_mfma_f32_32x32x16_f16(a3, *(const LAS h8v*)(kp + 96), acc, 0, 0, 0);
                  if (PROBE_IDX == 5) { float s0 = 0.f, s1 = 0.f, s2 = 0.f, s3 = 0.f;
#pragma unroll
                      for (int q4 = 0; q4 < 16; q4 += 4) { s0 += wr[q4] * relu_i(acc[q4]); s1 += wr[q4 + 1] * relu_i(acc[q4 + 1]); s2 += wr[q4 + 2] * relu_i(acc[q4 + 2]); s3 += wr[q4 + 3] * relu_i(acc[q4 + 3]); }
                      dm += (s0 + s1) + (s2 + s3); }
                  else dm += acc[0] + acc[5]; } }
          if (dm == 123.456f) F.IWS()[(size_t)m * 32] = dm; }
#endif
#if defined(PROBE_IDX) && PROBE_IDX == 3
        { const GAS u16* dp = (const GAS u16*)kg + (size_t)srow * 64 + sch * 8;
          for (int r = 0; r < nr; ++r) { const v4u d0 = *(const GAS v4u*)(dp), d1 = *(const GAS v4u*)(dp + 64 * 64); dp += IDX_RK * 64; asm volatile("" : "+v"(dp));
              LAS unsigned char* nb_ = kbuf + (r & 1) * IDX_BUFB; *(LAS v4u*)(nb_ + srow * IDX_KST + sch * 16) = d0; *(LAS v4u*)(nb_ + (srow + 64) * IDX_KST + sch * 16) = d1; __syncthreads(); } }
#endif
        const GAS u16* pfp = (const GAS u16*)kg + (size_t)srow * 64 + sch * 8;
        v4u pf0 = *(const GAS v4u*)(pfp), pf1 = *(const GAS v4u*)(pfp + 64 * 64); pfp += IDX_RK * 64; asm volatile("" : "+v"(pfp));
        *(LAS v4u*)(kbuf + srow * IDX_KST + sch * 16) = pf0; *(LAS v4u*)(kbuf + (srow + 64) * IDX_KST + sch * 16) = pf1;
        __syncthreads();
        const LAS unsigned char* kl0 = kbuf + c32 * IDX_KST + hi * 16;
        h8v fA, fB, fC; f32x16 accA, accB; float pp0 = 0.f, pp1 = 0.f;
        IDX_LDF(fA, kl0, 0, 0); IDX_LDF(fB, kl0, 0, 1);
#ifndef PROBE_IDX
#define PROBE_IDX 0
#endif
        for (int prb_ = 0; prb_ < ((PROBE_IDX == 1 || PROBE_IDX == 2) ? 2 : 1); ++prb_) {
        const bool stg = !(PROBE_IDX == 2 && prb_ == 0);
        if (prb_ == 1) { pfp = (const GAS u16*)kg + (size_t)srow * 64 + sch * 8; pf0 = *(const GAS v4u*)(pfp); pf1 = *(const GAS v4u*)(pfp + 64 * 64); pfp += IDX_RK * 64; asm volatile("" : "+v"(pfp));
            *(LAS v4u*)(kbuf + srow * IDX_KST + sch * 16) = pf0; *(LAS v4u*)(kbuf + (srow + 64) * IDX_KST + sch * 16) = pf1; __syncthreads(); IDX_LDF(fA, kl0, 0, 0); IDX_LDF(fB, kl0, 0, 1); }
        IDX_CHUNK(k0, k0, 0) IDX_CHUNK(k1, k0, 1) IDX_CHUNK(k2, k1, 2) IDX_CHUNK(k3, k2, 3) IDX_CHUNK(k4, k3, 4) IDX_CHUNK(k5, k4, 5) IDX_CHUNK(k6, k5, 6) IDX_CHUNK(k7, k6, 7)
        }
        const int nreg = 2 * nr;
        unsigned T = 0u; int cT = 1 << 30, bit = 31; bool done = false;
        { unsigned km = 0u;
          IDX_MAX(k0, 0) IDX_MAX(k1, 1) IDX_MAX(k2, 2) IDX_MAX(k3, 3) IDX_MAX(k4, 4) IDX_MAX(k5, 5) IDX_MAX(k6, 6) IDX_MAX(k7, 7)
          km = (unsigned)__builtin_amdgcn_readfirstlane(wave_max_u(km));
          for (unsigned e = km >> 23, tries = 0u; tries < 3u; --e, ++tries) {
              const unsigned cand = e << 23; int cv = 0;
              IDX_COUNT_GE(k0, 0) IDX_COUNT_GE(k1, 1) IDX_COUNT_GE(k2, 2) IDX_COUNT_GE(k3, 3) IDX_COUNT_GE(k4, 4) IDX_COUNT_GE(k5, 5) IDX_COUNT_GE(k6, 6) IDX_COUNT_GE(k7, 7)
              const int c = __builtin_amdgcn_readfirstlane(wave_sum_i(cv));
              if (c >= TOPK) { T = cand; cT = c; done = (c == TOPK); bit = 22; break; }
              if (e == 0u) break; } }
        while (!done && bit >= 0 && cT > IDX_CMAX) {
            const unsigned cand = T | (1u << bit); int cv = 0;
            IDX_COUNT_GE(k0, 0) IDX_COUNT_GE(k1, 1) IDX_COUNT_GE(k2, 2) IDX_COUNT_GE(k3, 3) IDX_COUNT_GE(k4, 4) IDX_COUNT_GE(k5, 5) IDX_COUNT_GE(k6, 6) IDX_COUNT_GE(k7, 7)
            const int c = __builtin_amdgcn_readfirstlane(wave_sum_i(cv));
            if (c >= TOPK) { T = cand; cT = c; }
            done = (c == TOPK); --bit;
        }
        if (done || bit < 0) {
            int cv = 0;
            IDX_COUNT_GT(k0, 0) IDX_COUNT_GT(k1, 1) IDX_COUNT_GT(k2, 2) IDX_COUNT_GT(k3, 3) IDX_COUNT_GT(k4, 4) IDX_COUNT_GT(k5, 5) IDX_COUNT_GT(k6, 6) IDX_COUNT_GT(k7, 7)
            const int need = TOPK - __builtin_amdgcn_readfirstlane(wave_sum_i(cv));
            int base = 0, eqbase = 0;
            IDX_EMIT(k0, 0) IDX_EMIT(k1, 1) IDX_EMIT(k2, 2) IDX_EMIT(k3, 3) IDX_EMIT(k4, 4) IDX_EMIT(k5, 5) IDX_EMIT(k6, 6) IDX_EMIT(k7, 7)
        } else {
            int cb = 0;
            IDX_COMPACT(k0, 0) IDX_COMPACT(k1, 1) IDX_COMPACT(k2, 2) IDX_COMPACT(k3, 3) IDX_COMPACT(k4, 4) IDX_COMPACT(k5, 5) IDX_COMPACT(k6, 6) IDX_COMPACT(k7, 7)
            u32x16 kq;
#pragma unroll
            for (int q = 0; q < 16; ++q) kq[q] = (64 * q + lane) < cb ? cmk[64 * q + lane] : 0u;
            for (; bit >= 0; --bit) {
                const unsigned cand = T | (1u << bit); int cv = 0;
#pragma unroll
                for (int q = 0; q < 16; ++q) cv += kq[q] >= cand ? 1 : 0;
                const int c = __builtin_amdgcn_readfirstlane(wave_sum_i(cv));
                if (c >= TOPK) T = cand;
                if (c == TOPK) break;
            }
            int cv = 0;
#pragma unroll
            for (int q = 0; q < 16; ++q) cv += kq[q] > T ? 1 : 0;
            const int need = TOPK - __builtin_amdgcn_readfirstlane(wave_sum_i(cv));
            int base = 0, eqbase = 0;
#pragma unroll
            for (int q = 0; q < 16; ++q) if (64 * q < cb) {
                const unsigned kk = kq[q];
                const bool gt = kk > T, eq = kk == T && (64 * q + lane) < cb;
                const unsigned long long meq = __ballot(eq);
                const bool sel = gt || (eq && (eqbase + mbcnt64(meq)) < need);
                const unsigned long long ms = __ballot(sel);
                if (ms != 0ull) {
                    const int pos = base + mbcnt64(ms);
                    const int sidx = (int)cmi[64 * q + lane], d = t - sidx;
                    const unsigned bk = d < 128 ? tbl[d < 0 ? 0 : d] : 31u;
                    if (sel && pos < TOPK) list[pos] = (unsigned)sidx | (bk << 16);
                    base += (int)__popcll(ms);
                }
                eqbase += (int)__popcll(meq);
            }
        }
    }
}
template <int O1, int O2> __device__ __forceinline__ void tr8_read2(v2u& a, v2u& b, unsigned addr) {
    asm volatile("ds_read_b64_tr_b8 %0, %2 offset:%3\n\tds_read_b64_tr_b8 %1, %2 offset:%4" : "=&v"(a), "=&v"(b) : "v"(addr), "i"(O1), "i"(O2) : "memory");
}
constexpr int SPA_VST = 288;
constexpr int SPA_V8ST = 144;
constexpr int SPA_WAVE_LDS = 2048 + 64 * SPA_V8ST + 1024 + 64;
__device__ __forceinline__ void sparse_fast(Frame& F0) {
    Frame F = F0; rethread(F);
    const float* const relb_p = F.relb();
    LAS float* rb = (LAS float*)(F.lds + RING_OFF + NWAVES * SPA_WAVE_LDS);
    for (int i = F.tid; i < 512; i += NWAVES * 64) rb[i] = relb_p[i] * 1.4426950408889634f;
    LAS unsigned char* wl = F.lds + RING_OFF + F.wave * SPA_WAVE_LDS;
    LAS unsigned* le = (LAS unsigned*)wl;
    LAS unsigned char* vst = wl + 2048;
    LAS float* lgb = (LAS float*)vst;
    LAS unsigned* pbb = (LAS unsigned*)(wl + 2048 + 64 * SPA_V8ST);
    LAS float* psb = (LAS float*)(wl + 2048 + 64 * SPA_V8ST + 1024);
    LAS u16* ktab = (LAS u16*)(F.lds + RING_OFF + NWAVES * SPA_WAVE_LDS + 2048);
    LAS u16* vtab = (LAS u16*)(F.lds + TAIL_OFF);
    const unsigned vst_addr = (unsigned)(size_t)vst;
    const int lane = F.lane, hh = lane & 15, qd = lane >> 4;
    const int gw = F.vcu * NWAVES + F.wave, NGW = F.G * NWAVES, per = NGW / 8;
    const int bg = gw / per, r0 = gw % per;
    { const int bgc = bg < 8 ? bg : 7; const GAS v4u* ksrc = (const GAS v4u*)(F.KS() + (size_t)bgc * SEQ); const GAS v4u* vsrc = (const GAS v4u*)(F.VS() + (size_t)bgc * SEQ);
      for (int i = F.tid; i < SEQ / 8; i += NWAVES * 64) { ((LAS v4u*)ktab)[i] = ksrc[i]; ((LAS v4u*)vtab)[i] = vsrc[i]; } }
    __syncthreads();
    if (bg < 8) {
    const int b = bg >> 2, g = bg & 3;
    const unsigned tr_base = vst_addr + (unsigned)((16 * qd + (hh >> 1)) * SPA_V8ST + 8 * (hh & 1));
    constexpr int KD = 9;
    unsigned en[4];
    v4u kf[KD + 1][2]; v4u qraw[2]; float sqn = 0.f;
    const unsigned char* const kbase = F.KQ8() + ((size_t)(b * SEQ) * 4 + g) * 128;
    const unsigned klo = 16u * (unsigned)qd, vlo = 16u * (unsigned)(lane & 7);
    const unsigned char* const vbase = F.VQ8() + ((size_t)(b * SEQ) * 4 + g) * 128;
#define SPA_STAGE(tt, leb) do { const int cnt_ = ((tt) + 1) < TOPK ? ((tt) + 1) : TOPK; \
        _Pragma("unroll") for (int j_ = 0; j_ < 4; ++j_) { const int pos_ = 64 * j_ + lane; (leb)[pos_] = pos_ < cnt_ ? en[j_] : 0u; } \
        _Pragma("unroll") for (int pt_ = 0; pt_ < KD; ++pt_) { const unsigned idx_ = (leb)[16 * pt_ + hh] & 0xffffu; const unsigned char* kp_ = kbase + (idx_ * 512u + klo); \
            kf[pt_][0] = *(const v4u*)(kp_); kf[pt_][1] = *(const v4u*)(kp_ + 64); } \
        { const unsigned char* qp_ = F.Q8() + (size_t)(b * SEQ + (tt)) * 2048 + (4 * g + (hh & 3)) * HD + 16 * qd; \
          qraw[0] = __builtin_nontemporal_load((const v4u*)(qp_)); qraw[1] = __builtin_nontemporal_load((const v4u*)(qp_ + 64)); \
          sqn = F.QS()[(size_t)(b * SEQ + (tt)) * 16 + 4 * g + (lane >> 4)]; } } while (0)
    if (r0 < SEQ) {
#pragma unroll
        for (int j = 0; j < 4; ++j) en[j] = __builtin_nontemporal_load(F.LIST() + (size_t)(b * SEQ + r0) * TOPK + 64 * j + lane);
        SPA_STAGE(r0, le);
    }
    int par = 0;
    for (int t = r0; t < SEQ; t += per, par ^= 1) {
        const int m = b * SEQ + t;
        const int cnt = (t + 1) < TOPK ? (t + 1) : TOPK;
        LAS unsigned* lec = le + 256 * par;
        LAS unsigned* len = le + 256 * (par ^ 1);
        { const int tn0 = (t + per) < SEQ ? (t + per) : t;
#pragma unroll
          for (int j = 0; j < 4; ++j) en[j] = __builtin_nontemporal_load(F.LIST() + (size_t)(b * SEQ + tn0) * TOPK + 64 * j + lane); }
        v4u vr[2][8];
#pragma unroll
        for (int pt = 0; pt < 2; ++pt)
#pragma unroll
            for (int i = 0; i < 8; ++i) { const int R = 8 * i + (lane >> 3); const int kp = 16 * (R & 3) + 4 * (R >> 4) + ((R >> 2) & 3);
                const unsigned idx = lec[64 * pt + kp] & 0xffffu; vr[pt][i] = *(const v4u*)(vbase + (idx * 512u + vlo)); }
        pg8::i32x4 qf[2]; const float sqs = sqn * (0.08838834764831845f * 1.4426950408889634f);
#pragma unroll
        for (int st = 0; st < 2; ++st) qf[st] = hh < 4 ? __builtin_bit_cast(pg8::i32x4, qraw[st]) : (pg8::i32x4){0, 0, 0, 0};
        float cl[16];
#pragma unroll
        for (int tile = 0; tile < 16; ++tile) {
            if (tile + KD < 16) { const unsigned idx = lec[16 * (tile + KD) + hh] & 0xffffu; const unsigned char* kp = kbase + (idx * 512u + klo);
#pragma unroll
                for (int st = 0; st < 2; ++st) kf[(tile + KD) % (KD + 1)][st] = *(const v4u*)(kp + 64 * st); }
            pg8::i32x4 acc = {0, 0, 0, 0};
#pragma unroll
            for (int st = 0; st < 2; ++st) acc = __builtin_amdgcn_mfma_i32_16x16x64_i8(__builtin_bit_cast(pg8::i32x4, kf[tile % (KD + 1)][st]), qf[st], acc, 0, 0, 0);
            if (hh < 4) *(LAS pg8::i32x4*)(lgb + 64 * tile + 16 * hh + 4 * qd) = acc;
        }
#pragma unroll
        for (int tile = 0; tile < 16; ++tile) cl[tile] = (float)((const LAS int*)lgb)[64 * tile + lane];
        const int ch = lane >> 4, ck = lane & 15;
        float mx = -INFINITY;
#pragma unroll
        for (int tile = 0; tile < 16; ++tile) { const int pos = 16 * tile + ck; const unsigned e = lec[pos];
            const float bias = rb[((e >> 16) & 31u) * 16 + 4 * g + ch];
            const float lgv = cl[tile] * (hlo((unsigned)ktab[e & 0xffffu]) * sqs) + bias; const float lg = pos < cnt ? lgv : -INFINITY;
            cl[tile] = lg; mx = fmaxf(mx, lg); }
        mx = fmaxf(mx, xshf<1>(mx)); mx = fmaxf(mx, xshf<2>(mx)); mx = fmaxf(mx, xshf<4>(mx)); mx = fmaxf(mx, xshf<8>(mx));
        float ps = 0.f;
#pragma unroll
        for (int tile = 0; tile < 16; ++tile) { const float p = __builtin_amdgcn_exp2f(cl[tile] - mx); cl[tile] = p; ps += p; }
        ps += xshf<1>(ps); ps += xshf<2>(ps); ps += xshf<4>(ps); ps += xshf<8>(ps);
        float pm = 0.f;
#pragma unroll
        for (int tile = 0; tile < 16; ++tile) { cl[tile] *= hlo((unsigned)vtab[lec[16 * tile + ck] & 0xffffu]); pm = fmaxf(pm, cl[tile]); }
        pm = fmaxf(pm, xshf<1>(pm)); pm = fmaxf(pm, xshf<2>(pm)); pm = fmaxf(pm, xshf<4>(pm)); pm = fmaxf(pm, xshf<8>(pm));
        { const float pinv = pm > 0.f ? 127.0f / pm : 0.f;
#pragma unroll
          for (int T = 0; T < 4; ++T) pbb[ch * 64 + T * 16 + ck] = q4((f32x4){cl[4 * T], cl[4 * T + 1], cl[4 * T + 2], cl[4 * T + 3]}, pinv); }
        if (ck == 0) { psb[2 * ch] = pm * (1.0f / 127.0f) / ps; }
        const float oscale = psb[2 * (hh & 3)];
        { const int tn = (t + per) < SEQ ? (t + per) : t;
          SPA_STAGE(tn, len); }
        pg8::i32x4 oacc[8];
#pragma unroll
        for (int dt = 0; dt < 8; ++dt) oacc[dt] = (pg8::i32x4){0, 0, 0, 0};
#pragma unroll
        for (int T = 0; T < 4; ++T) {
#pragma unroll
            for (int i = 0; i < 8; ++i) *(LAS v4u*)(vst + (8 * i + (lane >> 3)) * SPA_V8ST + (lane & 7) * 16) = vr[T & 1][i];
            if (T + 2 < 4) {
#pragma unroll
                for (int i = 0; i < 8; ++i) { const int R = 8 * i + (lane >> 3); const int kp = 16 * (R & 3) + 4 * (R >> 4) + ((R >> 2) & 3);
                    const unsigned idx = lec[64 * (T + 2) + kp] & 0xffffu; vr[T & 1][i] = *(const v4u*)(vbase + (idx * 512u + vlo)); } }
            const pg8::i32x4 pq = __builtin_bit_cast(pg8::i32x4, *(const LAS v4u*)(pbb + (hh & 3) * 64 + T * 16 + 4 * qd));
            v2u fa[8], fb[8];
            tr8_read2<0, 8 * SPA_V8ST>(fa[0], fb[0], tr_base); tr8_read2<16, 8 * SPA_V8ST + 16>(fa[1], fb[1], tr_base);
            tr8_read2<32, 8 * SPA_V8ST + 32>(fa[2], fb[2], tr_base); tr8_read2<48, 8 * SPA_V8ST + 48>(fa[3], fb[3], tr_base);
            tr8_read2<64, 8 * SPA_V8ST + 64>(fa[4], fb[4], tr_base); tr8_read2<80, 8 * SPA_V8ST + 80>(fa[5], fb[5], tr_base);
            tr8_read2<96, 8 * SPA_V8ST + 96>(fa[6], fb[6], tr_base); tr8_read2<112, 8 * SPA_V8ST + 112>(fa[7], fb[7], tr_base);
            asm volatile("s_waitcnt lgkmcnt(0)" : "+v"(fa[0]), "+v"(fb[0]), "+v"(fa[1]), "+v"(fb[1]), "+v"(fa[2]), "+v"(fb[2]), "+v"(fa[3]), "+v"(fb[3]),
                         "+v"(fa[4]), "+v"(fb[4]), "+v"(fa[5]), "+v"(fb[5]), "+v"(fa[6]), "+v"(fb[6]), "+v"(fa[7]), "+v"(fb[7]) :: "memory");
#pragma unroll
            for (int dt = 0; dt < 8; ++dt) { pg8::i32x4 vw; vw[0] = (int)fa[dt].x; vw[1] = (int)fa[dt].y; vw[2] = (int)fb[dt].x; vw[3] = (int)fb[dt].y;
                oacc[dt] = __builtin_amdgcn_mfma_i32_16x16x64_i8(vw, pq, oacc[dt], 0, 0, 0); }
        }
        float ss = 0.f;
        u16* orow = F.O() + (size_t)m * DM + (4 * g + (hh & 3)) * HD + 4 * qd;
#pragma unroll
        for (int dt = 0; dt < 8; ++dt) { const f32x4 o = __builtin_convertvector(oacc[dt], f32x4) * oscale; ss += (o.x * o.x + o.y * o.y) + (o.z * o.z + o.w * o.w);
            if (hh < 4) { v2u w; w.x = pk2(o.x, o.y); w.y = pk2(o.z, o.w); __builtin_nontemporal_store(w, (v2u*)(orow + 16 * dt)); } }
        ss += xshf<16>(ss); ss += xshf<32>(ss);
        if (lane < 4) F.SSQ()[m * 32 + 4 * g + lane] = ss;
    }
    }
}
template <bool FILL> __device__ __forceinline__ void p6_norm(Frame& F0) {
    Frame F = F0; rethread(F);
    const float* const gn_a_p = F.gn_a();
    const float* const gn_b_p = F.gn_b();
    const int gw = F.vcu * NWAVES + F.wave, NGW = F.G * NWAVES;
    LAS float* pl = (LAS float*)(F.lds + RING_OFF);
    if (FILL) { lds_fill(pl, gn_a_p, 2048, F.tid); lds_fill(pl + 2048, gn_b_p, 2048, F.tid); }
    __syncthreads();
    for (int m = gw; m < M; m += NGW) {
        const float sv = F.lane < 32 ? F.SSQ()[m * 32 + F.lane] : 0.f;
        float sa = F.lane < 16 ? sv : 0.f, sb = (F.lane >= 16 && F.lane < 32) ? sv : 0.f;
        sa = wave_sum(sa); sb = wave_sum(sb);
        const float ra = 1.f / sqrtf(sa * (1.f / 2048.f) + LN_EPS), rb = 1.f / sqrtf(sb * (1.f / 2048.f) + LN_EPS);
        const GAS v4u* src = (const GAS v4u*)(F.O() + (size_t)m * DM) + F.lane;
        f32x4 y[16]; float am = 0.f;
#pragma unroll
        for (int j = 0; j < 8; ++j) { const int col = 8 * (F.lane + 64 * j); const v4u w = src[64 * j];
            const float r = col < 2048 ? ra : rb;
            const f32x4 g0 = ldl(pl, 32u * (unsigned)F.lane, 512 * j), g1 = ldl(pl, 32u * (unsigned)F.lane, 512 * j + 4);
            y[2 * j] = (f32x4){bflo(w.x), bfhi(w.x), bflo(w.y), bfhi(w.y)} * r * g0; y[2 * j + 1] = (f32x4){bflo(w.z), bfhi(w.z), bflo(w.w), bfhi(w.w)} * r * g1;
            am = fmaxf(am, fmaxf(amax4(y[2 * j]), amax4(y[2 * j + 1]))); }
        am = wave_max(am); const float inv = am > 0.f ? 127.0f / am : 0.f;
        if (F.lane == 0) F.SA_ON()[m] = am * (1.0f / 127.0f);
        GAS v2u* dst = (GAS v2u*)(F.ONQ() + (size_t)m * DM) + F.lane;
#pragma unroll
        for (int j = 0; j < 8; ++j) { v2u o; o.x = q4(y[2 * j], inv); o.y = q4(y[2 * j + 1], inv); dst[64 * j] = o; }
    }
}
template <bool FILL> __device__ __forceinline__ void p8_rows(Frame& F0) {
    Frame F = F0; rethread(F);
    const float* const ln1_g_p = F.ln1_g();
    const float* const ln1_b_p = F.ln1_b();
    const int gw = F.vcu * NWAVES + F.wave, NGW = F.G * NWAVES;
    LAS float* pl = (LAS float*)(F.lds + RING_OFF);
    if (FILL) { lds_fill(pl, ln1_g_p, DM, F.tid); lds_fill(pl + DM, ln1_b_p, DM, F.tid);
        lds_fill(pl + 2 * DM, F.MOD() + 3 * DM, 2 * DM, F.tid); lds_fill(pl + 4 * DM, F.MOD() + 9 * DM, 2 * DM, F.tid); }
    __syncthreads();
    for (int m = gw; m < M; m += NGW) {
        const GAS v4u* xr = (const GAS v4u*)(F.V1B() + (size_t)m * DM) + F.lane;
        f32x4 v[16]; float s = 0.f;
#pragma unroll
        for (int j = 0; j < 8; ++j) { const v4u w = xr[64 * j]; v[2 * j] = (f32x4){bflo(w.x), bfhi(w.x), bflo(w.y), bfhi(w.y)}; v[2 * j + 1] = (f32x4){bflo(w.z), bfhi(w.z), bflo(w.w), bfhi(w.w)}; }
#pragma unroll
        for (int j = 0; j < 16; ++j) s += (v[j].x + v[j].y) + (v[j].z + v[j].w);
        const float mean = wave_sum(s) * (1.f / DM); float s2 = 0.f;
#pragma unroll
        for (int j = 0; j < 16; ++j) { v[j] = v[j] - mean; s2 += (v[j].x * v[j].x + v[j].y * v[j].y) + (v[j].z * v[j].z + v[j].w * v[j].w); }
        const float rstd = 1.f / sqrtf(wave_sum(s2) * (1.f / DM) + LN_EPS);
        if (F.lane == 0) { F.ST1()[2 * m] = mean; F.ST1()[2 * m + 1] = rstd; }
        LAS float* mod = pl + 2 * DM + (m / SEQ) * (2 * DM);
        float am = 0.f;
#pragma unroll
        for (int j = 0; j < 16; ++j) { if ((j & 3) == 0) asm volatile("" ::: "memory");
            const unsigned lb = 32u * (unsigned)F.lane; const int cj = 512 * (j >> 1) + 4 * (j & 1);
            const f32x4 gg = ldl(pl, lb, cj), bb = ldl(pl, lb, DM + cj), sh = ldl(mod, lb, cj), sc = ldl(mod, lb, DM + cj);
            const f32x4 h = v[j] * rstd * gg + bb; const f32x4 u = h * (sc + 1.0f) + sh; v[j] = u; am = fmaxf(am, amax4(u)); }
        am = wave_max(am); const float inv = am > 0.f ? 127.0f / am : 0.f;
        if (F.lane == 0) F.SA_U1()[m] = am * (1.0f / 127.0f);
        GAS v2u* oq = (GAS v2u*)(F.U1Q() + (size_t)m * DM) + F.lane;
#pragma unroll
        for (int j = 0; j < 8; ++j) { v2u o; o.x = q4(v[2 * j], inv); o.y = q4(v[2 * j + 1], inv); oq[64 * j] = o; }
    }
}
template <bool FILL> __device__ __forceinline__ void p11_rows(Frame& F0) {
    Frame F = F0; rethread(F);
    const float* const ln2_g_p = F.ln2_g();
    const float* const ln2_b_p = F.ln2_b();
    float* const out_p = F.out();
    const int gw = F.vcu * NWAVES + F.wave, NGW = F.G * NWAVES;
    LAS float* pl = (LAS float*)(F.lds + RING_OFF);
    if (FILL) { lds_fill(pl, ln2_g_p, DM, F.tid); lds_fill(pl + DM, ln2_b_p, DM, F.tid); }
    __syncthreads();
    for (int m = gw; m < M; m += NGW) {
        const GAS v4u* xr = (const GAS v4u*)(F.H0B() + (size_t)m * DM) + F.lane;
        f32x4 v[16]; float s = 0.f;
#pragma unroll
        for (int j = 0; j < 8; ++j) { const v4u w = xr[64 * j]; v[2 * j] = (f32x4){bflo(w.x), bfhi(w.x), bflo(w.y), bfhi(w.y)}; v[2 * j + 1] = (f32x4){bflo(w.z), bfhi(w.z), bflo(w.w), bfhi(w.w)}; }
#pragma unroll
        for (int j = 0; j < 16; ++j) s += (v[j].x + v[j].y) + (v[j].z + v[j].w);
        const float mean = wave_sum(s) * (1.f / DM); float s2 = 0.f;
#pragma unroll
        for (int j = 0; j < 16; ++j) { v[j] = v[j] - mean; s2 += (v[j].x * v[j].x + v[j].y * v[j].y) + (v[j].z * v[j].z + v[j].w * v[j].w); }
        const float rstd = 1.f / sqrtf(wave_sum(s2) * (1.f / DM) + LN_EPS);
        GAS f32x4* orow = (GAS f32x4*)(out_p + (size_t)m * DM) + 2 * F.lane;
#pragma unroll
        for (int j = 0; j < 16; ++j) { if ((j & 3) == 0) asm volatile("" ::: "memory");
            const unsigned lb = 32u * (unsigned)F.lane; const int cj = 512 * (j >> 1) + 4 * (j & 1);
            const f32x4 gg = ldl(pl, lb, cj), bb = ldl(pl, lb, DM + cj);
            orow[128 * (j >> 1) + (j & 1)] = v[j] * rstd * gg + bb; }
    }
}

__device__ __forceinline__ void pre_fill_sync() { asm volatile("s_waitcnt vmcnt(0) lgkmcnt(0)" ::: "memory"); __syncthreads(); }
__device__ __forceinline__ void p6_fill(Frame& F0) { Frame F = F0; rethread(F); LAS float* pl = (LAS float*)(F.lds + RING_OFF); lds_fill(pl, F.gn_a(), 2048, F.tid); lds_fill(pl + 2048, F.gn_b(), 2048, F.tid); }
__device__ __forceinline__ void p8_fill(Frame& F0) { Frame F = F0; rethread(F); LAS float* pl = (LAS float*)(F.lds + RING_OFF); lds_fill(pl, F.ln1_g(), DM, F.tid); lds_fill(pl + DM, F.ln1_b(), DM, F.tid);
    lds_fill(pl + 2 * DM, F.MOD() + 3 * DM, 2 * DM, F.tid); lds_fill(pl + 4 * DM, F.MOD() + 9 * DM, 2 * DM, F.tid); }
__device__ __forceinline__ void p11_fill(Frame& F0) { Frame F = F0; rethread(F); LAS float* pl = (LAS float*)(F.lds + RING_OFF); lds_fill(pl, F.ln2_g(), DM, F.tid); lds_fill(pl + DM, F.ln2_b(), DM, F.tid); }

__global__ void __launch_bounds__(NWAVES * 64, 2) hybrid_fwd(Args args) {
    extern __shared__ __attribute__((aligned(16))) unsigned char lds[];
    Frame F;
    F.lds = (LAS unsigned char*)lds;
    F.MISC = (volatile LAS unsigned*)(F.lds + MISC_OFF);
    F.wave = __builtin_amdgcn_readfirstlane((int)threadIdx.x >> 6); rethread(F);
#define REFRAME() do { const unsigned char CAS* kp_ = (const unsigned char CAS*)__builtin_amdgcn_kernarg_segment_ptr(); asm volatile("" : "+s"(kp_)); \
        F.ws = *(unsigned char* const CAS*)(kp_ + 160); F.ctl = (gu32*)(F.ws + WS_CTL); \
        unsigned gd_ = gridDim.x; asm volatile("" : "+s"(gd_)); F.G = (int)gd_; \
        { const int bx = blockIdx.x; F.vcu = (F.G % 8 == 0) ? (bx % 8) * (F.G / 8) + bx / 8 : bx; } } while (0)
    REFRAME();
    for (int u = F.tid; u < (LDS_BYTES - LDSCTL_OFF) / 4; u += NWAVES * 64) ((LAS unsigned*)(F.lds + LDSCTL_OFF))[u] = 0u;
    __syncthreads();
    if (N_LAUNCHES == 1) (void)xcd_barrier_post((unsigned*)(F.ctl + CW_BAR), F.MISC + 8, F.tid == 0);
#define GRID_BAR() do { if (N_LAUNCHES == 1) { REFRAME(); XcdBarrier bar_; bar_.bar = (unsigned*)(F.ctl + CW_BAR); bar_.x = xb_xcc_id(); bar_.st = F.MISC + 8; xcd_barrier(bar_, F.wave == 0 && lane_now() == 0); REFRAME(); } } while (0)
#ifndef PH_MASK
#define PH_MASK 0xfff
#endif
#if MK_N_LAUNCHES == 1
#define IN(k) (((PH_MASK) >> (k)) & 1)
#else
    const int lo = args.ph_lo, hi = args.ph_hi;
#define IN(k) ((((PH_MASK) >> (k)) & 1) && lo <= (k) && (k) < hi)
#endif
#define BOTH(k) (IN(k) && IN((k) + 1))
#ifndef PROBE_PH
#define PROBE_PH -1
#endif
#define REP(k) for (int rep_ = 0; rep_ < ((PROBE_PH == (k)) ? 2 : 1); ++rep_)

    if (IN(0)) { REP(0) { p0_prologue(F); __syncthreads(); } if (BOTH(0)) GRID_BAR(); }
    if (IN(1)) { p1a_modsum(F); GRID_BAR(); REP(1) p1_rows(F); if (BOTH(1)) GRID_BAR(); }
    if (IN(2)) { REP(2) {
        { pg8::Gemm g{(const u16*)F.UQ(), (const u16*)F.WIN_Q(), M, NP_BF, DM / 2, DM / 2}; pg8::StaticOrder S; S.init(M, NP_BF, F.G, (int)blockIdx.x);
          pg8::EpiQBf16<0> E{F.PROJ(), NP_BF, F.SA_U(), F.SW()};
          pg8::gemm_phase<pg8::EpiQBf16<0>, pg8::StaticOrder, 2, false, PG8_ALIGN, PG8_SP2>(F.lds + RING_OFF, g, S, E, F.wave * 64 + lane_now()); }
        { pg8::Gemm g{F.UH(), F.WIN_H(), M, 2048, DM, DM}; pg8::StaticOrder S; S.init(M, 2048, F.G, (int)blockIdx.x);
          pg8::EpiIdx E{F.IQ()};
          pg8::gemm_phase<pg8::EpiIdx, pg8::StaticOrder, 1, false, PG8_ALIGN, PG8_SP2>(F.lds + RING_OFF, g, S, E, F.wave * 64 + lane_now()); }
        { pg8::Gemm g{F.UH(), F.WIN_H() + (size_t)2048 * DM, M, 4 * 256, DM / 4, DM}; pg8::StaticOrder S; S.init(M, 4 * 256, F.G, (int)blockIdx.x);
          pg8::EpiTail E{F.IKWP(), (size_t)M * 128};
          pg8::gemm_phase<pg8::EpiTail, pg8::StaticOrder, 1, true, PG8_ALIGN, PG8_SP2>(F.lds + RING_OFF, g, S, E, F.wave * 64 + lane_now()); } }
        if (BOTH(2)) GRID_BAR();
    }
    if (IN(3)) { p3_kq8(F); p3_ikn(F); REP(3) sb_fast(F); if (BOTH(3)) GRID_BAR(); }
    if (IN(4)) { REP(4) { idx_fast(F); __syncthreads(); } if (BOTH(4)) GRID_BAR(); }
    if (IN(5)) { REP(5) { sparse_fast(F); __syncthreads(); } if (BOTH(5)) { if (IN(6)) p6_fill(F); GRID_BAR(); } }
    if (IN(6)) { REP(6) p6_norm<!(IN(5) && N_LAUNCHES == 1 && PROBE_PH != 6)>(F); if (BOTH(6)) GRID_BAR(); }
    if (IN(7)) { REP(7) {
        pg8::Gemm g{(const u16*)F.ONQ(), (const u16*)F.WOUT_Q(), M, DM, DM / 2, DM / 2}; pg8::StaticOrder S; S.init(M, DM, F.G, (int)blockIdx.x);
        pg8::EpiOut E{F.H0B(), F.MOD() + 2 * DM, F.V1B(), F.SA_ON(), F.SW() + NP_BF};
        pg8::gemm_phase<pg8::EpiOut, pg8::StaticOrder, 2, false, PG8_ALIGN, PG8_SP2>(F.lds + RING_OFF, g, S, E, F.wave * 64 + lane_now()); }
        if (BOTH(7)) { if (IN(8)) { pre_fill_sync(); p8_fill(F); } GRID_BAR(); }
    }
    if (IN(8)) { REP(8) p8_rows<!(IN(7) && N_LAUNCHES == 1 && PROBE_PH != 8)>(F); if (BOTH(8)) GRID_BAR(); }
#ifndef PROBE_GK
#define PROBE_GK 0
#endif
    if (IN(9) && PROBE_GK == 2) {
        struct SameOrder { __device__ bool next(int i, pg8::Unit& u) const { u.pm = 0; u.pn = 0; return i < 16; } __device__ void a_ready(const pg8::Unit&) const {} __device__ void done(const pg8::Unit&) const {} };
        pg8::Gemm g{(const u16*)F.U1Q(), (const u16*)F.WUP_Q(), M, DFF, DM / 2, DM / 2}; SameOrder S;
        pg8::EpiQF8 E{F.HID8(), DFF, F.SA_U1(), F.SW() + NP_BF + DM};
        pg8::gemm_phase<pg8::EpiQF8, SameOrder, 2, false, PG8_ALIGN, PG8_SP2>(F.lds + RING_OFF, g, S, E, F.wave * 64 + lane_now());
        __syncthreads();
    }
    if (IN(9) && PROBE_GK == 1) {
        pg8::Gemm g{(const u16*)F.U1Q(), (const u16*)F.WUP_Q(), M, DFF, DM / 4, DM / 2}; pg8::StaticOrder S; S.init(M, DFF, F.G, (int)blockIdx.x);
        pg8::EpiQF8 E{F.HID8(), DFF, F.SA_U1(), F.SW() + NP_BF + DM};
        pg8::gemm_phase<pg8::EpiQF8, pg8::StaticOrder, 2, false, PG8_ALIGN, PG8_SP2>(F.lds + RING_OFF, g, S, E, F.wave * 64 + lane_now());
        __syncthreads();
    }
    if (IN(9)) { REP(9) {
        pg8::Gemm g{(const u16*)F.U1Q(), (const u16*)F.WUP_Q(), M, DFF, DM / 2, DM / 2}; pg8::StaticOrder S; S.init(M, DFF, F.G, (int)blockIdx.x);
        pg8::EpiQF8 E{F.HID8(), DFF, F.SA_U1(), F.SW() + NP_BF + DM};
        pg8::gemm_phase<pg8::EpiQF8, pg8::StaticOrder, 2, false, PG8_ALIGN, PG8_SP2>(F.lds + RING_OFF, g, S, E, F.wave * 64 + lane_now()); }
        if (BOTH(9)) GRID_BAR();
    }
    if (IN(10)) {
        pg8::Gemm g{(const u16*)F.HID8(), (const u16*)F.WDOWN8(), M, DM, DFF / 2, DFF / 2}; pg8::StaticOrder S; S.init(M, DM, F.G, (int)blockIdx.x);
        pg8::EpiDown E{F.MOD() + 5 * DM, F.H0B()  , F.ST1(), F.ln1_g(), F.ln1_b(), F.SW() + NP_BF + DM + DFF, F.V1B()};
        pg8::gemm_phase<pg8::EpiDown, pg8::StaticOrder, 3, false, PG8_ALIGN, PG8_SP2>(F.lds + RING_OFF, g, S, E, F.wave * 64 + lane_now());
        if (BOTH(10)) { if (IN(11)) { pre_fill_sync(); p11_fill(F); } GRID_BAR(); }
    }
    if (IN(11)) { p11_rows<!(IN(10) && N_LAUNCHES == 1)>(F); }
#undef IN
#undef BOTH
}

extern "C" void kernel_launch(void* const* d_in, const int* in_sizes, int n_in, void* d_out, int out_size, void* d_ws, size_t ws_size, hipStream_t stream) {
    static int grid = 0;
    if (grid == 0) {
        if (n_in != 19 || in_sizes[0] != M * DM || out_size != M * DM || ws_size < WS_END) { fprintf(stderr, "kernel_launch: unexpected shapes (n_in %d, in0 %d, out %d, ws %zu, need %zu); nothing launched\n", n_in, n_in > 0 ? in_sizes[0] : -1, out_size, ws_size, (size_t)WS_END); grid = -1; return; }
        int dev = 0, cus = 0, per_cu = 0;
        if (hipGetDevice(&dev) != hipSuccess || hipDeviceGetAttribute(&cus, hipDeviceAttributeMultiprocessorCount, dev) != hipSuccess) { fprintf(stderr, "kernel_launch: device query failed\n"); grid = -1; return; }
        if (hipFuncSetAttribute((const void*)hybrid_fwd, hipFuncAttributeMaxDynamicSharedMemorySize, LDS_BYTES) != hipSuccess) { fprintf(stderr, "kernel_launch: hipFuncSetAttribute failed\n"); grid = -1; return; }
        if (hipOccupancyMaxActiveBlocksPerMultiprocessor(&per_cu, (const void*)hybrid_fwd, NWAVES * 64, LDS_BYTES) != hipSuccess || per_cu < 1)
            fprintf(stderr, "kernel_launch: note: occupancy query reports %d workgroups per CU\n", per_cu);
        (void)hipGetLastError();
        grid = cus & ~7;
    }
    if (grid < 0) return;
    if (hipMemsetAsync((char*)d_ws + WS_CTL, 0, CTL_ZERO_BYTES, stream) != hipSuccess) { fprintf(stderr, "kernel_launch: memset failed\n"); return; }
    Args a{};
    for (int i = 0; i < 19; ++i) a.in[i] = (const float*)d_in[i];
    a.out = (float*)d_out; a.ws = (unsigned char*)d_ws;
    for (int li = 0; li < N_LAUNCHES; ++li) {
        a.ph_lo = (N_LAUNCHES == 1) ? 0 : li; a.ph_hi = (N_LAUNCHES == 1) ? N_PHASES : li + 1; a.li = li; a.pad = 0;
        hipLaunchKernelGGL(hybrid_fwd, dim3(grid), dim3(NWAVES * 64), LDS_BYTES, stream, a);
        const hipError_t le = hipPeekAtLastError();
        if (le != hipSuccess) { fprintf(stderr, "kernel_launch: launch %d failed: %s\n", li, hipGetErrorName(le)); break; }
    }
}
```

```cpp
#include <hip/hip_runtime.h>
#include <cstdio>
#include <cstdint>
#include <cmath>
namespace pg8 {
#define PG8_LAS __attribute__((address_space(3)))
typedef unsigned short bf16_t;
typedef short bf16x8 __attribute__((ext_vector_type(8)));
typedef float f32x4 __attribute__((ext_vector_type(4)));
typedef unsigned u32x4 __attribute__((ext_vector_type(4)));
constexpr int BM = 256, BK = 64, HALF = 128, HTB = HALF * BK * 2  , STAGE_BYTES = 8 * HTB, NXCD = 8, WGM = 8;

__host__ __device__ __forceinline__ int lds_byte(int r, int c) { const int st = (r >> 4) * 2 + (c >> 5), rr = r & 15, cc = c & 31, ob = rr * 64 + cc * 2; return st * 1024 + (ob ^ (((ob >> 9) & 1) << 5)); }
__host__ __device__ __forceinline__ void stage_rc(int b, int& R, int& C) { const int st = b / 1024, sb = b % 1024, swz = sb ^ (((sb >> 9) & 1) << 5); R = (st >> 1) * 16 + swz / 64; C = (st & 1) * 32 + (swz % 64) / 2; }
__host__ __device__ __forceinline__ int perm32(int rho) { const int n = rho >> 4, i = rho & 15; return 8 * (i >> 2) + 4 * n + (i & 3); }

struct Unit { int pm, pn; };
struct Gemm { const bf16_t* A; const bf16_t* Bt; int M, N, K, ld; };

struct StaticOrder {
    int nM, nN, nwg, G, c;
    __host__ __device__ void init(int M, int N, int G_, int c_) { nM = M / BM; nN = N / BM; nwg = nM * nN; G = G_; c = c_; }
    __host__ __device__ bool next(int i, Unit& u) const {
        const long L = (long)i * G + c; if (L >= nwg) return false;
        int wgid = (int)L; { const int q = nwg / NXCD, r = nwg % NXCD, xcd = wgid % NXCD, off = wgid / NXCD; wgid = (xcd < r ? xcd * (q + 1) : r * (q + 1) + (xcd - r) * q) + off; }
        const int nig = WGM * nN, gid = wgid / nig, fm = gid * WGM, gsz = (nM - fm) < WGM ? (nM - fm) : WGM;
        u.pm = fm + ((wgid % nig) % gsz); u.pn = (wgid % nig) / gsz; return true;
    }
    __device__ __forceinline__ void a_ready(const Unit&) const {}
    __device__ __forceinline__ void done(const Unit&) const {}
};

typedef float cvt_f2 __attribute__((ext_vector_type(2)));
typedef __bf16 cvt_b2 __attribute__((ext_vector_type(2)));
__device__ __forceinline__ unsigned cvt_pk_bf16(float lo, float hi) { const cvt_f2 v = {lo, hi}; const cvt_b2 r = __builtin_convertvector(v, cvt_b2); return __builtin_bit_cast(unsigned, r); }
constexpr float EPI_ALPHA = 1.189207115002721f;
constexpr long long EPI_BQ_OFF = 640ll << 20, EPI_BK_OFF = -(128ll << 20), EPI_BV_OFF = -(64ll << 20);
constexpr int EPI_SEQ = 8192, EPI_GSTRIDE = 6 * 4096;
typedef _Float16 f16x8 __attribute__((ext_vector_type(8)));
typedef _Float16 f16x2 __attribute__((ext_vector_type(2)));
typedef unsigned u32x2 __attribute__((ext_vector_type(2)));
__device__ __forceinline__ unsigned cvt_pk_f16(float lo, float hi) { f16x2 h; h.x = (_Float16)lo; h.y = (_Float16)hi; return __builtin_bit_cast(unsigned, h); }
typedef int i32x4 __attribute__((ext_vector_type(4)));
template <int MODE> __device__ __forceinline__ f32x4 mma16(bf16x8 a, bf16x8 b, f32x4 c) {
    if constexpr (MODE == 1) return __builtin_amdgcn_mfma_f32_16x16x32_f16(__builtin_bit_cast(f16x8, a), __builtin_bit_cast(f16x8, b), c, 0, 0, 0);
    else if constexpr (MODE == 2) return __builtin_bit_cast(f32x4, __builtin_amdgcn_mfma_i32_16x16x64_i8(__builtin_bit_cast(i32x4, a), __builtin_bit_cast(i32x4, b), __builtin_bit_cast(i32x4, c), 0, 0, 0));
    else return __builtin_amdgcn_mfma_f32_16x16x32_bf16(a, b, c, 0, 0, 0);
}
typedef int i32x8 __attribute__((ext_vector_type(8)));
__device__ __forceinline__ f32x4 mma_f8(bf16x8 a0, bf16x8 a1, bf16x8 b0, bf16x8 b1, f32x4 c) {
    const i32x4 x0 = __builtin_bit_cast(i32x4, a0), x1 = __builtin_bit_cast(i32x4, a1), y0 = __builtin_bit_cast(i32x4, b0), y1 = __builtin_bit_cast(i32x4, b1);
    const i32x8 a = {x0[0], x0[1], x0[2], x0[3], x1[0], x1[1], x1[2], x1[3]}, b = {y0[0], y0[1], y0[2], y0[3], y1[0], y1[1], y1[2], y1[3]};
    const int sc1 = 0x7f7f7f7f;
    asm volatile("v_mfma_scale_f32_16x16x128_f8f6f4 %0, %1, %2, %0, %3, %3 op_sel_hi:[0,0,0]" : "+v"(c) : "v"(a), "v"(b), "v"(sc1));
    return c;
}
__device__ __forceinline__ f32x4 acc_i2f(const f32x4 a) { return __builtin_convertvector(__builtin_bit_cast(i32x4, a), f32x4); }

template <int ACT  > struct EpiBf16 {
    static constexpr bool PERM = true, AFTER_DRAIN = false;
    bf16_t* O; int ldc;
    __device__ __forceinline__ void operator()(const f32x4 (&acc)[2][2][4][2], const Unit& u, int wr, int wc, int fr, int fq) const {
        const int row0 = u.pm * BM + wr * 64 + fr; const int col0 = u.pn * BM + wc * 32 + 8 * fq;
#pragma unroll
        for (int ai = 0; ai < 2; ++ai)
#pragma unroll
            for (int m = 0; m < 4; ++m) { bf16_t* rowp = O + (size_t)(row0 + ai * HALF + m * 16) * ldc + col0;
#pragma unroll
                for (int bj = 0; bj < 2; ++bj) { f32x4 v0 = acc[ai][bj][m][0], v1 = acc[ai][bj][m][1];
                    if (ACT == 1) {
#pragma unroll
                        for (int j = 0; j < 4; ++j) { const float a = fmaxf(v0[j], 0.f), b = fmaxf(v1[j], 0.f); v0[j] = a * a; v1[j] = b * b; } }
                    u32x4 w; w.x = cvt_pk_bf16(v0[0], v0[1]); w.y = cvt_pk_bf16(v0[2], v0[3]); w.z = cvt_pk_bf16(v1[0], v1[1]); w.w = cvt_pk_bf16(v1[2], v1[3]);
                    *(u32x4*)(rowp + bj * HALF) = w; } }
    }
};
struct EpiIdx {
    static constexpr bool PERM = true, AFTER_DRAIN = false;
    bf16_t* IQ;
    __device__ __forceinline__ void operator()(const f32x4 (&acc)[2][2][4][2], const Unit& u, int wr, int wc, int fr, int fq) const {
        const int row0 = u.pm * BM + wr * 64 + fr; const int col0 = u.pn * BM + wc * 32 + 8 * fq;
#pragma unroll
        for (int ai = 0; ai < 2; ++ai)
#pragma unroll
            for (int m = 0; m < 4; ++m) { bf16_t* rowp = IQ + (size_t)(row0 + ai * HALF + m * 16) * 2048 + col0;
#pragma unroll
                for (int bj = 0; bj < 2; ++bj) { const f32x4 v0 = acc[ai][bj][m][0], v1 = acc[ai][bj][m][1];
                    u32x4 w; w.x = cvt_pk_f16(v0[0], v0[1]); w.y = cvt_pk_f16(v0[2], v0[3]); w.z = cvt_pk_f16(v1[0], v1[1]); w.w = cvt_pk_f16(v1[2], v1[3]);
                    *(u32x4*)(rowp + bj * HALF) = w; } }
    }
};
struct EpiTail {
    static constexpr bool PERM = true, AFTER_DRAIN = false;
    float* IKWP; size_t qstride;
    __device__ __forceinline__ void operator()(const f32x4 (&acc)[2][2][4][2], const Unit& u, int wr, int wc, int fr, int fq) const {
        const int row0 = u.pm * BM + wr * 64 + fr; const int col0 = wc * 32 + 8 * fq;
        float* base = IKWP + (size_t)u.pn * qstride;
#pragma unroll
        for (int ai = 0; ai < 2; ++ai)
#pragma unroll
            for (int m = 0; m < 4; ++m) { float* rowp = base + (size_t)(row0 + ai * HALF + m * 16) * 128 + col0;
                *(f32x4*)(rowp) = acc[ai][0][m][0]; *(f32x4*)(rowp + 4) = acc[ai][0][m][1]; }
    }
};
template <int ACT  > struct EpiQBf16 {
    static constexpr bool PERM = true, AFTER_DRAIN = false;
    bf16_t* O; int ldc; const float* sa; const float* sb;
    __device__ __forceinline__ void operator()(const f32x4 (&acc)[2][2][4][2], const Unit& u, int wr, int wc, int fr, int fq) const {
        const int row0 = u.pm * BM + wr * 64 + fr; const int col0 = u.pn * BM + wc * 32 + 8 * fq;
        f32x4 sbv[2][2];
#pragma unroll
        for (int bj = 0; bj < 2; ++bj)
#pragma unroll
            for (int n = 0; n < 2; ++n) sbv[bj][n] = *(const f32x4*)(sb + col0 + bj * HALF + 4 * n);
#pragma unroll
        for (int ai = 0; ai < 2; ++ai)
#pragma unroll
            for (int m = 0; m < 4; ++m) { const int r = row0 + ai * HALF + m * 16; const float sr = sa[r]; bf16_t* rowp = O + (size_t)r * ldc + col0;
                if (u.pn >= 12) {
                    const int cb = u.pn * BM - 3072, wh = cb >> 11, hd = (cb & 2047) >> 7;
                    bf16_t* hbp = (bf16_t*)((char*)O + (wh == 0 ? EPI_BQ_OFF : (wh == 1 ? EPI_BK_OFF : EPI_BV_OFF)));
                    rowp = hbp + ((size_t)((r / EPI_SEQ) * 16 + hd) * EPI_SEQ + (r % EPI_SEQ)) * 128 + (col0 & 127); }
#pragma unroll
                for (int bj = 0; bj < 2; ++bj) { f32x4 v0 = acc_i2f(acc[ai][bj][m][0]) * sr * sbv[bj][0], v1 = acc_i2f(acc[ai][bj][m][1]) * sr * sbv[bj][1];
                    if (ACT == 1) {
#pragma unroll
                        for (int j = 0; j < 4; ++j) { const float a = fmaxf(v0[j], 0.f), b = fmaxf(v1[j], 0.f); v0[j] = a * a; v1[j] = b * b; } }
                    u32x4 w; w.x = cvt_pk_bf16(v0[0], v0[1]); w.y = cvt_pk_bf16(v0[2], v0[3]); w.z = cvt_pk_bf16(v1[0], v1[1]); w.w = cvt_pk_bf16(v1[2], v1[3]);
                    *(u32x4*)(rowp + (u.pn >= 12 ? bj * (EPI_SEQ * 128) : bj * HALF)) = w; } }
    }
};
constexpr float EPI_HSCALE = 8.0f;
struct EpiQF8 {
    static constexpr bool PERM = true, AFTER_DRAIN = false;
    unsigned char* O; int ldc; const float* sa; const float* sb;
    __device__ __forceinline__ void operator()(const f32x4 (&acc)[2][2][4][2], const Unit& u, int wr, int wc, int fr, int fq) const {
        const int row0 = u.pm * BM + wr * 64 + fr; const int col0 = u.pn * BM + wc * 32 + 8 * fq;
        f32x4 sbv[2][2];
#pragma unroll
        for (int bj = 0; bj < 2; ++bj)
#pragma unroll
            for (int n = 0; n < 2; ++n) sbv[bj][n] = *(const f32x4*)(sb + col0 + bj * HALF + 4 * n) * __builtin_sqrtf(EPI_HSCALE);
        const int colw = u.pn * BM + wc * 32 + 8 * (fq & ~1);
#pragma unroll
        for (int ai = 0; ai < 2; ++ai)
#pragma unroll
            for (int mp = 0; mp < 4; mp += 2) { const int ra = row0 + ai * HALF + mp * 16, rb = ra + 16; const float sra = sa[ra], srb = sa[rb];
                unsigned char* rowp = O + (size_t)((fq & 1) ? rb : ra) * ldc + colw;
#pragma unroll
                for (int bj = 0; bj < 2; ++bj) { u32x2 wab[2];
#pragma unroll
                    for (int h = 0; h < 2; ++h) { const float sr = h ? srb : sra;
                        f32x4 v0 = acc_i2f(acc[ai][bj][mp + h][0]) * sr * sbv[bj][0], v1 = acc_i2f(acc[ai][bj][mp + h][1]) * sr * sbv[bj][1];
#pragma unroll
                        for (int j = 0; j < 4; ++j) { v0[j] = __builtin_amdgcn_fmed3f(v0[j], 0.f, 20.976176963403f); v1[j] = __builtin_amdgcn_fmed3f(v1[j], 0.f, 20.976176963403f); }
                        v0 = v0 * v0; v1 = v1 * v1;
                        int w0 = 0, w1 = 0;
                        w0 = __builtin_amdgcn_cvt_pk_fp8_f32(v0[0], v0[1], w0, false); w0 = __builtin_amdgcn_cvt_pk_fp8_f32(v0[2], v0[3], w0, true);
                        w1 = __builtin_amdgcn_cvt_pk_fp8_f32(v1[0], v1[1], w1, false); w1 = __builtin_amdgcn_cvt_pk_fp8_f32(v1[2], v1[3], w1, true);
                        wab[h].x = (unsigned)w0; wab[h].y = (unsigned)w1; }
                    const auto sx = __builtin_amdgcn_permlane16_swap(wab[0].x, wab[1].x, false, false); const auto sy = __builtin_amdgcn_permlane16_swap(wab[0].y, wab[1].y, false, false);
                    const unsigned sx0 = sx[0], sx1 = sx[1], sy0 = sy[0], sy1 = sy[1];
                    u32x4 w; w.x = sx0; w.y = sy0; w.z = sx1; w.w = sy1; *(u32x4*)(rowp + bj * HALF) = w; } }
    }
};
struct EpiOut {
    static constexpr bool PERM = true, AFTER_DRAIN = false;
    const bf16_t* h0; const float* gate; bf16_t* v1; const float* sa; const float* sb;
    __device__ __forceinline__ void operator()(const f32x4 (&acc)[2][2][4][2], const Unit& u, int wr, int wc, int fr, int fq) const {
        const int row0 = u.pm * BM + wr * 64 + fr, col0 = u.pn * BM + wc * 32 + 8 * fq;
        const float* gt = gate + (size_t)((u.pm * BM) / EPI_SEQ) * EPI_GSTRIDE;
        f32x4 gv[2][2];
#pragma unroll
        for (int bj = 0; bj < 2; ++bj)
#pragma unroll
            for (int n = 0; n < 2; ++n) { const int c = col0 + bj * HALF + 4 * n; gv[bj][n] = *(const f32x4*)(gt + c) * *(const f32x4*)(sb + c); }
#pragma unroll
        for (int ai = 0; ai < 2; ++ai)
#pragma unroll
            for (int m = 0; m < 4; ++m) { const int r = row0 + ai * HALF + m * 16; const float sr = sa[r]; const size_t off = (size_t)r * 4096 + col0;
#pragma unroll
                for (int bj = 0; bj < 2; ++bj) { const u32x4 hw = *(const u32x4*)(h0 + off + bj * HALF);
                    const f32x4 ha = {__builtin_bit_cast(float, hw.x << 16), __builtin_bit_cast(float, hw.x & 0xffff0000u), __builtin_bit_cast(float, hw.y << 16), __builtin_bit_cast(float, hw.y & 0xffff0000u)};
                    const f32x4 hb = {__builtin_bit_cast(float, hw.z << 16), __builtin_bit_cast(float, hw.z & 0xffff0000u), __builtin_bit_cast(float, hw.w << 16), __builtin_bit_cast(float, hw.w & 0xffff0000u)};
                    const f32x4 v0 = ha * EPI_ALPHA + gv[bj][0] * (acc_i2f(acc[ai][bj][m][0]) * sr), vb = hb * EPI_ALPHA + gv[bj][1] * (acc_i2f(acc[ai][bj][m][1]) * sr);
                    u32x4 w; w.x = cvt_pk_bf16(v0[0], v0[1]); w.y = cvt_pk_bf16(v0[2], v0[3]); w.z = cvt_pk_bf16(vb[0], vb[1]); w.w = cvt_pk_bf16(vb[2], vb[3]);
                    *(u32x4*)(v1 + off + bj * HALF) = w; }
                if (m == 3) asm volatile("" ::: "memory"); }
    }
};
struct EpiDown {
    static constexpr bool PERM = true, AFTER_DRAIN = false;
    const float* gate; bf16_t* v2; const float* st1; const float* lng; const float* lnb; const float* sb; const bf16_t* v1;
    __device__ __forceinline__ void operator()(const f32x4 (&acc)[2][2][4][2], const Unit& u, int wr, int wc, int fr, int fq) const {
        const int row0 = u.pm * BM + wr * 64 + fr, col0 = u.pn * BM + wc * 32 + 8 * fq;
        const float* gt = gate + (size_t)((u.pm * BM) / EPI_SEQ) * EPI_GSTRIDE;
#pragma unroll
        for (int bj = 0; bj < 2; ++bj) {
            asm volatile("" ::: "memory");
            f32x4 gv[2], lg[2], lb[2];
#pragma unroll
            for (int n = 0; n < 2; ++n) { const int c = col0 + bj * HALF + 4 * n; gv[n] = *(const f32x4*)(gt + c) * *(const f32x4*)(sb + c) * (1.0f / EPI_HSCALE); lg[n] = *(const f32x4*)(lng + c); lb[n] = *(const f32x4*)(lnb + c); }
#pragma unroll
            for (int ai = 0; ai < 2; ++ai)
#pragma unroll
                for (int m = 0; m < 4; ++m) { const int r = row0 + ai * HALF + m * 16; const float mean = st1[2 * r], rstd = st1[2 * r + 1]; const size_t off = (size_t)r * 4096 + col0 + bj * HALF;
                    const u32x4 hw = *(const u32x4*)(v1 + off);
                    const f32x4 ha = {__builtin_bit_cast(float, hw.x << 16), __builtin_bit_cast(float, hw.x & 0xffff0000u), __builtin_bit_cast(float, hw.y << 16), __builtin_bit_cast(float, hw.y & 0xffff0000u)};
                    const f32x4 hb = {__builtin_bit_cast(float, hw.z << 16), __builtin_bit_cast(float, hw.z & 0xffff0000u), __builtin_bit_cast(float, hw.w << 16), __builtin_bit_cast(float, hw.w & 0xffff0000u)};
                    const f32x4 o0 = ((ha - mean) * rstd * lg[0] + lb[0]) * EPI_ALPHA + gv[0] * acc[ai][bj][m][0], o1 = ((hb - mean) * rstd * lg[1] + lb[1]) * EPI_ALPHA + gv[1] * acc[ai][bj][m][1];
                    u32x4 w; w.x = cvt_pk_bf16(o0[0], o0[1]); w.y = cvt_pk_bf16(o0[2], o0[3]); w.z = cvt_pk_bf16(o1[0], o1[1]); w.w = cvt_pk_bf16(o1[2], o1[3]);
                    *(u32x4*)(v2 + off) = w;
                    if (m & 1) asm volatile("" ::: "memory"); }
        }
    }
};

template <class Epi, class Sched, int MODE, bool KS, bool ALIGN_EPI, bool SP2>
__device__ __forceinline__ void gemm_phase(PG8_LAS unsigned char* lds, const Gemm g, const Sched& S, const Epi& E, const int tid  ) {
    const int wid = __builtin_amdgcn_readfirstlane(tid >> 6), lane = tid & 63, wr = wid >> 2, wc = wid & 3, fr = lane & 15, fq = lane >> 4;
    const int K = g.K, nt = K / BK, LD = g.ld;
    unsigned voffA[2], voffB[2];
#pragma unroll
    for (int i = 0; i < 2; ++i) { int R, C; stage_rc(tid * 16 + i * 8192, R, C); const int Rb = Epi::PERM ? ((R & ~31) + perm32(R & 31)) : R;
        voffA[i] = (unsigned)(R * LD + C) * 2u; voffB[i] = (unsigned)(Rb * LD + C) * 2u; }
    const size_t kstep = (size_t)(BK * 2);
    const size_t hstep = (size_t)HALF * LD * 2;
    const size_t tstep = 2 * hstep;
    const unsigned ldsw = (unsigned)wid * 1024u;
    const int aoff = lds_byte(wr * 64 + fr, fq * 8), boff = lds_byte(wc * 32 + fr, fq * 8);
#define PG8_SA(b, h) (((b) * 2 + (h)) * HTB)
#define PG8_SB(b, h) ((4 + (b) * 2 + (h)) * HTB)
#define PG8_STAGE(bufoff, gbase, voff) do { _Pragma("unroll") for (int _i = 0; _i < 2; ++_i) \
        __builtin_amdgcn_global_load_lds((const unsigned*)((const char*)(gbase) + (voff)[_i]), (PG8_LAS unsigned*)(lds + (bufoff) + ldsw + _i * 8192), 16, 0, 0); } while (0)
#define PG8_LDA(dst, b, h) do { _Pragma("unroll") for (int m = 0; m < 4; ++m) _Pragma("unroll") for (int k = 0; k < 2; ++k) dst[m][k] = *(const PG8_LAS bf16x8*)(lds + PG8_SA(b, h) + aoff + m * 2048 + k * 1024); } while (0)
#define PG8_LDB(dst, b, h) do { _Pragma("unroll") for (int n = 0; n < 2; ++n) _Pragma("unroll") for (int k = 0; k < 2; ++k) dst[n][k] = *(const PG8_LAS bf16x8*)(lds + PG8_SB(b, h) + boff + n * 2048 + k * 1024); } while (0)
#define PG8_MMA(ai, bj, At, Bt) do { __builtin_amdgcn_s_setprio(1); \
        if constexpr (MODE == 3) { _Pragma("unroll") for (int m = 0; m < 4; ++m) _Pragma("unroll") for (int n = 0; n < 2; ++n) acc[ai][bj][m][n] = mma_f8(Bt[n][0], Bt[n][1], At[m][0], At[m][1], acc[ai][bj][m][n]); } \
        else { _Pragma("unroll") for (int m = 0; m < 4; ++m) _Pragma("unroll") for (int n = 0; n < 2; ++n) _Pragma("unroll") for (int k = 0; k < 2; ++k) \
        acc[ai][bj][m][n] = mma16<MODE>(Bt[n][k], At[m][k], acc[ai][bj][m][n]); } __builtin_amdgcn_s_setprio(0); } while (0)
#define PG8_WAIT_V(n) asm volatile("s_waitcnt vmcnt(" #n ")" ::: "memory")
#define PG8_WAIT_L(n) asm volatile("s_waitcnt lgkmcnt(" #n ")" ::: "memory")
#define PG8_BAR __builtin_amdgcn_s_barrier()
#define PG8_SCHED __builtin_amdgcn_sched_barrier(0)
    Unit cur, nxt; int ui = 0;
    if (!S.next(0, cur)) return;
    f32x4 acc[2][2][4][2];
#pragma unroll
    for (int a = 0; a < 2; ++a)
#pragma unroll
        for (int b = 0; b < 2; ++b)
#pragma unroll
            for (int m = 0; m < 4; ++m)
#pragma unroll
                for (int n = 0; n < 2; ++n) acc[a][b][m][n] = (f32x4){0.f, 0.f, 0.f, 0.f};
    bf16x8 At[4][2], B0[2][2], B1[2][2];
#define PG8_APTR(u) ((const char*)g.A + (size_t)(u).pm * tstep + (KS ? (size_t)(u).pn * K * 2 : (size_t)0))
#define PG8_BPTR(u) ((const char*)g.Bt + (KS ? (size_t)(u).pn * K * 2 : (size_t)(u).pn * tstep))
    const char* cA = PG8_APTR(cur); const char* cB = PG8_BPTR(cur);
    S.a_ready(cur);
    if constexpr (SP2) {
        PG8_STAGE(PG8_SB(0, 0), cB, voffB); PG8_STAGE(PG8_SB(0, 1), cB + hstep, voffB); PG8_STAGE(PG8_SA(0, 0), cA, voffA); PG8_STAGE(PG8_SA(0, 1), cA + hstep, voffA);
        if (wr == 1) PG8_BAR;
        PG8_WAIT_V(2); PG8_BAR;
        PG8_STAGE(PG8_SB(1, 0), cB + kstep, voffB); PG8_STAGE(PG8_SA(1, 0), cA + kstep, voffA); PG8_STAGE(PG8_SB(1, 1), cB + hstep + kstep, voffB);
        PG8_WAIT_V(6); PG8_BAR;
    } else {
        PG8_STAGE(PG8_SB(0, 0), cB, voffB); PG8_STAGE(PG8_SA(0, 0), cA, voffA); PG8_STAGE(PG8_SB(0, 1), cB + hstep, voffB); PG8_STAGE(PG8_SA(0, 1), cA + hstep, voffA);
        if (wr == 1) PG8_BAR;
        PG8_WAIT_V(4); PG8_BAR;
        PG8_STAGE(PG8_SB(1, 0), cB + kstep, voffB); PG8_STAGE(PG8_SA(1, 0), cA + kstep, voffA); PG8_STAGE(PG8_SB(1, 1), cB + hstep + kstep, voffB);
        PG8_WAIT_V(6); PG8_BAR;
    }
    for (;;) {
        const bool has_next = S.next(ui + 1, nxt);
        const char* nA = has_next ? PG8_APTR(nxt) : cA; const char* nB = has_next ? PG8_BPTR(nxt) : cB;
        for (int t = 0; t < nt; t += 2) {
            const bool last = (t == nt - 2);
            const char* a1 = cA + (size_t)(t + 1) * kstep;
            const char* a2 = last ? nA : cA + (size_t)(t + 2) * kstep; const char* b2 = last ? nB : cB + (size_t)(t + 2) * kstep;
            const char* a3 = a2 + kstep; const char* b3 = b2 + kstep;
            if (last && has_next) S.a_ready(nxt);
            if constexpr (SP2) {
            PG8_LDB(B0, 0, 0); PG8_LDB(B1, 0, 1); PG8_SCHED; PG8_LDA(At, 0, 0); PG8_STAGE(PG8_SA(1, 1), a1 + hstep, voffA);
            PG8_WAIT_V(8); PG8_WAIT_L(0); PG8_BAR; PG8_MMA(0, 0, At, B0); PG8_MMA(0, 1, At, B1); PG8_BAR; PG8_SCHED;
            PG8_LDA(At, 0, 1); PG8_STAGE(PG8_SB(0, 0), b2, voffB); PG8_STAGE(PG8_SB(0, 1), b2 + hstep, voffB); PG8_STAGE(PG8_SA(0, 0), a2, voffA);
            PG8_WAIT_V(8); PG8_WAIT_L(0); PG8_BAR; PG8_MMA(1, 0, At, B0); PG8_MMA(1, 1, At, B1); PG8_BAR; PG8_SCHED;
            PG8_LDB(B0, 1, 0); PG8_LDB(B1, 1, 1); PG8_SCHED; PG8_LDA(At, 1, 0); PG8_STAGE(PG8_SA(0, 1), a2 + hstep, voffA);
            PG8_WAIT_V(8); PG8_WAIT_L(0); PG8_BAR; PG8_MMA(0, 0, At, B0); PG8_MMA(0, 1, At, B1); PG8_BAR; PG8_SCHED;
            PG8_LDA(At, 1, 1); PG8_STAGE(PG8_SB(1, 0), b3, voffB); PG8_STAGE(PG8_SB(1, 1), b3 + hstep, voffB); PG8_STAGE(PG8_SA(1, 0), a3, voffA);
            PG8_WAIT_V(8); PG8_WAIT_L(0); PG8_BAR; PG8_MMA(1, 0, At, B0); PG8_MMA(1, 1, At, B1); PG8_BAR; PG8_SCHED;
            } else {
            PG8_LDB(B0, 0, 0); PG8_SCHED; PG8_LDA(At, 0, 0); PG8_STAGE(PG8_SA(1, 1), a1 + hstep, voffA);
            PG8_WAIT_L(8); PG8_BAR; PG8_WAIT_L(0); PG8_MMA(0, 0, At, B0); PG8_BAR; PG8_SCHED;
            PG8_LDB(B1, 0, 1); PG8_STAGE(PG8_SB(0, 0), b2, voffB);
            PG8_BAR; PG8_WAIT_L(0); PG8_MMA(0, 1, At, B1); PG8_BAR;
            PG8_LDA(At, 0, 1); PG8_STAGE(PG8_SA(0, 0), a2, voffA);
            PG8_BAR; PG8_WAIT_L(0); PG8_MMA(1, 0, At, B0); PG8_BAR; PG8_SCHED;
            PG8_STAGE(PG8_SB(0, 1), b2 + hstep, voffB);
            PG8_WAIT_V(6); PG8_BAR; PG8_MMA(1, 1, At, B1); PG8_BAR;
            PG8_LDB(B0, 1, 0); PG8_SCHED; PG8_LDA(At, 1, 0); PG8_STAGE(PG8_SA(0, 1), a2 + hstep, voffA);
            PG8_WAIT_L(8); PG8_BAR; PG8_WAIT_L(0); PG8_MMA(0, 0, At, B0); PG8_BAR; PG8_SCHED;
            PG8_LDB(B1, 1, 1); PG8_STAGE(PG8_SB(1, 0), b3, voffB);
            PG8_BAR; PG8_WAIT_L(0); PG8_MMA(0, 1, At, B1); PG8_BAR;
            PG8_LDA(At, 1, 1); PG8_STAGE(PG8_SA(1, 0), a3, voffA);
            PG8_BAR; PG8_WAIT_L(0); PG8_MMA(1, 0, At, B0); PG8_BAR; PG8_SCHED;
            PG8_STAGE(PG8_SB(1, 1), b3 + hstep, voffB);
            PG8_WAIT_V(6); PG8_BAR; PG8_MMA(1, 1, At, B1); PG8_BAR;
            }
        }
        if constexpr (ALIGN_EPI) { if (wr == 0) PG8_BAR; }
        if constexpr (!Epi::AFTER_DRAIN) { E(acc, cur, wr, wc, fr, fq); S.done(cur); }
        if (!has_next) break;
#pragma unroll
        for (int a = 0; a < 2; ++a)
#pragma unroll
            for (int b = 0; b < 2; ++b)
#pragma unroll
                for (int m = 0; m < 4; ++m)
#pragma unroll
                    for (int n = 0; n < 2; ++n) acc[a][b][m][n] = (f32x4){0.f, 0.f, 0.f, 0.f};
        cur = nxt; cA = nA; cB = nB; ++ui;
        if constexpr (ALIGN_EPI) { if (wr == 1) PG8_BAR; }
    }
    PG8_WAIT_V(0);
    if constexpr (!ALIGN_EPI) { if (wr == 0) PG8_BAR; }
    PG8_BAR;
    if constexpr (Epi::AFTER_DRAIN) { E.fused(acc, cur, wr, wc, fr, fq, lds, wid, lane); S.done(cur); }
#undef PG8_APTR
#undef PG8_BPTR
#undef PG8_SA
#undef PG8_SB
#undef PG8_STAGE
#undef PG8_LDA
#undef PG8_LDB
#undef PG8_MMA
#undef PG8_WAIT_V
#undef PG8_WAIT_L
#undef PG8_BAR
#undef PG8_SCHED
}
}
#ifndef PG8_SP2
#define PG8_SP2 true
#endif
#ifndef PG8_ALIGN
#define PG8_ALIGN true
#endif
constexpr int NWAVES = 8;
#ifndef MK_N_LAUNCHES
#define MK_N_LAUNCHES 1
#endif
constexpr int N_PHASES = 12;
constexpr int N_LAUNCHES = MK_N_LAUNCHES;

constexpr int BATCH = 2, SEQ = 8192, DM = 4096, M = BATCH * SEQ, HD = 128, DFF = 16384, TOPK = 256;
constexpr int C_AQ = 0, C_AK = 2048, C_AV = 2560, C_BQ = 3072, C_BK = 5120, C_BV = 7168, C_IQ = 9216, C_IK = 11264, C_IW = 11328, IN_COLS = 11360;
constexpr int NP_BF = 9216;
constexpr int NP_H = 2304;
constexpr float LN_EPS = 1e-5f;
constexpr float ALPHA = 1.189207115002721f;

constexpr size_t MiB = 1u << 20;
constexpr size_t WS_CTL = 0, CTL_ZERO_BYTES = 64 * 1024;
constexpr size_t WS_MOD = 2 * MiB;
constexpr size_t WS_XST = 2 * MiB + 512 * 1024;
constexpr size_t WS_SSQ = 3 * MiB;
constexpr size_t WS_SCL = 5 * MiB;
constexpr size_t WS_WIN_Q = 6 * MiB;
constexpr size_t WS_WIN_H = 42 * MiB;
constexpr size_t WS_WOUT_Q = 60 * MiB;
constexpr size_t WS_WUP_Q = 76 * MiB;
constexpr size_t WS_WDOWN = 140 * MiB;
constexpr size_t WS_UQ = 268 * MiB;
constexpr size_t WS_Q8 = 268 * MiB;
constexpr size_t WS_QS = 300 * MiB;
constexpr size_t WS_UH = 332 * MiB;
constexpr size_t WS_O = 460 * MiB;
constexpr size_t WS_ONQ = 588 * MiB;
constexpr size_t WS_U1Q = 652 * MiB;
constexpr size_t WS_PROJ = 716 * MiB;
constexpr size_t WS_IQ = 1004 * MiB;
constexpr size_t WS_IKWP = 1068 * MiB;
constexpr size_t WS_IKN = 1100 * MiB;
constexpr size_t WS_IWS = 1102 * MiB;
constexpr size_t WS_LIST = 1104 * MiB;
constexpr size_t WS_HID = 716 * MiB;
constexpr size_t WS_H0B = 1228 * MiB;
constexpr size_t WS_V1B = 1356 * MiB;
constexpr size_t WS_KQ8 = 1492 * MiB;
constexpr size_t WS_KS = 1500 * MiB;
constexpr size_t WS_VQ8 = 1501 * MiB;
constexpr size_t WS_VS = 1509 * MiB;
constexpr size_t WS_MODP = 1484 * MiB;
constexpr size_t WS_BQ = WS_V1B, WS_BK = WS_ONQ, WS_BV = WS_U1Q;
static_assert((long long)WS_BQ - (long long)WS_PROJ == pg8::EPI_BQ_OFF && (long long)WS_BK - (long long)WS_PROJ == pg8::EPI_BK_OFF && (long long)WS_BV - (long long)WS_PROJ == pg8::EPI_BV_OFF, "head-major buffer offsets");
constexpr size_t WS_END = 1510 * MiB;
constexpr int CW_TMO = 0, CW_CODE = 1, CW_BAR = 4096;
constexpr int NQ_COLS = NP_BF + DM + DFF + DM;
constexpr int CW_QHEAD = 2048;
static_assert((CW_BAR + 3456) * 4 <= (int)CTL_ZERO_BYTES && (CW_QHEAD + 64) * 4 <= CW_BAR * 4, "control words inside the memset region");

constexpr int RING_OFF = 0, RING_BYTES = 131072;
constexpr int LDSCTL_OFF = RING_BYTES, MISC_OFF = LDSCTL_OFF + 320;
constexpr int LDS_BYTES = 155648;
constexpr int TAIL_OFF = LDSCTL_OFF + 1024;

#define GAS __attribute__((address_space(1)))
#define LAS __attribute__((address_space(3)))
typedef unsigned short u16;
typedef unsigned v4u __attribute__((ext_vector_type(4)));
typedef unsigned v2u __attribute__((ext_vector_type(2)));
typedef float f32x4 __attribute__((ext_vector_type(4)));
typedef GAS unsigned gu32;
#define RLX_AGENT __ATOMIC_RELAXED, __HIP_MEMORY_SCOPE_AGENT
#define LDS_WAIT() asm volatile("s_waitcnt lgkmcnt(0)" ::: "memory")
#define VM_WAIT() asm volatile("s_waitcnt vmcnt(0)" ::: "memory")
__device__ __forceinline__ unsigned f2bf(float f) { unsigned u = __builtin_bit_cast(unsigned, f); return (u + 0x7fffu + ((u >> 16) & 1u)) >> 16; }
__device__ __forceinline__ unsigned pk2(float lo, float hi) { return pg8::cvt_pk_bf16(lo, hi); }
__device__ __forceinline__ unsigned pkh2(float lo, float hi) { return pg8::cvt_pk_f16(lo, hi); }
__device__ __forceinline__ float bflo(unsigned w) { return __builtin_bit_cast(float, w << 16); }
__device__ __forceinline__ float bfhi(unsigned w) { return __builtin_bit_cast(float, w & 0xffff0000u); }
__device__ __forceinline__ float hlo(unsigned w) { return (float)__builtin_bit_cast(pg8::f16x2, w).x; }
__device__ __forceinline__ float hhi(unsigned w) { return (float)__builtin_bit_cast(pg8::f16x2, w).y; }

#define XB_TMO      128
#define XB_XCNT(j)  (256  + 64 * (j))
#define XB_XSUB(j)  (1280 + 64 * (j))
#define XB_XGEN(j)  (2304 + 64 * (j))
#define XB_TOP      3328
#define XB_TOPGEN   3392
#define XCD_BAR_WORDS 3456
#define XB_SPIN_CAP (1u << 18)

__device__ __forceinline__ unsigned xb_ld(unsigned* p)              { return __hip_atomic_load(p, __ATOMIC_RELAXED, __HIP_MEMORY_SCOPE_AGENT); }
__device__ __forceinline__ unsigned xb_add(unsigned* p, unsigned v) { return __hip_atomic_fetch_add(p, v, __ATOMIC_RELAXED, __HIP_MEMORY_SCOPE_AGENT); }
__device__ __forceinline__ unsigned xb_xcc_id() { return (unsigned)__builtin_amdgcn_s_getreg((3 << 11) | 20) & 0xFu; }
#define XB_SPIN(cond, bar) do { unsigned _sp = 0; while (cond) { __builtin_amdgcn_s_sleep(1); \
    if ((++_sp & 255u) == 0u) { if (xb_ld(&(bar)[XB_TMO])) break; if (_sp > XB_SPIN_CAP) { atomicAdd(&(bar)[XB_TMO], 1u); break; } } } } while (0)

struct XcdBarrier {
    unsigned* bar; unsigned x;
    volatile LAS unsigned* st;
};

__device__ __forceinline__ XcdBarrier xcd_barrier_post(unsigned* bar, volatile LAS unsigned* st, bool t0  ) {
    XcdBarrier b; b.bar = bar; b.x = xb_xcc_id(); b.st = st;
    if (t0) (void)xb_add(&bar[XB_XCNT(b.x)], 1u);
    return b;
}
__device__ __forceinline__ void xcd_barrier_complete(unsigned* bar, unsigned x, unsigned& nloc, unsigned& nx) {
    const unsigned G = gridDim.x * gridDim.y * gridDim.z;
    unsigned sum, cnt, mine, sp = 0u;
    for (;;) {
        sum = 0u; cnt = 0u; mine = 0u;
#pragma unroll
        for (unsigned j = 0; j < 16; ++j) { const unsigned c = xb_ld(&bar[XB_XCNT(j)]); sum += c; cnt += (c > 0u) ? 1u : 0u; mine = (j == x) ? c : mine; }
        if (sum == G) break;
        __builtin_amdgcn_s_sleep(1);
        if ((++sp & 255u) == 0u) { if (xb_ld(&bar[XB_TMO])) break; if (sp > XB_SPIN_CAP) { atomicAdd(&bar[XB_TMO], 1u); break; } }
    }
    nloc = mine > 0u ? mine : 1u; nx = cnt > 0u ? cnt : 1u;
}

__device__ __forceinline__ void xcd_barrier(const XcdBarrier& b, bool t0  ) {
    asm volatile("s_waitcnt vmcnt(0)" ::: "memory");
    __syncthreads();
    if (t0) {
        unsigned* bar = b.bar;
        __builtin_amdgcn_s_waitcnt(0);
        unsigned nloc = b.st[0], nx = b.st[1];
        if (nloc == 0u) { xcd_barrier_complete(bar, b.x, nloc, nx); b.st[0] = nloc; b.st[1] = nx; }
        const unsigned old = xb_add(&bar[XB_XSUB(b.x)], 1u);
        const unsigned gen = old / nloc;
        if (old + 1u == (gen + 1u) * nloc) {
            __builtin_amdgcn_fence(__ATOMIC_RELEASE, "agent");
            asm volatile("s_waitcnt vmcnt(0)" ::: "memory");
            const unsigned og = xb_add(&bar[XB_TOP], 1u);
            const unsigned tg = og / nx;
            if (og + 1u == (tg + 1u) * nx) xb_add(&bar[XB_TOPGEN], 1u);
            else XB_SPIN(xb_ld(&bar[XB_TOPGEN]) == tg, bar);
            __builtin_amdgcn_fence(__ATOMIC_ACQUIRE, "agent");
            xb_add(&bar[XB_XGEN(b.x)], 1u);
            asm volatile("s_waitcnt vmcnt(0)" ::: "memory");
        } else {
            XB_SPIN(xb_ld(&bar[XB_XGEN(b.x)]) == gen, bar);
            __builtin_amdgcn_fence(__ATOMIC_ACQUIRE, "agent");
            asm volatile("s_waitcnt vmcnt(0)" ::: "memory");
        }
    }
    __syncthreads();
}
struct Args { const float* in[19]; float* out; unsigned char* ws; int ph_lo, ph_hi, li, pad; };
#define CAS __attribute__((address_space(4)))
__device__ __forceinline__ const unsigned char CAS* karg_base() { const unsigned char CAS* p = (const unsigned char CAS*)__builtin_amdgcn_kernarg_segment_ptr(); asm volatile("" : "+s"(p)); return p; }
__device__ __forceinline__ const float* karg_in(int k) { return ((const float* const CAS*)karg_base())[k]; }
__device__ __forceinline__ float* karg_out() { return ((float* const CAS*)karg_base())[19]; }
struct Frame {
    LAS unsigned char* lds;
    volatile LAS unsigned* MISC;
    gu32* ctl;
    int tid, lane, wave;
    int vcu, G;
    __device__ __forceinline__ const float* x() const { return karg_in(0); }
    __device__ __forceinline__ const float* c() const { return karg_in(1); }
    __device__ __forceinline__ const float* in_g() const { return karg_in(2); }
    __device__ __forceinline__ const float* in_b() const { return karg_in(3); }
    __device__ __forceinline__ const float* relb() const { return karg_in(4); }
    __device__ __forceinline__ const float* w_ada() const { return karg_in(5); }
    __device__ __forceinline__ const float* b_ada() const { return karg_in(6); }
    __device__ __forceinline__ const float* w_in() const { return karg_in(7); }
    __device__ __forceinline__ const float* kn_g() const { return karg_in(8); }
    __device__ __forceinline__ const float* kn_b() const { return karg_in(9); }
    __device__ __forceinline__ const float* gn_a() const { return karg_in(10); }
    __device__ __forceinline__ const float* gn_b() const { return karg_in(11); }
    __device__ __forceinline__ const float* w_out() const { return karg_in(12); }
    __device__ __forceinline__ const float* ln1_g() const { return karg_in(13); }
    __device__ __forceinline__ const float* ln1_b() const { return karg_in(14); }
    __device__ __forceinline__ const float* w_up() const { return karg_in(15); }
    __device__ __forceinline__ const float* w_down() const { return karg_in(16); }
    __device__ __forceinline__ const float* ln2_g() const { return karg_in(17); }
    __device__ __forceinline__ const float* ln2_b() const { return karg_in(18); }
    __device__ __forceinline__ float* out() const { return karg_out(); }
    unsigned char* ws;
    __device__ __forceinline__ float* MOD() const { return (float*)(ws + WS_MOD); }
    __device__ __forceinline__ float* XST() const { return (float*)(ws + WS_XST); }
    __device__ __forceinline__ float* SSQ() const { return (float*)(ws + WS_SSQ); }
    __device__ __forceinline__ float* IKWP() const { return (float*)(ws + WS_IKWP); }
    __device__ __forceinline__ float* IWS() const { return (float*)(ws + WS_IWS); }
    __device__ __forceinline__ float* SA_U() const { return (float*)(ws + WS_SCL); }
    __device__ __forceinline__ float* SA_ON() const { return (float*)(ws + WS_SCL + (size_t)M * 4); }
    __device__ __forceinline__ float* SA_U1() const { return (float*)(ws + WS_SCL + (size_t)M * 8); }
    __device__ __forceinline__ float* ST1() const { return (float*)(ws + WS_SCL + (size_t)M * 12); }
    __device__ __forceinline__ float* SW() const { return (float*)(ws + WS_SCL + (size_t)M * 20); }
    __device__ __forceinline__ u16* WIN_H() const { return (u16*)(ws + WS_WIN_H); }
    __device__ __forceinline__ unsigned char* WDOWN8() const { return (unsigned char*)(ws + WS_WDOWN); }
    __device__ __forceinline__ u16* UH() const { return (u16*)(ws + WS_UH); }
    __device__ __forceinline__ u16* O() const { return (u16*)(ws + WS_O); }
    __device__ __forceinline__ u16* PROJ() const { return (u16*)(ws + WS_PROJ); }
    __device__ __forceinline__ u16* IQ() const { return (u16*)(ws + WS_IQ); }
    __device__ __forceinline__ u16* IKN() const { return (u16*)(ws + WS_IKN); }
    __device__ __forceinline__ unsigned char* HID8() const { return (unsigned char*)(ws + WS_HID); }
    __device__ __forceinline__ unsigned char* WIN_Q() const { return (unsigned char*)(ws + WS_WIN_Q); }
    __device__ __forceinline__ unsigned char* WOUT_Q() const { return (unsigned char*)(ws + WS_WOUT_Q); }
    __device__ __forceinline__ unsigned char* WUP_Q() const { return (unsigned char*)(ws + WS_WUP_Q); }
    __device__ __forceinline__ unsigned char* UQ() const { return (unsigned char*)(ws + WS_UQ); }
    __device__ __forceinline__ unsigned char* Q8() const { return (unsigned char*)(ws + WS_Q8); }
    __device__ __forceinline__ float* QS() const { return (float*)(ws + WS_QS); }
    __device__ __forceinline__ u16* BQ() const { return (u16*)(ws + WS_BQ); }
    __device__ __forceinline__ u16* BK() const { return (u16*)(ws + WS_BK); }
    __device__ __forceinline__ u16* BV() const { return (u16*)(ws + WS_BV); }
    __device__ __forceinline__ unsigned char* ONQ() const { return (unsigned char*)(ws + WS_ONQ); }
    __device__ __forceinline__ unsigned char* U1Q() const { return (unsigned char*)(ws + WS_U1Q); }
    __device__ __forceinline__ unsigned char* KQ8() const { return (unsigned char*)(ws + WS_KQ8); }
    __device__ __forceinline__ u16* KS() const { return (u16*)(ws + WS_KS); }
    __device__ __forceinline__ unsigned char* VQ8() const { return (unsigned char*)(ws + WS_VQ8); }
    __device__ __forceinline__ u16* VS() const { return (u16*)(ws + WS_VS); }
    __device__ __forceinline__ float* MODP() const { return (float*)(ws + WS_MODP); }
    __device__ __forceinline__ u16* H0B() const { return (u16*)(ws + WS_H0B); }
    __device__ __forceinline__ u16* V1B() const { return (u16*)(ws + WS_V1B); }
    __device__ __forceinline__ unsigned* LIST() const { return (unsigned*)(ws + WS_LIST); }
};

__device__ __forceinline__ int lane_now() { unsigned ones = ~0u; asm volatile("" : "+v"(ones)); return (int)__builtin_amdgcn_mbcnt_hi(ones, __builtin_amdgcn_mbcnt_lo(ones, 0u)); }
__device__ __forceinline__ void rethread(Frame& F) { F.lane = lane_now(); F.tid = F.wave * 64 + F.lane; }
template <int K> __device__ __forceinline__ float xshf(float v) {
    if constexpr (K == 32) { auto r = __builtin_amdgcn_permlane32_swap(__float_as_uint(v), __float_as_uint(v), false, false); const unsigned a = r[0], b = r[1];
        return __uint_as_float(a ^ b ^ __float_as_uint(v)); }
    else return __int_as_float(__builtin_amdgcn_ds_swizzle(__float_as_int(v), (K << 10) | 0x1f));
}
__device__ __forceinline__ float wave_sum(float v) {
    v += xshf<1>(v); v += xshf<2>(v); v += xshf<4>(v); v += xshf<8>(v); v += xshf<16>(v); v += xshf<32>(v);
    return v;
}
__device__ __forceinline__ float wave_max(float v) {
    v = fmaxf(v, xshf<1>(v)); v = fmaxf(v, xshf<2>(v)); v = fmaxf(v, xshf<4>(v)); v = fmaxf(v, xshf<8>(v)); v = fmaxf(v, xshf<16>(v)); v = fmaxf(v, xshf<32>(v));
    return v;
}
__device__ __forceinline__ unsigned q4(const f32x4 v, float inv) {
    const int a = __float2int_rn(v.x * inv), b = __float2int_rn(v.y * inv), c = __float2int_rn(v.z * inv), d = __float2int_rn(v.w * inv);
    return (unsigned)(a & 255) | ((unsigned)(b & 255) << 8) | ((unsigned)(c & 255) << 16) | ((unsigned)d << 24);
}
__device__ __forceinline__ float amax4(const f32x4 v) { return fmaxf(fmaxf(fabsf(v.x), fabsf(v.y)), fmaxf(fabsf(v.z), fabsf(v.w))); }
__device__ __forceinline__ unsigned wave_max_u(unsigned v) {
    unsigned t;
    t = __float_as_uint(xshf<1>(__uint_as_float(v))); v = t > v ? t : v; t = __float_as_uint(xshf<2>(__uint_as_float(v))); v = t > v ? t : v; t = __float_as_uint(xshf<4>(__uint_as_float(v))); v = t > v ? t : v;
    t = __float_as_uint(xshf<8>(__uint_as_float(v))); v = t > v ? t : v; t = __float_as_uint(xshf<16>(__uint_as_float(v))); v = t > v ? t : v; t = __float_as_uint(xshf<32>(__uint_as_float(v))); v = t > v ? t : v;
    return v;
}
__device__ __forceinline__ int wave_sum_i(int v) {
    v += __float_as_int(xshf<1>(__int_as_float(v))); v += __float_as_int(xshf<2>(__int_as_float(v))); v += __float_as_int(xshf<4>(__int_as_float(v))); v += __float_as_int(xshf<8>(__int_as_float(v))); v += __float_as_int(xshf<16>(__int_as_float(v))); v += __float_as_int(xshf<32>(__int_as_float(v)));
    return v;
}
__device__ __forceinline__ unsigned t5_bucket(int n) {
    if (n < 16) return (unsigned)n;
    const float nf = (float)n;
    int large = 16 + (int)(logf(nf / 16.0f) / 2.0794415416798357f * 16.0f);
    return (unsigned)(large < 31 ? large : 31);
}

__device__ __forceinline__ f32x4 ldp(const float* base, unsigned lane_bytes, int const_floats) { return *(const f32x4*)((const char*)(base + const_floats) + lane_bytes); }
__device__ __forceinline__ f32x4 ldl(LAS float* base, unsigned lane_bytes, int const_floats) { return *(const LAS f32x4*)((const LAS char*)(base + const_floats) + lane_bytes); }
__device__ __forceinline__ void lds_fill(LAS float* dst, const float* src, int nfloats, int tid) {
    for (int i = 4 * tid; i < nfloats; i += 4 * NWAVES * 64) *(LAS f32x4*)(dst + i) = *(const GAS f32x4*)(src + i);
}
__device__ __forceinline__ void p0_transpose_item(const float* W, int K, int ldw, int k0, int n0, u16* WT, int drow, bool f16, LAS float* scr, int lane) {
#pragma unroll 8
    for (int i = 0; i < 32; ++i) { const int kk = 2 * i + (lane >> 5); scr[kk * 33 + (lane & 31)] = W[(size_t)(k0 + kk) * ldw + n0 + (lane & 31)]; }
    LDS_WAIT(); asm volatile("" ::: "memory");
    const int c = lane & 7;
#pragma unroll
    for (int j = 0; j < 4; ++j) { const int n = (lane >> 3) + 8 * j; const LAS float* s = scr + (8 * c) * 33 + n;
        v4u o;
        if (f16) { o.x = pkh2(s[0 * 33], s[1 * 33]); o.y = pkh2(s[2 * 33], s[3 * 33]); o.z = pkh2(s[4 * 33], s[5 * 33]); o.w = pkh2(s[6 * 33], s[7 * 33]); }
        else     { o.x = pk2(s[0 * 33], s[1 * 33]);  o.y = pk2(s[2 * 33], s[3 * 33]);  o.z = pk2(s[4 * 33], s[5 * 33]);  o.w = pk2(s[6 * 33], s[7 * 33]); }
        *(GAS v4u*)(WT + (size_t)(drow + n) * K + k0 + 8 * c) = o; }
    LDS_WAIT(); asm volatile("" ::: "memory");
}
__device__ __forceinline__ void p0_absmax_item(const float* W, int ldw, int k0, int n0, unsigned* colmax, int lane) {
    float mx = 0.f;
    const float* wp = W + (size_t)(k0 + (lane >> 5)) * ldw + n0 + (lane & 31);
#pragma unroll 1
    for (int i = 0; i < 128; i += 8) {
        float t[8];
#pragma unroll
        for (int j = 0; j < 8; ++j) t[j] = wp[(size_t)(2 * j) * ldw];
#pragma unroll
        for (int j = 0; j < 8; ++j) mx = fmaxf(mx, fabsf(t[j]));
        wp += (size_t)16 * ldw; }
    mx = fmaxf(mx, xshf<32>(mx));
    if (lane < 32) atomicMax(colmax + lane, __float_as_uint(mx));
}
__device__ __forceinline__ unsigned f8x4(const f32x4 v, float inv) {
    int w = 0; w = __builtin_amdgcn_cvt_pk_fp8_f32(v.x * inv, v.y * inv, w, false); w = __builtin_amdgcn_cvt_pk_fp8_f32(v.z * inv, v.w * inv, w, true); return (unsigned)w;
}
template <bool FP8> __device__ __forceinline__ void p1_quant_item(const float* W, int K, int ldw, int k0, int n0, unsigned char* WT, const float am  , float* sw, LAS float* scr, int lane) {
    constexpr float QMAX = FP8 ? 224.0f : 127.0f;
#pragma unroll 16
    for (int i = 0; i < 32; ++i) { const int kk = 2 * i + (lane >> 5); scr[kk * 33 + (lane & 31)] = W[(size_t)(k0 + kk) * ldw + n0 + (lane & 31)]; }
    LDS_WAIT(); asm volatile("" ::: "memory");
    const int n = lane >> 1, hf = lane & 1;
    const float inv = am > 0.f ? QMAX / am : 0.f;
    if (k0 == 0 && hf == 0) sw[n] = am * (1.0f / QMAX);
    const LAS float* sp = scr + (32 * hf) * 33 + n;
    v4u o0, o1;
#pragma unroll
    for (int j = 0; j < 4; ++j) { const f32x4 a = {sp[(4 * j) * 33], sp[(4 * j + 1) * 33], sp[(4 * j + 2) * 33], sp[(4 * j + 3) * 33]}; o0[j] = FP8 ? f8x4(a, inv) : q4(a, inv);
        const f32x4 b = {sp[(16 + 4 * j) * 33], sp[(16 + 4 * j + 1) * 33], sp[(16 + 4 * j + 2) * 33], sp[(16 + 4 * j + 3) * 33]}; o1[j] = FP8 ? f8x4(b, inv) : q4(b, inv); }
    GAS v4u* dst = (GAS v4u*)(WT + (size_t)(n0 + n) * K + k0 + 32 * hf);
    dst[0] = o0; dst[1] = o1;
    LDS_WAIT(); asm volatile("" ::: "memory");
}
__device__ __forceinline__ void p0_prologue(Frame& F0) {
    Frame F = F0; rethread(F);
    const float* const c_p = F.c();
    const float* const w_ada_p = F.w_ada();
    const float* const b_ada_p = F.b_ada();
    const float* const w_in_p = F.w_in();
    const float* const w_out_p = F.w_out();
    const float* const w_up_p = F.w_up();
    const float* const w_down_p = F.w_down();
#ifndef PROBE_SUB
#define PROBE_SUB 0
#endif
    for (int ps_ = 0; ps_ < (PROBE_SUB == 1 ? 2 : 1); ++ps_)
    {
        LAS float* cs = (LAS float*)(F.lds + RING_OFF);
        for (int i = F.tid; i < 2 * DM; i += NWAVES * 64) { const float v = c_p[i]; cs[i] = v / (1.0f + __expf(-v)); }
        __syncthreads();
        for (int it = blockIdx.x; it < 256; it += F.G) {
            const int kg = it >> 3, cp = it & 7;
            if (F.tid < 384) {
                const float* wp = w_ada_p + (size_t)(128 * kg) * (6 * DM) + 3072 * cp + 4 * F.tid;
                f32x4 a0 = {0.f, 0.f, 0.f, 0.f}, a1 = a0, b0 = a0, b1 = a0;
#pragma unroll 8
                for (int k = 0; k < 128; ++k) { const f32x4 wa = *(const GAS f32x4*)(wp + (size_t)k * (6 * DM)), wb = *(const GAS f32x4*)(wp + (size_t)k * (6 * DM) + 1536);
                    const float s0 = cs[128 * kg + k], s1 = cs[DM + 128 * kg + k]; a0 += wa * s0; a1 += wa * s1; b0 += wb * s0; b1 += wb * s1; }
                float* pp = F.MODP() + (size_t)kg * (2 * 6 * DM) + 3072 * cp + 4 * F.tid;
                *(f32x4*)(pp) = a0; *(f32x4*)(pp + 1536) = b0; *(f32x4*)(pp + 6 * DM) = a1; *(f32x4*)(pp + 6 * DM + 1536) = b1;
            }
        }
        __syncthreads();
    }
    for (int ps2_ = 0; ps2_ < (PROBE_SUB == 2 ? 2 : 1); ++ps2_)
    {
        LAS float* scr = (LAS float*)(F.lds + RING_OFF + F.wave * 16384);
        const int gw = F.vcu * NWAVES + F.wave, NGW = F.G * NWAVES;
        constexpr int NB_H = (IN_COLS - NP_BF) / 32;
        constexpr int I_H = (DM / 64) * NB_H;
        for (int it = gw; it < I_H; it += NGW) { const int kb = it / NB_H, nb = it % NB_H; p0_transpose_item(w_in_p, DM, IN_COLS, 64 * kb, NP_BF + 32 * nb, F.WIN_H(), 32 * nb, true, scr, F.lane); }
        { constexpr int R0 = IN_COLS - NP_BF; GAS v4u* z = (GAS v4u*)(F.WIN_H() + (size_t)R0 * DM); const size_t n16 = (size_t)(NP_H - R0) * DM * 2 / 16;
          for (size_t i = (size_t)gw * 64 + F.lane; i < n16; i += (size_t)NGW * 64) z[i] = (v4u){0u, 0u, 0u, 0u}; }
    }
    {
        LAS float* scr = (LAS float*)(F.lds + RING_OFF + F.wave * 16384);
        LAS float* cmx = (LAS float*)(F.lds + RING_OFF + 12288);
        volatile LAS int* qslot = (volatile LAS int*)(cmx + 256);
        constexpr int S_DN = DM / 32, S_UP = DFF / 32, S_IN = NP_BF / 32, S_OUT = DM / 32, NSTRIPS = S_DN + S_UP + S_IN + S_OUT;
        unsigned* qhead = (unsigned*)F.ctl + CW_QHEAD;
        for (;;) {
            __syncthreads();
            if (F.tid == 0) *qslot = (int)atomicAdd(qhead, 1u);
            __syncthreads();
            int r = *qslot; if (r >= NSTRIPS) break;
            const float* W; int K, ldw, n0; unsigned char* WT; float* sw; bool fp8 = false;
            if (r < S_DN) { W = w_down_p; K = DFF; ldw = DM; n0 = 32 * r; WT = F.WDOWN8(); sw = F.SW() + NP_BF + DM + DFF; fp8 = true; }
            else if ((r -= S_DN) < S_UP) { W = w_up_p; K = DM; ldw = DFF; n0 = 32 * r; WT = F.WUP_Q(); sw = F.SW() + NP_BF + DM; }
            else if ((r -= S_UP) < S_IN) { W = w_in_p; K = DM; ldw = IN_COLS; n0 = 32 * r; WT = F.WIN_Q(); sw = F.SW(); }
            else { r -= S_IN; W = w_out_p; K = DM; ldw = DM; n0 = 32 * r; WT = F.WOUT_Q(); sw = F.SW() + NP_BF; }
            const int ntile = K / 64;
            float mx = 0.f;
            for (int kb = F.wave; kb < ntile; kb += NWAVES) {
                const float* wp = W + (size_t)(64 * kb + (F.lane >> 5)) * ldw + n0 + (F.lane & 31);
#pragma unroll 1
                for (int i = 0; i < 32; i += 16) { float t[16];
#pragma unroll
                    for (int q = 0; q < 16; ++q) t[q] = wp[(size_t)(2 * q) * ldw];
#pragma unroll
                    for (int q = 0; q < 16; ++q) mx = fmaxf(mx, fabsf(t[q]));
                    wp += (size_t)32 * ldw; } }
            mx = fmaxf(mx, xshf<32>(mx));
            if (F.lane < 32) cmx[F.wave * 32 + F.lane] = mx;
            __syncthreads();
            float am = 0.f;
#pragma unroll
            for (int w = 0; w < NWAVES; ++w) am = fmaxf(am, cmx[w * 32 + (F.lane >> 1)]);
            for (int kb = ntile - NWAVES + F.wave; kb >= 0; kb -= NWAVES) {
                if (fp8) p1_quant_item<true>(W, K, ldw, 64 * kb, n0, WT, am, sw + n0, scr, F.lane);
                else p1_quant_item<false>(W, K, ldw, 64 * kb, n0, WT, am, sw + n0, scr, F.lane);
            }
        }
    }
}
__device__ __forceinline__ void p1a_modsum(Frame& F0) {
    Frame F = F0; rethread(F);
    const float* const b_ada_p = F.b_ada();
    const int gt = (F.vcu * NWAVES + F.wave) * 64 + F.lane, NGT = F.G * NWAVES * 64;
    for (int j = gt; j < 2 * (2 * 6 * DM); j += NGT) { const int i = j >> 1, hf = j & 1;
        float s = 0.f;
#pragma unroll 8
        for (int g = 0; g < 16; ++g) s += F.MODP()[(size_t)(16 * hf + g) * (2 * 6 * DM) + i];
        s += xshf<1>(s);
        if (hf == 0) F.MOD()[i] = s + b_ada_p[i % (6 * DM)]; }
}
template <bool FILL_LN> __device__ __forceinline__ void p1_rows(Frame& F0) {
    Frame F = F0; rethread(F);
    const float* const x_p = F.x();
    const float* const in_g_p = F.in_g();
    const float* const in_b_p = F.in_b();
    const int gw = F.vcu * NWAVES + F.wave, NGW = F.G * NWAVES;
    LAS float* pl = (LAS float*)(F.lds + RING_OFF);
    if (FILL_LN) { lds_fill(pl, in_g_p, DM, F.tid); lds_fill(pl + DM, in_b_p, DM, F.tid); }
    lds_fill(pl + 2 * DM, F.MOD(), 2 * DM, F.tid); lds_fill(pl + 4 * DM, F.MOD() + 6 * DM, 2 * DM, F.tid);
    __syncthreads();
    for (int m = gw; m < M; m += NGW) {
        const GAS f32x4* xr = (const GAS f32x4*)(x_p + (size_t)m * DM) + F.lane;
        f32x4 v[16]; float s = 0.f;
#pragma unroll
        for (int j = 0; j < 16; ++j) { v[j] = xr[64 * j]; s += (v[j].x + v[j].y) + (v[j].z + v[j].w); }
        const float mean = wave_sum(s) * (1.f / DM); float s2 = 0.f;
#pragma unroll
        for (int j = 0; j < 16; ++j) { v[j] = v[j] - mean; s2 += (v[j].x * v[j].x + v[j].y * v[j].y) + (v[j].z * v[j].z + v[j].w * v[j].w); }
        const float rstd = 1.f / sqrtf(wave_sum(s2) * (1.f / DM) + LN_EPS);
        if (F.lane == 0) { F.XST()[2 * m] = mean; F.XST()[2 * m + 1] = rstd; }
        LAS float* mod = pl + 2 * DM + (m / SEQ) * (2 * DM);
        GAS v2u* oh = (GAS v2u*)(F.UH() + (size_t)m * DM) + F.lane; GAS v2u* o0 = (GAS v2u*)(F.H0B() + (size_t)m * DM) + F.lane;
        float am = 0.f;
#pragma unroll
        for (int j = 0; j < 16; ++j) { if ((j & 3) == 0) asm volatile("" ::: "memory");
            const unsigned lb = 16u * (unsigned)F.lane; const int cj = 256 * j;
            const f32x4 g = ldl(pl, lb, cj), bb = ldl(pl, lb, DM + cj), sh = ldl(mod, lb, cj), sc = ldl(mod, lb, DM + cj);
            const f32x4 h0 = v[j] * rstd * g + bb; const f32x4 u = h0 * (sc + 1.0f) + sh; v[j] = u; am = fmaxf(am, amax4(u));
            v2u wh; wh.x = pkh2(u.x, u.y); wh.y = pkh2(u.z, u.w); oh[64 * j] = wh;
            v2u w0; w0.x = pk2(h0.x, h0.y); w0.y = pk2(h0.z, h0.w); o0[64 * j] = w0; }
        am = wave_max(am); const float inv = am > 0.f ? 127.0f / am : 0.f;
        if (F.lane == 0) F.SA_U()[m] = am * (1.0f / 127.0f);
        GAS unsigned* oq = (GAS unsigned*)(F.UQ() + (size_t)m * DM) + F.lane;
#pragma unroll
        for (int j = 0; j < 16; ++j) oq[64 * j] = q4(v[j], inv);
    }
}
__device__ __forceinline__ void p3_kq8(Frame& F0) {
    Frame F = F0; rethread(F);
    const int gw = F.vcu * NWAVES + F.wave, NGW = F.G * NWAVES;
#define KQ8_LOAD(wv, mm) do { const u16* pr_ = F.PROJ() + (size_t)(mm) * NP_BF + 8 * F.lane; wv[0] = *(const GAS v4u*)(pr_ + C_AK); wv[1] = *(const GAS v4u*)(pr_ + C_AV); \
        _Pragma("unroll") for (int j_ = 0; j_ < 4; ++j_) wv[2 + j_] = *(const GAS v4u*)(pr_ + C_AQ + 512 * j_); } while (0)
    v4u nw[6];
    if (gw < M) KQ8_LOAD(nw, gw);
    for (int m = gw; m < M; m += NGW) {
        v4u cw[6];
#pragma unroll
        for (int i = 0; i < 6; ++i) cw[i] = nw[i];
        if (m + NGW < M) KQ8_LOAD(nw, m + NGW);
#pragma unroll
        for (int i = 0; i < 6; ++i) {
            const v4u w = cw[i];
            const f32x4 a = {bflo(w.x), bfhi(w.x), bflo(w.y), bfhi(w.y)}, c = {bflo(w.z), bfhi(w.z), bflo(w.w), bfhi(w.w)};
            float am = fmaxf(amax4(a), amax4(c));
            am = fmaxf(am, xshf<1>(am)); am = fmaxf(am, xshf<2>(am)); am = fmaxf(am, xshf<4>(am)); am = fmaxf(am, xshf<8>(am));
            const float inv = am > 0.f ? 127.0f / am : 0.f;
            v2u o; o.x = q4(a, inv); o.y = q4(c, inv);
            if (i < 2) { *(GAS v2u*)((i == 0 ? F.KQ8() : F.VQ8()) + (size_t)m * 512 + 8 * F.lane) = o;
                if ((F.lane & 15) == 0) (i == 0 ? F.KS() : F.VS())[(size_t)((m / SEQ) * 4 + (F.lane >> 4)) * SEQ + (m % SEQ)] = (u16)pkh2(am * (1.0f / 127.0f), 0.f); }
            else { *(GAS v2u*)(F.Q8() + (size_t)m * 2048 + 512 * (i - 2) + 8 * F.lane) = o;
                if ((F.lane & 15) == 0) F.QS()[(size_t)m * 16 + 4 * (i - 2) + (F.lane >> 4)] = am * (1.0f / 127.0f); }
        }
    }
#undef KQ8_LOAD
}
__device__ __forceinline__ void p3_ikn(Frame& F0) {
    Frame F = F0; rethread(F);
    const float* const kn_g_p = F.kn_g();
    const float* const kn_b_p = F.kn_b();
    const int gw = F.vcu * NWAVES + F.wave, NGW = F.G * NWAVES, sub = F.lane & 15;
    const size_t qs = (size_t)M * 128 / 4;
    for (int m4 = gw; m4 < M / 4; m4 += NGW) {
        const int m = 4 * m4 + (F.lane >> 4);
        const GAS f32x4* r0 = (const GAS f32x4*)(F.IKWP() + (size_t)m * 128);
        f32x4 v = r0[sub], wv = r0[16 + (sub & 7)];
#pragma unroll
        for (int q = 1; q < 4; ++q) { v += r0[(size_t)q * qs + sub]; wv += r0[(size_t)q * qs + 16 + (sub & 7)]; }
        float s = (v.x + v.y) + (v.z + v.w);
        s += xshf<1>(s); s += xshf<2>(s); s += xshf<4>(s); s += xshf<8>(s);
        const float mean = s * (1.f / 64.f); v = v - mean;
        float s2 = (v.x * v.x + v.y * v.y) + (v.z * v.z + v.w * v.w);
        s2 += xshf<1>(s2); s2 += xshf<2>(s2); s2 += xshf<4>(s2); s2 += xshf<8>(s2);
        const float rstd = 1.f / sqrtf(s2 * (1.f / 64.f) + LN_EPS);
        const f32x4 g = *(const f32x4*)(kn_g_p + 4 * sub), bb = *(const f32x4*)(kn_b_p + 4 * sub); const f32x4 y = v * rstd * g + bb;
        v2u w; w.x = pkh2(y.x, y.y); w.y = pkh2(y.z, y.w); *(GAS v2u*)(F.IKN() + (size_t)m * 64 + 4 * sub) = w;
        if (sub < 8) *(GAS f32x4*)(F.IWS() + (size_t)m * 32 + 4 * sub) = wv;
    }
}
constexpr float SB_EXIT = -40.0f * 1.4426950408889634f;
typedef short bf8v __attribute__((ext_vector_type(8)));
typedef float f32x16 __attribute__((ext_vector_type(16)));
template <int O1, int O2> __device__ __forceinline__ void tr_read2(v2u& a, v2u& b, unsigned addr) {
    asm volatile("ds_read_b64_tr_b16 %0, %2 offset:%3\n\tds_read_b64_tr_b16 %1, %2 offset:%4" : "=&v"(a), "=&v"(b) : "v"(addr), "i"(O1), "i"(O2) : "memory");
}
constexpr int SB_VST = 320;
constexpr int SB_WAVE_LDS = 32 * SB_VST;
__device__ __forceinline__ void sb_fast(Frame& F0) {
    Frame F = F0; rethread(F);
    LAS unsigned char* vimg = F.lds + RING_OFF + F.wave * SB_WAVE_LDS;
    const int lane = F.lane, c = lane & 31, hi = lane >> 5;
    const unsigned tr_base = (unsigned)(size_t)vimg + (unsigned)((4 * hi + ((lane & 15) >> 2)) * SB_VST + (16 * ((lane >> 4) & 1) + 4 * (lane & 3)) * 2);
    const int gw = F.vcu * NWAVES + F.wave, NGW = F.G * NWAVES;
    for (int task = gw; task < BATCH * 16 * (SEQ / 32); task += NGW) {
        const int qt = task % (SEQ / 32), bh = task / (SEQ / 32), h = bh & 15, b = bh >> 4;
        const int q0 = 32 * qt;
        const size_t hoff = (size_t)(b * 16 + h) * SEQ * HD;
        const u16* const qb = F.BQ() + hoff; const u16* const kb = F.BK() + hoff; const u16* const vb = F.BV() + hoff;
        bf8v qf[8];
        { const u16* qp = qb + (size_t)(q0 + c) * HD + 8 * hi;
#pragma unroll
          for (int st = 0; st < 8; ++st) qf[st] = __builtin_bit_cast(bf8v, *(const v4u*)(qp + 16 * st)); }
        f32x16 oacc[4];
#pragma unroll
        for (int dt = 0; dt < 4; ++dt)
#pragma unroll
            for (int r = 0; r < 16; ++r) oacc[dt][r] = 0.f;
        float carry = 0.f;
        v4u kf[8];
        { const u16* kp = kb + (size_t)(q0 + c) * HD + 8 * hi;
#pragma unroll
          for (int st = 0; st < 8; ++st) kf[st] = *(const v4u*)(kp + 16 * st); }
        for (int k0 = q0; k0 >= 0; k0 -= 32) {
            f32x16 acc;
#pragma unroll
            for (int r = 0; r < 16; ++r) acc[r] = 0.f;
#pragma unroll
            for (int st = 0; st < 8; ++st) acc = __builtin_amdgcn_mfma_f32_32x32x16_bf16(__builtin_bit_cast(bf8v, kf[st]), qf[st], acc, 0, 0, 0);
            __builtin_amdgcn_sched_barrier(0);
            if (k0 >= 32) { const u16* kp = kb + (size_t)(k0 - 32 + c) * HD + 8 * hi;
#pragma unroll
                for (int st = 0; st < 8; ++st) kf[st] = *(const v4u*)(kp + 16 * st); }
            __builtin_amdgcn_sched_barrier(0);
            { v4u vr[8];
              const u16* vp = vb + (size_t)(k0 + (lane >> 4)) * HD + 8 * (lane & 15);
#pragma unroll
              for (int i = 0; i < 8; ++i) vr[i] = *(const v4u*)(vp + (size_t)(4 * i) * HD);
#pragma unroll
              for (int i = 0; i < 8; ++i) *(LAS v4u*)(vimg + (4 * i + (lane >> 4)) * SB_VST + (lane & 15) * 16) = vr[i]; }
            float lk[16], lb[16]; float tot = 0.f;
#pragma unroll
            for (int r = 0; r < 16; ++r) { const int kap = 8 * (r >> 2) + 4 * hi + (r & 3);
                const float z = acc[r] * (0.08838834764831845f * 1.4426950408889634f);
                const float sp = fmaxf(z, 0.f) + __builtin_amdgcn_logf(1.0f + __builtin_amdgcn_exp2f(-fabsf(z)));
                const bool valid = (k0 + kap) < (q0 + c);
                lk[r] = valid ? -sp : 0.f; lb[r] = valid ? (z - sp) : -INFINITY; tot += lk[r]; }
            tot += xshf<32>(tot);
            bf8v tm[2];
            { int cc = c; asm volatile("" : "+v"(cc));
#pragma unroll
              for (int j = 0; j < 2; ++j) { v4u w;
#pragma unroll
                for (int i2 = 0; i2 < 4; ++i2) { const int ia = 2 * i2, ib = 2 * i2 + 1; const int ka = 16 * j + 8 * (ia >> 2) + 4 * hi + (ia & 3), kb = 16 * j + 8 * (ib >> 2) + 4 * hi + (ib & 3);
                    w[i2] = (ka > cc ? 0x3f80u : 0u) | (kb > cc ? 0x3f800000u : 0u); }
                tm[j] = __builtin_bit_cast(bf8v, w); } }
            f32x16 lat;
#pragma unroll
            for (int r = 0; r < 16; ++r) lat[r] = 0.f;
#pragma unroll
            for (int j = 0; j < 2; ++j) { v4u whi, wlo;
#pragma unroll
                for (int i2 = 0; i2 < 4; ++i2) { const float x0 = lk[8 * j + 2 * i2], x1 = lk[8 * j + 2 * i2 + 1];
                    const unsigned ph = pg8::cvt_pk_bf16(x0, x1); whi[i2] = ph;
                    wlo[i2] = pg8::cvt_pk_bf16(x0 - bflo(ph), x1 - bfhi(ph)); }
                lat = __builtin_amdgcn_mfma_f32_32x32x16_bf16(tm[j], __builtin_bit_cast(bf8v, whi), lat, 0, 0, 0);
                lat = __builtin_amdgcn_mfma_f32_32x32x16_bf16(tm[j], __builtin_bit_cast(bf8v, wlo), lat, 0, 0, 0); }
            v4u pw[2];
#pragma unroll
            for (int j = 0; j < 2; ++j)
#pragma unroll
                for (int i2 = 0; i2 < 4; ++i2) { const int ra = 8 * j + 2 * i2;
                    const float pa = __builtin_amdgcn_exp2f(lb[ra] + lat[ra] + carry), pb = __builtin_amdgcn_exp2f(lb[ra + 1] + lat[ra + 1] + carry);
                    pw[j][i2] = pg8::cvt_pk_bf16(pa, pb); }
            carry += tot;
#pragma unroll
            for (int j = 0; j < 2; ++j) {
                v2u fa[4], fb[4];
                if (j == 0) { tr_read2<0, 8 * SB_VST>(fa[0], fb[0], tr_base); tr_read2<64, 8 * SB_VST + 64>(fa[1], fb[1], tr_base);
                              tr_read2<128, 8 * SB_VST + 128>(fa[2], fb[2], tr_base); tr_read2<192, 8 * SB_VST + 192>(fa[3], fb[3], tr_base); }
                else { tr_read2<16 * SB_VST, 24 * SB_VST>(fa[0], fb[0], tr_base); tr_read2<16 * SB_VST + 64, 24 * SB_VST + 64>(fa[1], fb[1], tr_base);
                       tr_read2<16 * SB_VST + 128, 24 * SB_VST + 128>(fa[2], fb[2], tr_base); tr_read2<16 * SB_VST + 192, 24 * SB_VST + 192>(fa[3], fb[3], tr_base); }
                asm volatile("s_waitcnt lgkmcnt(0)" : "+v"(fa[0]), "+v"(fb[0]), "+v"(fa[1]), "+v"(fb[1]), "+v"(fa[2]), "+v"(fb[2]), "+v"(fa[3]), "+v"(fb[3]) :: "memory");
#pragma unroll
                for (int dt = 0; dt < 4; ++dt) { v4u vw; vw.x = fa[dt].x; vw.y = fa[dt].y; vw.z = fb[dt].x; vw.w = fb[dt].y;
                    oacc[dt] = __builtin_amdgcn_mfma_f32_32x32x16_bf16(__builtin_bit_cast(bf8v, vw), __builtin_bit_cast(bf8v, pw[j]), oacc[dt], 0, 0, 0); }
            }
            if (__all(carry < SB_EXIT)) break;
        }
        float ss = 0.f;
        u16* orow = F.O() + (size_t)(b * SEQ + q0 + c) * DM + 2048 + h * HD + 4 * hi;
#pragma unroll
        for (int dt = 0; dt < 4; ++dt)
#pragma unroll
            for (int r4 = 0; r4 < 4; ++r4) { const float o0 = oacc[dt][4 * r4], o1 = oacc[dt][4 * r4 + 1], o2 = oacc[dt][4 * r4 + 2], o3 = oacc[dt][4 * r4 + 3];
                ss += (o0 * o0 + o1 * o1) + (o2 * o2 + o3 * o3);
                v2u w; w.x = pk2(o0, o1); w.y = pk2(o2, o3); *(v2u*)(orow + 32 * dt + 8 * r4) = w; }
        ss += xshf<32>(ss);
        if (hi == 0) F.SSQ()[(b * SEQ + q0 + c) * 32 + 16 + h] = ss;
    }
}
__device__ __forceinline__ unsigned mono_key(float f) { const unsigned u = __builtin_bit_cast(unsigned, f); return (u & 0x80000000u) ? ~u : (u | 0x80000000u); }
typedef unsigned u32x16 __attribute__((ext_vector_type(16)));
typedef float f32x2 __attribute__((ext_vector_type(2)));
typedef _Float16 h8v __attribute__((ext_vector_type(8)));
__device__ __forceinline__ int mbcnt64(unsigned long long m) { return (int)__builtin_amdgcn_mbcnt_hi((unsigned)(m >> 32), __builtin_amdgcn_mbcnt_lo((unsigned)m, 0u)); }
__device__ __forceinline__ float relu_i(float x) { const int i = __float_as_int(x); return __int_as_float(i > 0 ? i : 0); }
constexpr int IDX_CMAX = 1024;
constexpr int IDX_KST = 144, IDX_RK = 128, IDX_BUFB = IDX_RK * IDX_KST;
#define IDX_LDF(f, base, tt, k) do { f = *(const LAS h8v*)((base) + (tt) * 32 * IDX_KST + 32 * (k)); asm volatile("" ::: "memory"); } while (0)
#define IDX_MF(acc, a, f) acc = __builtin_amdgcn_mfma_f32_32x32x16_f16(a, f, acc, 0, 0, 0)
#define IDX_Z(acc) acc = (f32x16){0.f, 0.f, 0.f, 0.f, 0.f, 0.f, 0.f, 0.f, 0.f, 0.f, 0.f, 0.f, 0.f, 0.f, 0.f, 0.f}
#define IDX_RED(acc, pp) do { f32x2 sA_ = {0.f, 0.f}, sB_ = {0.f, 0.f}; \
        _Pragma("unroll") for (int q2 = 0; q2 < 8; q2 += 2) { \
            const f32x2 ra_ = {relu_i(acc[2 * q2]), relu_i(acc[2 * q2 + 1])}, rb_ = {relu_i(acc[2 * q2 + 2]), relu_i(acc[2 * q2 + 3])}; \
            sA_ = __builtin_elementwise_fma(wrp[q2], ra_, sA_); sB_ = __builtin_elementwise_fma(wrp[q2 + 1], rb_, sB_); } \
        const f32x2 st_ = sA_ + sB_; pp = st_.x + st_.y; } while (0)
#define IDX_OUT(kc, el, koff) do { auto sw = __builtin_amdgcn_permlane32_swap(__float_as_uint(pp0), __float_as_uint(pp1), false, false); \
        const unsigned sw0 = sw[0], sw1 = sw[1]; const float sc = __uint_as_float(sw0) + __uint_as_float(sw1); \
        const unsigned su_ = __float_as_uint(sc); const unsigned mk_ = su_ ^ ((unsigned)((int)su_ >> 31) | 0x80000000u);     \
        kc[el] = lane <= (t - (koff)) ? mk_ : 0u; } while (0)
#define IDX_CHUNK(kc, kp, ch) \
    if (8 * (ch) < nr) { \
        _Pragma("unroll") for (int rr_ = 0; rr_ < 8; ++rr_) { const int r = 8 * (ch) + rr_; \
            if (r < nr) { \
                const LAS unsigned char* curl = kl0 + (r & 1) * IDX_BUFB; LAS unsigned char* nxt = kbuf + ((r + 1) & 1) * IDX_BUFB; \
                const bool more = (r + 1) < nr; \
                if (more && stg) { pf0 = *(const GAS v4u*)(pfp); pf1 = *(const GAS v4u*)(pfp + 64 * 64); pfp += IDX_RK * 64; asm volatile("" : "+v"(pfp)); } \
                IDX_Z(accA); \
                IDX_LDF(fC, curl, 0, 2); IDX_MF(accA, a0, fA); \
                IDX_LDF(fA, curl, 0, 3); IDX_MF(accA, a1, fB); \
                if (r > 0) { IDX_RED(accB, pp1); if (rr_ > 0) IDX_OUT(kc, (rr_ > 0 ? 2 * rr_ - 1 : 0), (r - 1) * IDX_RK + 64); else IDX_OUT(kp, 15, (r - 1) * IDX_RK + 64); } \
                IDX_LDF(fB, curl, 1, 0); IDX_MF(accA, a2, fC); \
                IDX_LDF(fC, curl, 1, 1); IDX_MF(accA, a3, fA); \
                IDX_Z(accB); \
                IDX_LDF(fA, curl, 1, 2); IDX_MF(accB, a0, fB); \
                IDX_LDF(fB, curl, 1, 3); IDX_MF(accB, a1, fC); \
                IDX_RED(accA, pp0); \
                IDX_LDF(fC, curl, 2, 0); IDX_MF(accB, a2, fA); \
                IDX_LDF(fA, curl, 2, 1); IDX_MF(accB, a3, fB); \
                IDX_Z(accA); \
                IDX_LDF(fB, curl, 2, 2); IDX_MF(accA, a0, fC); \
                IDX_LDF(fC, curl, 2, 3); IDX_MF(accA, a1, fA); \
                IDX_RED(accB, pp1); IDX_OUT(kc, 2 * rr_, r * IDX_RK); \
                IDX_LDF(fA, curl, 3, 0); IDX_MF(accA, a2, fB); \
                IDX_LDF(fB, curl, 3, 1); IDX_MF(accA, a3, fC); \
                IDX_Z(accB); \
                IDX_LDF(fC, curl, 3, 2); IDX_MF(accB, a0, fA); \
                IDX_LDF(fA, curl, 3, 3); IDX_MF(accB, a1, fB); \
                IDX_RED(accA, pp0); \
                IDX_MF(accB, a2, fC); IDX_MF(accB, a3, fA); \
                if (more && stg) { *(LAS v4u*)(nxt + srow * IDX_KST + sch * 16) = pf0; *(LAS v4u*)(nxt + (srow + 64) * IDX_KST + sch * 16) = pf1; } \
                if (stg) __syncthreads(); \
                if (more) { const LAS unsigned char* nl_ = kl0 + ((r + 1) & 1) * IDX_BUFB; IDX_LDF(fA, nl_, 0, 0); IDX_LDF(fB, nl_, 0, 1); } \
                else { IDX_RED(accB, pp1); IDX_OUT(kc, 2 * rr_ + 1, r * IDX_RK + 64); } \
            } } }
#define IDX_COUNT_GE(kc, ch) if (16 * (ch) < nreg) { _Pragma("unroll") for (int i_ = 0; i_ < 16; ++i_) cv += kc[i_] >= cand ? 1 : 0; }
#define IDX_MAX(kc, ch) if (16 * (ch) < nreg) { _Pragma("unroll") for (int i_ = 0; i_ < 16; ++i_) km = kc[i_] > km ? kc[i_] : km; }
#define IDX_COMPACT(kc, ch) if (16 * (ch) < nreg) { _Pragma("unroll") for (int i_ = 0; i_ < 16; ++i_) { const unsigned kk_ = kc[i_]; const bool f_ = kk_ >= T; const unsigned long long mf_ = __ballot(f_); \
                if (mf_ != 0ull) { const int p_ = cb + mbcnt64(mf_); int ln_ = lane; asm volatile("" : "+v"(ln_)); if (f_ && p_ < IDX_CMAX) { cmk[p_] = kk_; cmi[p_] = (unsigned)(64 * (16 * (ch) + i_) + ln_); } cb += (int)__popcll(mf_); } } }
#define IDX_COUNT_GT(kc, ch) if (16 * (ch) < nreg) { _Pragma("unroll") for (int i_ = 0; i_ < 16; ++i_) cv += kc[i_] > T ? 1 : 0; }
#define IDX_EMIT(kc, ch) if (16 * (ch) < nreg) { _Pragma("unroll") for (int i_ = 0; i_ < 16; ++i_) { \
                const int rg = 16 * (ch) + i_; const unsigned kk = kc[i_]; \
                const bool gt = kk > T, eq = kk == T; \
                const unsigned long long meq = __ballot(eq); \
                const bool sel = gt || (eq && (eqbase + mbcnt64(meq)) < need); \
                const unsigned long long ms = __ballot(sel); \
                if (ms != 0ull) { \
                    const int pos = base + mbcnt64(ms); \
                    int ln_ = lane; asm volatile("" : "+v"(ln_));     \
                    const int s = 64 * rg + ln_, d = t - s; \
                    const unsigned bk = d < 128 ? tbl[d < 0 ? 0 : d] : 31u; \
                    if (sel && pos < TOPK) list[pos] = (unsigned)s | (bk << 16); \
                    base += (int)__popcll(ms); \
                } \
                eqbase += (int)__popcll(meq); } }
__device__ __forceinline__ void idx_fast(Frame& F0) {
    Frame F = F0; rethread(F);
    LAS unsigned char* kbuf = F.lds + RING_OFF;
    LAS unsigned* tbl = (LAS unsigned*)(F.lds + RING_OFF + 2 * IDX_BUFB);
    LAS unsigned* cmk = (LAS unsigned*)(F.lds + RING_OFF + 40960 + F.wave * 8192);
    LAS unsigned* cmi = cmk + IDX_CMAX;
    const int tid = F.tid, lane = F.lane, wave = F.wave, hi = lane >> 5, c32 = lane & 31;
    if (tid < 128) tbl[tid] = t5_bucket(tid);
    __syncthreads();
    const int srow = tid >> 3, sch = tid & 7;
    for (int item = F.vcu; item < 2048; item += F.G) {
        const int kq = item >> 8, w = item & 255, b = kq & 1, q = kq >> 1;
        const int gi = q == 0 ? w : (q == 1 ? 511 - w : (q == 2 ? 512 + w : 1023 - w));
        const int t0 = gi * 8, t = t0 + wave, m = b * SEQ + t;
        unsigned* list = F.LIST() + (size_t)m * TOPK;
        if (t0 + 8 <= TOPK) {
#pragma unroll
            for (int j = 0; j < 4; ++j) { const int i = lane + 64 * j; const int d = t - i; list[i] = i <= t ? ((unsigned)i | (t5_bucket(d < 0 ? 0 : d) << 16)) : 0u; }
            continue;
        }
        const u16* iqp = F.IQ() + (size_t)m * 2048 + c32 * 64 + hi * 8;
        const h8v a0 = *(const h8v*)(iqp), a1 = *(const h8v*)(iqp + 16), a2 = *(const h8v*)(iqp + 32), a3 = *(const h8v*)(iqp + 48);
        f32x16 wr;
#pragma unroll
        for (int r = 0; r < 16; ++r) wr[r] = F.IWS()[(size_t)m * 32 + 8 * (r >> 2) + 4 * hi + (r & 3)] * (0.17677669529663687f * 0.125f);
        f32x2 wrp[8];
#pragma unroll
        for (int r = 0; r < 8; ++r) wrp[r] = (f32x2){wr[2 * r], wr[2 * r + 1]};
        const u32x16 kz = {0u, 0u, 0u, 0u, 0u, 0u, 0u, 0u, 0u, 0u, 0u, 0u, 0u, 0u, 0u, 0u};
        u32x16 k0 = kz, k1 = kz, k2 = kz, k3 = kz, k4 = kz, k5 = kz, k6 = kz, k7 = kz;
        const int nr = (t0 + 8 + IDX_RK - 1) / IDX_RK;
        const u16* kg = F.IKN() + (size_t)b * SEQ * 64;
#if defined(PROBE_IDX) && (PROBE_IDX == 4 || PROBE_IDX == 5)
        { const LAS unsigned char* kl0p = kbuf + c32 * IDX_KST + hi * 16; float dm = 0.f;
          for (int r = 0; r < nr; ++r) {
#pragma unroll
              for (int tt = 0; tt < 4; ++tt) { const LAS unsigned char* kp = kl0p + (r & 1) * IDX_BUFB + tt * 32 * IDX_KST;
                  f32x16 acc = {0.f, 0.f, 0.f, 0.f, 0.f, 0.f, 0.f, 0.f, 0.f, 0.f, 0.f, 0.f, 0.f, 0.f, 0.f, 0.f};
                  acc = __builtin_amdgcn_mfma_f32_32x32x16_f16(a0, *(const LAS h8v*)(kp), acc, 0, 0, 0); acc = __builtin_amdgcn_mfma_f32_32x32x16_f16(a1, *(const LAS h8v*)(kp + 32), acc, 0, 0, 0);
                  acc = __builtin_amdgcn_mfma_f32_32x32x16_f16(a2, *(const LAS h8v*)(kp + 64), acc, 0, 0, 0); acc = __builtin_amdgcn_mfma_f32_32x32x16_f16(a3, *(const LAS h8v*)(kp + 96), acc, 0, 0, 0);
                  if (PROBE_IDX == 5) { float s0 = 0.f, s1 = 0.f, s2 = 0.f, s3 = 0.f;
#pragma unroll
                      for (int q4 = 0; q4 < 16; q4 += 4) { s0 += wr[q4] * relu_i(acc[q4]); s1 += wr[q4 + 1] * relu_i(acc[q4 + 1]); s2 += wr[q4 + 2] * relu_i(acc[q4 + 2]); s3 += wr[q4 + 3] * relu_i(acc[q4 + 3]); }
                      dm += (s0 + s1) + (s2 + s3); }
                  else dm += acc[0] + acc[5]; } }
          if (dm == 123.456f) F.IWS()[(size_t)m * 32] = dm; }
#endif
#if defined(PROBE_IDX) && PROBE_IDX == 3
        { const GAS u16* dp = (const GAS u16*)kg + (size_t)srow * 64 + sch * 8;
          for (int r = 0; r < nr; ++r) { const v4u d0 = *(const GAS v4u*)(dp), d1 = *(const GAS v4u*)(dp + 64 * 64); dp += IDX_RK * 64; asm volatile("" : "+v"(dp));
              LAS unsigned char* nb_ = kbuf + (r & 1) * IDX_BUFB; *(LAS v4u*)(nb_ + srow * IDX_KST + sch * 16) = d0; *(LAS v4u*)(nb_ + (srow + 64) * IDX_KST + sch * 16) = d1; __syncthreads(); } }
#endif
        const GAS u16* pfp = (const GAS u16*)kg + (size_t)srow * 64 + sch * 8;
        v4u pf0 = *(const GAS v4u*)(pfp), pf1 = *(const GAS v4u*)(pfp + 64 * 64); pfp += IDX_RK * 64; asm volatile("" : "+v"(pfp));
        *(LAS v4u*)(kbuf + srow * IDX_KST + sch * 16) = pf0; *(LAS v4u*)(kbuf + (srow + 64) * IDX_KST + sch * 16) = pf1;
        __syncthreads();
        const LAS unsigned char* kl0 = kbuf + c32 * IDX_KST + hi * 16;
        h8v fA, fB, fC; f32x16 accA, accB; float pp0 = 0.f, pp1 = 0.f;
        IDX_LDF(fA, kl0, 0, 0); IDX_LDF(fB, kl0, 0, 1);
#ifndef PROBE_IDX
#define PROBE_IDX 0
#endif
        for (int prb_ = 0; prb_ < ((PROBE_IDX == 1 || PROBE_IDX == 2) ? 2 : 1); ++prb_) {
        const bool stg = !(PROBE_IDX == 2 && prb_ == 0);
        if (prb_ == 1) { pfp = (const GAS u16*)kg + (size_t)srow * 64 + sch * 8; pf0 = *(const GAS v4u*)(pfp); pf1 = *(const GAS v4u*)(pfp + 64 * 64); pfp += IDX_RK * 64; asm volatile("" : "+v"(pfp));
            *(LAS v4u*)(kbuf + srow * IDX_KST + sch * 16) = pf0; *(LAS v4u*)(kbuf + (srow + 64) * IDX_KST + sch * 16) = pf1; __syncthreads(); IDX_LDF(fA, kl0, 0, 0); IDX_LDF(fB, kl0, 0, 1); }
        IDX_CHUNK(k0, k0, 0) IDX_CHUNK(k1, k0, 1) IDX_CHUNK(k2, k1, 2) IDX_CHUNK(k3, k2, 3) IDX_CHUNK(k4, k3, 4) IDX_CHUNK(k5, k4, 5) IDX_CHUNK(k6, k5, 6) IDX_CHUNK(k7, k6, 7)
        }
        const int nreg = 2 * nr;
        unsigned T = 0u; int cT = 1 << 30, bit = 31; bool done = false;
        { unsigned km = 0u;
          IDX_MAX(k0, 0) IDX_MAX(k1, 1) IDX_MAX(k2, 2) IDX_MAX(k3, 3) IDX_MAX(k4, 4) IDX_MAX(k5, 5) IDX_MAX(k6, 6) IDX_MAX(k7, 7)
          km = (unsigned)__builtin_amdgcn_readfirstlane(wave_max_u(km));
          for (unsigned e = km >> 23, tries = 0u; tries < 3u; --e, ++tries) {
              const unsigned cand = e << 23; int cv = 0;
              IDX_COUNT_GE(k0, 0) IDX_COUNT_GE(k1, 1) IDX_COUNT_GE(k2, 2) IDX_COUNT_GE(k3, 3) IDX_COUNT_GE(k4, 4) IDX_COUNT_GE(k5, 5) IDX_COUNT_GE(k6, 6) IDX_COUNT_GE(k7, 7)
              const int c = __builtin_amdgcn_readfirstlane(wave_sum_i(cv));
              if (c >= TOPK) { T = cand; cT = c; done = (c == TOPK); bit = 22; break; }
              if (e == 0u) break; } }
        while (!done && bit >= 0 && cT > IDX_CMAX) {
            const unsigned cand = T | (1u << bit); int cv = 0;
            IDX_COUNT_GE(k0, 0) IDX_COUNT_GE(k1, 1) IDX_COUNT_GE(k2, 2) IDX_COUNT_GE(k3, 3) IDX_COUNT_GE(k4, 4) IDX_COUNT_GE(k5, 5) IDX_COUNT_GE(k6, 6) IDX_COUNT_GE(k7, 7)
            const int c = __builtin_amdgcn_readfirstlane(wave_sum_i(cv));
            if (c >= TOPK) { T = cand; cT = c; }
            done = (c == TOPK); --bit;
        }
        if (done || bit < 0) {
            int cv = 0;
            IDX_COUNT_GT(k0, 0) IDX_COUNT_GT(k1, 1) IDX_COUNT_GT(k2, 2) IDX_COUNT_GT(k3, 3) IDX_COUNT_GT(k4, 4) IDX_COUNT_GT(k5, 5) IDX_COUNT_GT(k6, 6) IDX_COUNT_GT(k7, 7)
            const int need = TOPK - __builtin_amdgcn_readfirstlane(wave_sum_i(cv));
            int base = 0, eqbase = 0;
            IDX_EMIT(k0, 0) IDX_EMIT(k1, 1) IDX_EMIT(k2, 2) IDX_EMIT(k3, 3) IDX_EMIT(k4, 4) IDX_EMIT(k5, 5) IDX_EMIT(k6, 6) IDX_EMIT(k7, 7)
        } else {
            int cb = 0;
            IDX_COMPACT(k0, 0) IDX_COMPACT(k1, 1) IDX_COMPACT(k2, 2) IDX_COMPACT(k3, 3) IDX_COMPACT(k4, 4) IDX_COMPACT(k5, 5) IDX_COMPACT(k6, 6) IDX_COMPACT(k7, 7)
            u32x16 kq;
#pragma unroll
            for (int q = 0; q < 16; ++q) kq[q] = (64 * q + lane) < cb ? cmk[64 * q + lane] : 0u;
            for (; bit >= 0; --bit) {
                const unsigned cand = T | (1u << bit); int cv = 0;
#pragma unroll
                for (int q = 0; q < 16; ++q) cv += kq[q] >= cand ? 1 : 0;
                const int c = __builtin_amdgcn_readfirstlane(wave_sum_i(cv));
                if (c >= TOPK) T = cand;
                if (c == TOPK) break;
            }
            int cv = 0;
#pragma unroll
            for (int q = 0; q < 16; ++q) cv += kq[q] > T ? 1 : 0;
            const int need = TOPK - __builtin_amdgcn_readfirstlane(wave_sum_i(cv));
            int base = 0, eqbase = 0;
#pragma unroll
            for (int q = 0; q < 16; ++q) if (64 * q < cb) {
                const unsigned kk = kq[q];
                const bool gt = kk > T, eq = kk == T && (64 * q + lane) < cb;
                const unsigned long long meq = __ballot(eq);
                const bool sel = gt || (eq && (eqbase + mbcnt64(meq)) < need);
                const unsigned long long ms = __ballot(sel);
                if (ms != 0ull) {
                    const int pos = base + mbcnt64(ms);
                    const int sidx = (int)cmi[64 * q + lane], d = t - sidx;
                    const unsigned bk = d < 128 ? tbl[d < 0 ? 0 : d] : 31u;
                    if (sel && pos < TOPK) list[pos] = (unsigned)sidx | (bk << 16);
                    base += (int)__popcll(ms);
                }
                eqbase += (int)__popcll(meq);
            }
        }
    }
}
template <int O1, int O2> __device__ __forceinline__ void tr8_read2(v2u& a, v2u& b, unsigned addr) {
    asm volatile("ds_read_b64_tr_b8 %0, %2 offset:%3\n\tds_read_b64_tr_b8 %1, %2 offset:%4" : "=&v"(a), "=&v"(b) : "v"(addr), "i"(O1), "i"(O2) : "memory");
}
constexpr int SPA_VST = 288;
constexpr int SPA_V8ST = 144;
constexpr int SPA_WAVE_LDS = 2048 + 64 * SPA_V8ST + 1024 + 64;
__device__ __forceinline__ void sparse_fast(Frame& F0) {
    Frame F = F0; rethread(F);
    const float* const relb_p = F.relb();
    LAS float* rb = (LAS float*)(F.lds + RING_OFF + NWAVES * SPA_WAVE_LDS);
    for (int i = F.tid; i < 512; i += NWAVES * 64) rb[i] = relb_p[i] * 1.4426950408889634f;
    LAS unsigned char* wl = F.lds + RING_OFF + F.wave * SPA_WAVE_LDS;
    LAS unsigned* le = (LAS unsigned*)wl;
    LAS unsigned char* vst = wl + 2048;
    LAS float* lgb = (LAS float*)vst;
    LAS unsigned* pbb = (LAS unsigned*)(wl + 2048 + 64 * SPA_V8ST);
    LAS float* psb = (LAS float*)(wl + 2048 + 64 * SPA_V8ST + 1024);
    LAS u16* ktab = (LAS u16*)(F.lds + RING_OFF + NWAVES * SPA_WAVE_LDS + 2048);
    LAS u16* vtab = (LAS u16*)(F.lds + TAIL_OFF);
    const unsigned vst_addr = (unsigned)(size_t)vst;
    const int lane = F.lane, hh = lane & 15, qd = lane >> 4;
    const int gw = F.vcu * NWAVES + F.wave, NGW = F.G * NWAVES, per = NGW / 8;
    const int bg = gw / per, r0 = gw % per;
    { const int bgc = bg < 8 ? bg : 7; const GAS v4u* ksrc = (const GAS v4u*)(F.KS() + (size_t)bgc * SEQ); const GAS v4u* vsrc = (const GAS v4u*)(F.VS() + (size_t)bgc * SEQ);
      for (int i = F.tid; i < SEQ / 8; i += NWAVES * 64) { ((LAS v4u*)ktab)[i] = ksrc[i]; ((LAS v4u*)vtab)[i] = vsrc[i]; } }
    __syncthreads();
    if (bg < 8) {
    const int b = bg >> 2, g = bg & 3;
    const unsigned tr_base = vst_addr + (unsigned)((16 * qd + (hh >> 1)) * SPA_V8ST + 8 * (hh & 1));
    constexpr int KD = 8;
    unsigned en[4];
    v4u kf[KD + 1][2]; v4u qraw[2]; float sqn = 0.f;
    const unsigned char* const kbase = F.KQ8() + ((size_t)(b * SEQ) * 4 + g) * 128;
    const unsigned klo = 16u * (unsigned)qd, vlo = 16u * (unsigned)(lane & 7);
    const unsigned char* const vbase = F.VQ8() + ((size_t)(b * SEQ) * 4 + g) * 128;
#define SPA_STAGE(tt, leb) do { const int cnt_ = ((tt) + 1) < TOPK ? ((tt) + 1) : TOPK; \
        _Pragma("unroll") for (int j_ = 0; j_ < 4; ++j_) { const int pos_ = 64 * j_ + lane; (leb)[pos_] = pos_ < cnt_ ? en[j_] : 0u; } \
        _Pragma("unroll") for (int pt_ = 0; pt_ < KD; ++pt_) { const unsigned idx_ = (leb)[16 * pt_ + hh] & 0xffffu; const unsigned char* kp_ = kbase + (idx_ * 512u + klo); \
            kf[pt_][0] = *(const v4u*)(kp_); kf[pt_][1] = *(const v4u*)(kp_ + 64); } \
        { const unsigned char* qp_ = F.Q8() + (size_t)(b * SEQ + (tt)) * 2048 + (4 * g + (hh & 3)) * HD + 16 * qd; \
          qraw[0] = __builtin_nontemporal_load((const v4u*)(qp_)); qraw[1] = __builtin_nontemporal_load((const v4u*)(qp_ + 64)); \
          sqn = F.QS()[(size_t)(b * SEQ + (tt)) * 16 + 4 * g + (lane >> 4)]; } } while (0)
    if (r0 < SEQ) {
#pragma unroll
        for (int j = 0; j < 4; ++j) en[j] = __builtin_nontemporal_load(F.LIST() + (size_t)(b * SEQ + r0) * TOPK + 64 * j + lane);
        SPA_STAGE(r0, le);
        { const int tn = (r0 + per) < SEQ ? (r0 + per) : r0;
#pragma unroll
          for (int j = 0; j < 4; ++j) en[j] = __builtin_nontemporal_load(F.LIST() + (size_t)(b * SEQ + tn) * TOPK + 64 * j + lane); }
    }
    int par = 0;
    for (int t = r0; t < SEQ; t += per, par ^= 1) {
        const int m = b * SEQ + t;
        const int cnt = (t + 1) < TOPK ? (t + 1) : TOPK;
        LAS unsigned* lec = le + 256 * par;
        LAS unsigned* len = le + 256 * (par ^ 1);
        v4u vr[2][8];
#pragma unroll
        for (int pt = 0; pt < 2; ++pt)
#pragma unroll
            for (int i = 0; i < 8; ++i) { const int R = 8 * i + (lane >> 3); const int kp = 16 * (R & 3) + 4 * (R >> 4) + ((R >> 2) & 3);
                const unsigned idx = lec[64 * pt + kp] & 0xffffu; vr[pt][i] = *(const v4u*)(vbase + (idx * 512u + vlo)); }
        pg8::i32x4 qf[2]; const float sqs = sqn * (0.08838834764831845f * 1.4426950408889634f);
#pragma unroll
        for (int st = 0; st < 2; ++st) qf[st] = hh < 4 ? __builtin_bit_cast(pg8::i32x4, qraw[st]) : (pg8::i32x4){0, 0, 0, 0};
        float cl[16];
#pragma unroll
        for (int tile = 0; tile < 16; ++tile) {
            if (tile + KD < 16) { const unsigned idx = lec[16 * (tile + KD) + hh] & 0xffffu; const unsigned char* kp = kbase + (idx * 512u + klo);
#pragma unroll
                for (int st = 0; st < 2; ++st) kf[(tile + KD) % (KD + 1)][st] = *(const v4u*)(kp + 64 * st); }
            pg8::i32x4 acc = {0, 0, 0, 0};
#pragma unroll
            for (int st = 0; st < 2; ++st) acc = __builtin_amdgcn_mfma_i32_16x16x64_i8(__builtin_bit_cast(pg8::i32x4, kf[tile % (KD + 1)][st]), qf[st], acc, 0, 0, 0);
            if (hh < 4) *(LAS pg8::i32x4*)(lgb + 64 * tile + 16 * hh + 4 * qd) = acc;
        }
#pragma unroll
        for (int tile = 0; tile < 16; ++tile) cl[tile] = (float)((const LAS int*)lgb)[64 * tile + lane];
        const int ch = lane >> 4, ck = lane & 15;
        float mx = -INFINITY;
#pragma unroll
        for (int tile = 0; tile < 16; ++tile) { const int pos = 16 * tile + ck; const unsigned e = lec[pos];
            const float bias = rb[((e >> 16) & 31u) * 16 + 4 * g + ch];
            const float lgv = cl[tile] * (hlo((unsigned)ktab[e & 0xffffu]) * sqs) + bias; const float lg = pos < cnt ? lgv : -INFINITY;
            cl[tile] = lg; mx = fmaxf(mx, lg); }
        mx = fmaxf(mx, xshf<1>(mx)); mx = fmaxf(mx, xshf<2>(mx)); mx = fmaxf(mx, xshf<4>(mx)); mx = fmaxf(mx, xshf<8>(mx));
        float ps = 0.f;
#pragma unroll
        for (int tile = 0; tile < 16; ++tile) { const float p = __builtin_amdgcn_exp2f(cl[tile] - mx); cl[tile] = p; ps += p; }
        ps += xshf<1>(ps); ps += xshf<2>(ps); ps += xshf<4>(ps); ps += xshf<8>(ps);
        float pm = 0.f;
#pragma unroll
        for (int tile = 0; tile < 16; ++tile) { cl[tile] *= hlo((unsigned)vtab[lec[16 * tile + ck] & 0xffffu]); pm = fmaxf(pm, cl[tile]); }
        pm = fmaxf(pm, xshf<1>(pm)); pm = fmaxf(pm, xshf<2>(pm)); pm = fmaxf(pm, xshf<4>(pm)); pm = fmaxf(pm, xshf<8>(pm));
        { const float pinv = pm > 0.f ? 127.0f / pm : 0.f;
#pragma unroll
          for (int T = 0; T < 4; ++T) pbb[ch * 64 + T * 16 + ck] = q4((f32x4){cl[4 * T], cl[4 * T + 1], cl[4 * T + 2], cl[4 * T + 3]}, pinv); }
        if (ck == 0) { psb[2 * ch] = pm * (1.0f / 127.0f) / ps; }
        const float oscale = psb[2 * (hh & 3)];
        { const int tn = (t + per) < SEQ ? (t + per) : t;
          SPA_STAGE(tn, len);
          const int tnn = (tn + per) < SEQ ? (tn + per) : tn;
#pragma unroll
          for (int j = 0; j < 4; ++j) en[j] = __builtin_nontemporal_load(F.LIST() + (size_t)(b * SEQ + tnn) * TOPK + 64 * j + lane); }
        pg8::i32x4 oacc[8];
#pragma unroll
        for (int dt = 0; dt < 8; ++dt) oacc[dt] = (pg8::i32x4){0, 0, 0, 0};
#pragma unroll
        for (int T = 0; T < 4; ++T) {
#pragma unroll
            for (int i = 0; i < 8; ++i) *(LAS v4u*)(vst + (8 * i + (lane >> 3)) * SPA_V8ST + (lane & 7) * 16) = vr[T & 1][i];
            if (T + 2 < 4) {
#pragma unroll
                for (int i = 0; i < 8; ++i) { const int R = 8 * i + (lane >> 3); const int kp = 16 * (R & 3) + 4 * (R >> 4) + ((R >> 2) & 3);
                    const unsigned idx = lec[64 * (T + 2) + kp] & 0xffffu; vr[T & 1][i] = *(const v4u*)(vbase + (idx * 512u + vlo)); } }
            const pg8::i32x4 pq = __builtin_bit_cast(pg8::i32x4, *(const LAS v4u*)(pbb + (hh & 3) * 64 + T * 16 + 4 * qd));
            v2u fa[8], fb[8];
            tr8_read2<0, 8 * SPA_V8ST>(fa[0], fb[0], tr_base); tr8_read2<16, 8 * SPA_V8ST + 16>(fa[1], fb[1], tr_base);
            tr8_read2<32, 8 * SPA_V8ST + 32>(fa[2], fb[2], tr_base); tr8_read2<48, 8 * SPA_V8ST + 48>(fa[3], fb[3], tr_base);
            tr8_read2<64, 8 * SPA_V8ST + 64>(fa[4], fb[4], tr_base); tr8_read2<80, 8 * SPA_V8ST + 80>(fa[5], fb[5], tr_base);
            tr8_read2<96, 8 * SPA_V8ST + 96>(fa[6], fb[6], tr_base); tr8_read2<112, 8 * SPA_V8ST + 112>(fa[7], fb[7], tr_base);
            asm volatile("s_waitcnt lgkmcnt(0)" : "+v"(fa[0]), "+v"(fb[0]), "+v"(fa[1]), "+v"(fb[1]), "+v"(fa[2]), "+v"(fb[2]), "+v"(fa[3]), "+v"(fb[3]),
                         "+v"(fa[4]), "+v"(fb[4]), "+v"(fa[5]), "+v"(fb[5]), "+v"(fa[6]), "+v"(fb[6]), "+v"(fa[7]), "+v"(fb[7]) :: "memory");
#pragma unroll
            for (int dt = 0; dt < 8; ++dt) { pg8::i32x4 vw; vw[0] = (int)fa[dt].x; vw[1] = (int)fa[dt].y; vw[2] = (int)fb[dt].x; vw[3] = (int)fb[dt].y;
                oacc[dt] = __builtin_amdgcn_mfma_i32_16x16x64_i8(vw, pq, oacc[dt], 0, 0, 0); }
        }
        float ss = 0.f;
        u16* orow = F.O() + (size_t)m * DM + (4 * g + (hh & 3)) * HD + 4 * qd;
#pragma unroll
        for (int dt = 0; dt < 8; ++dt) { const f32x4 o = __builtin_convertvector(oacc[dt], f32x4) * oscale; ss += (o.x * o.x + o.y * o.y) + (o.z * o.z + o.w * o.w);
            if (hh < 4) { v2u w; w.x = pk2(o.x, o.y); w.y = pk2(o.z, o.w); __builtin_nontemporal_store(w, (v2u*)(orow + 16 * dt)); } }
        ss += xshf<16>(ss); ss += xshf<32>(ss);
        if (lane < 4) F.SSQ()[m * 32 + 4 * g + lane] = ss;
    }
    }
}
template <bool FILL> __device__ __forceinline__ void p6_norm(Frame& F0) {
    Frame F = F0; rethread(F);
    const float* const gn_a_p = F.gn_a();
    const float* const gn_b_p = F.gn_b();
    const int gw = F.vcu * NWAVES + F.wave, NGW = F.G * NWAVES;
    LAS float* pl = (LAS float*)(F.lds + RING_OFF);
    if (FILL) { lds_fill(pl, gn_a_p, 2048, F.tid); lds_fill(pl + 2048, gn_b_p, 2048, F.tid); }
    __syncthreads();
    for (int m = gw; m < M; m += NGW) {
        const float sv = F.lane < 32 ? F.SSQ()[m * 32 + F.lane] : 0.f;
        float sa = F.lane < 16 ? sv : 0.f, sb = (F.lane >= 16 && F.lane < 32) ? sv : 0.f;
        sa = wave_sum(sa); sb = wave_sum(sb);
        const float ra = 1.f / sqrtf(sa * (1.f / 2048.f) + LN_EPS), rb = 1.f / sqrtf(sb * (1.f / 2048.f) + LN_EPS);
        const GAS v4u* src = (const GAS v4u*)(F.O() + (size_t)m * DM) + F.lane;
        f32x4 y[16]; float am = 0.f;
#pragma unroll
        for (int j = 0; j < 8; ++j) { const int col = 8 * (F.lane + 64 * j); const v4u w = src[64 * j];
            const float r = col < 2048 ? ra : rb;
            const f32x4 g0 = ldl(pl, 32u * (unsigned)F.lane, 512 * j), g1 = ldl(pl, 32u * (unsigned)F.lane, 512 * j + 4);
            y[2 * j] = (f32x4){bflo(w.x), bfhi(w.x), bflo(w.y), bfhi(w.y)} * r * g0; y[2 * j + 1] = (f32x4){bflo(w.z), bfhi(w.z), bflo(w.w), bfhi(w.w)} * r * g1;
            am = fmaxf(am, fmaxf(amax4(y[2 * j]), amax4(y[2 * j + 1]))); }
        am = wave_max(am); const float inv = am > 0.f ? 127.0f / am : 0.f;
        if (F.lane == 0) F.SA_ON()[m] = am * (1.0f / 127.0f);
        GAS v2u* dst = (GAS v2u*)(F.ONQ() + (size_t)m * DM) + F.lane;
#pragma unroll
        for (int j = 0; j < 8; ++j) { v2u o; o.x = q4(y[2 * j], inv); o.y = q4(y[2 * j + 1], inv); dst[64 * j] = o; }
    }
}
template <bool FILL> __device__ __forceinline__ void p8_rows(Frame& F0) {
    Frame F = F0; rethread(F);
    const float* const ln1_g_p = F.ln1_g();
    const float* const ln1_b_p = F.ln1_b();
    const int gw = F.vcu * NWAVES + F.wave, NGW = F.G * NWAVES;
    LAS float* pl = (LAS float*)(F.lds + RING_OFF);
    if (FILL) { lds_fill(pl, ln1_g_p, DM, F.tid); lds_fill(pl + DM, ln1_b_p, DM, F.tid);
        lds_fill(pl + 2 * DM, F.MOD() + 3 * DM, 2 * DM, F.tid); lds_fill(pl + 4 * DM, F.MOD() + 9 * DM, 2 * DM, F.tid); }
    __syncthreads();
    for (int m = gw; m < M; m += NGW) {
        const GAS v4u* xr = (const GAS v4u*)(F.V1B() + (size_t)m * DM) + F.lane;
        f32x4 v[16]; float s = 0.f;
#pragma unroll
        for (int j = 0; j < 8; ++j) { const v4u w = xr[64 * j]; v[2 * j] = (f32x4){bflo(w.x), bfhi(w.x), bflo(w.y), bfhi(w.y)}; v[2 * j + 1] = (f32x4){bflo(w.z), bfhi(w.z), bflo(w.w), bfhi(w.w)}; }
#pragma unroll
        for (int j = 0; j < 16; ++j) s += (v[j].x + v[j].y) + (v[j].z + v[j].w);
        const float mean = wave_sum(s) * (1.f / DM); float s2 = 0.f;
#pragma unroll
        for (int j = 0; j < 16; ++j) { v[j] = v[j] - mean; s2 += (v[j].x * v[j].x + v[j].y * v[j].y) + (v[j].z * v[j].z + v[j].w * v[j].w); }
        const float rstd = 1.f / sqrtf(wave_sum(s2) * (1.f / DM) + LN_EPS);
        if (F.lane == 0) { F.ST1()[2 * m] = mean; F.ST1()[2 * m + 1] = rstd; }
        LAS float* mod = pl + 2 * DM + (m / SEQ) * (2 * DM);
        float am = 0.f;
#pragma unroll
        for (int j = 0; j < 16; ++j) { if ((j & 3) == 0) asm volatile("" ::: "memory");
            const unsigned lb = 32u * (unsigned)F.lane; const int cj = 512 * (j >> 1) + 4 * (j & 1);
            const f32x4 gg = ldl(pl, lb, cj), bb = ldl(pl, lb, DM + cj), sh = ldl(mod, lb, cj), sc = ldl(mod, lb, DM + cj);
            const f32x4 h = v[j] * rstd * gg + bb; const f32x4 u = h * (sc + 1.0f) + sh; v[j] = u; am = fmaxf(am, amax4(u)); }
        am = wave_max(am); const float inv = am > 0.f ? 127.0f / am : 0.f;
        if (F.lane == 0) F.SA_U1()[m] = am * (1.0f / 127.0f);
        GAS v2u* oq = (GAS v2u*)(F.U1Q() + (size_t)m * DM) + F.lane;
#pragma unroll
        for (int j = 0; j < 8; ++j) { v2u o; o.x = q4(v[2 * j], inv); o.y = q4(v[2 * j + 1], inv); oq[64 * j] = o; }
    }
}
template <bool FILL> __device__ __forceinline__ void p11_rows(Frame& F0) {
    Frame F = F0; rethread(F);
    const float* const ln2_g_p = F.ln2_g();
    const float* const ln2_b_p = F.ln2_b();
    float* const out_p = F.out();
    const int gw = F.vcu * NWAVES + F.wave, NGW = F.G * NWAVES;
    LAS float* pl = (LAS float*)(F.lds + RING_OFF);
    if (FILL) { lds_fill(pl, ln2_g_p, DM, F.tid); lds_fill(pl + DM, ln2_b_p, DM, F.tid); }
    __syncthreads();
    for (int m = gw; m < M; m += NGW) {
        const GAS v4u* xr = (const GAS v4u*)(F.H0B() + (size_t)m * DM) + F.lane;
        f32x4 v[16]; float s = 0.f;
#pragma unroll
        for (int j = 0; j < 8; ++j) { const v4u w = xr[64 * j]; v[2 * j] = (f32x4){bflo(w.x), bfhi(w.x), bflo(w.y), bfhi(w.y)}; v[2 * j + 1] = (f32x4){bflo(w.z), bfhi(w.z), bflo(w.w), bfhi(w.w)}; }
#pragma unroll
        for (int j = 0; j < 16; ++j) s += (v[j].x + v[j].y) + (v[j].z + v[j].w);
        const float mean = wave_sum(s) * (1.f / DM); float s2 = 0.f;
#pragma unroll
        for (int j = 0; j < 16; ++j) { v[j] = v[j] - mean; s2 += (v[j].x * v[j].x + v[j].y * v[j].y) + (v[j].z * v[j].z + v[j].w * v[j].w); }
        const float rstd = 1.f / sqrtf(wave_sum(s2) * (1.f / DM) + LN_EPS);
        GAS f32x4* orow = (GAS f32x4*)(out_p + (size_t)m * DM) + 2 * F.lane;
#pragma unroll
        for (int j = 0; j < 16; ++j) { if ((j & 3) == 0) asm volatile("" ::: "memory");
            const unsigned lb = 32u * (unsigned)F.lane; const int cj = 512 * (j >> 1) + 4 * (j & 1);
            const f32x4 gg = ldl(pl, lb, cj), bb = ldl(pl, lb, DM + cj);
            orow[128 * (j >> 1) + (j & 1)] = v[j] * rstd * gg + bb; }
    }
}

__device__ __forceinline__ void pre_fill_sync() { asm volatile("s_waitcnt vmcnt(0) lgkmcnt(0)" ::: "memory"); __syncthreads(); }
__device__ __forceinline__ void p1_fill_ln(Frame& F0) { Frame F = F0; rethread(F); LAS float* pl = (LAS float*)(F.lds + RING_OFF); lds_fill(pl, F.in_g(), DM, F.tid); lds_fill(pl + DM, F.in_b(), DM, F.tid); }
__device__ __forceinline__ void p6_fill(Frame& F0) { Frame F = F0; rethread(F); LAS float* pl = (LAS float*)(F.lds + RING_OFF); lds_fill(pl, F.gn_a(), 2048, F.tid); lds_fill(pl + 2048, F.gn_b(), 2048, F.tid); }
__device__ __forceinline__ void p8_fill(Frame& F0) { Frame F = F0; rethread(F); LAS float* pl = (LAS float*)(F.lds + RING_OFF); lds_fill(pl, F.ln1_g(), DM, F.tid); lds_fill(pl + DM, F.ln1_b(), DM, F.tid);
    lds_fill(pl + 2 * DM, F.MOD() + 3 * DM, 2 * DM, F.tid); lds_fill(pl + 4 * DM, F.MOD() + 9 * DM, 2 * DM, F.tid); }
__device__ __forceinline__ void p11_fill(Frame& F0) { Frame F = F0; rethread(F); LAS float* pl = (LAS float*)(F.lds + RING_OFF); lds_fill(pl, F.ln2_g(), DM, F.tid); lds_fill(pl + DM, F.ln2_b(), DM, F.tid); }

__global__ void __launch_bounds__(NWAVES * 64, 2) hybrid_fwd(Args args) {
    extern __shared__ __attribute__((aligned(16))) unsigned char lds[];
    Frame F;
    F.lds = (LAS unsigned char*)lds;
    F.MISC = (volatile LAS unsigned*)(F.lds + MISC_OFF);
    F.wave = __builtin_amdgcn_readfirstlane((int)threadIdx.x >> 6); rethread(F);
#define REFRAME() do { const unsigned char CAS* kp_ = (const unsigned char CAS*)__builtin_amdgcn_kernarg_segment_ptr(); asm volatile("" : "+s"(kp_)); \
        F.ws = *(unsigned char* const CAS*)(kp_ + 160); F.ctl = (gu32*)(F.ws + WS_CTL); \
        unsigned gd_ = gridDim.x; asm volatile("" : "+s"(gd_)); F.G = (int)gd_; \
        { const int bx = blockIdx.x; F.vcu = (F.G % 8 == 0) ? (bx % 8) * (F.G / 8) + bx / 8 : bx; } } while (0)
    REFRAME();
    for (int u = F.tid; u < (LDS_BYTES - LDSCTL_OFF) / 4; u += NWAVES * 64) ((LAS unsigned*)(F.lds + LDSCTL_OFF))[u] = 0u;
    __syncthreads();
    if (N_LAUNCHES == 1) (void)xcd_barrier_post((unsigned*)(F.ctl + CW_BAR), F.MISC + 8, F.tid == 0);
#define GRID_BAR() do { if (N_LAUNCHES == 1) { REFRAME(); XcdBarrier bar_; bar_.bar = (unsigned*)(F.ctl + CW_BAR); bar_.x = xb_xcc_id(); bar_.st = F.MISC + 8; xcd_barrier(bar_, F.wave == 0 && lane_now() == 0); REFRAME(); } } while (0)
#ifndef PH_MASK
#define PH_MASK 0xfff
#endif
#if MK_N_LAUNCHES == 1
#define IN(k) (((PH_MASK) >> (k)) & 1)
#else
    const int lo = args.ph_lo, hi = args.ph_hi;
#define IN(k) ((((PH_MASK) >> (k)) & 1) && lo <= (k) && (k) < hi)
#endif
#define BOTH(k) (IN(k) && IN((k) + 1))
#ifndef PROBE_PH
#define PROBE_PH -1
#endif
#define REP(k) for (int rep_ = 0; rep_ < ((PROBE_PH == (k)) ? 2 : 1); ++rep_)

    if (IN(0)) { REP(0) { p0_prologue(F); __syncthreads(); } if (BOTH(0)) GRID_BAR(); }
    if (IN(1)) { p1a_modsum(F); p1_fill_ln(F); GRID_BAR(); REP(1) p1_rows<(PROBE_PH == 1)>(F); if (BOTH(1)) GRID_BAR(); }
    if (IN(2)) { REP(2) {
        { pg8::Gemm g{(const u16*)F.UQ(), (const u16*)F.WIN_Q(), M, NP_BF, DM / 2, DM / 2}; pg8::StaticOrder S; S.init(M, NP_BF, F.G, (int)blockIdx.x);
          pg8::EpiQBf16<0> E{F.PROJ(), NP_BF, F.SA_U(), F.SW()};
          pg8::gemm_phase<pg8::EpiQBf16<0>, pg8::StaticOrder, 2, false, PG8_ALIGN, PG8_SP2>(F.lds + RING_OFF, g, S, E, F.wave * 64 + lane_now()); }
        { pg8::Gemm g{F.UH(), F.WIN_H(), M, 2048, DM, DM}; pg8::StaticOrder S; S.init(M, 2048, F.G, (int)blockIdx.x);
          pg8::EpiIdx E{F.IQ()};
          pg8::gemm_phase<pg8::EpiIdx, pg8::StaticOrder, 1, false, PG8_ALIGN, PG8_SP2>(F.lds + RING_OFF, g, S, E, F.wave * 64 + lane_now()); }
        { pg8::Gemm g{F.UH(), F.WIN_H() + (size_t)2048 * DM, M, 4 * 256, DM / 4, DM}; pg8::StaticOrder S; S.init(M, 4 * 256, F.G, (int)blockIdx.x);
          pg8::EpiTail E{F.IKWP(), (size_t)M * 128};
          pg8::gemm_phase<pg8::EpiTail, pg8::StaticOrder, 1, true, PG8_ALIGN, PG8_SP2>(F.lds + RING_OFF, g, S, E, F.wave * 64 + lane_now()); } }
        if (BOTH(2)) GRID_BAR();
    }
    if (IN(3)) { p3_kq8(F); p3_ikn(F); REP(3) sb_fast(F); if (BOTH(3)) GRID_BAR(); }
    if (IN(4)) { REP(4) { idx_fast(F); __syncthreads(); } if (BOTH(4)) GRID_BAR(); }
    if (IN(5)) { REP(5) { sparse_fast(F); __syncthreads(); } if (BOTH(5)) { if (IN(6)) p6_fill(F); GRID_BAR(); } }
    if (IN(6)) { REP(6) p6_norm<!(IN(5) && N_LAUNCHES == 1 && PROBE_PH != 6)>(F); if (BOTH(6)) GRID_BAR(); }
    if (IN(7)) { REP(7) {
        pg8::Gemm g{(const u16*)F.ONQ(), (const u16*)F.WOUT_Q(), M, DM, DM / 2, DM / 2}; pg8::StaticOrder S; S.init(M, DM, F.G, (int)blockIdx.x);
        pg8::EpiOut E{F.H0B(), F.MOD() + 2 * DM, F.V1B(), F.SA_ON(), F.SW() + NP_BF};
        pg8::gemm_phase<pg8::EpiOut, pg8::StaticOrder, 2, false, PG8_ALIGN, PG8_SP2>(F.lds + RING_OFF, g, S, E, F.wave * 64 + lane_now()); }
        if (BOTH(7)) { if (IN(8)) { pre_fill_sync(); p8_fill(F); } GRID_BAR(); }
    }
    if (IN(8)) { REP(8) p8_rows<!(IN(7) && N_LAUNCHES == 1 && PROBE_PH != 8)>(F); if (BOTH(8)) GRID_BAR(); }
#ifndef PROBE_GK
#define PROBE_GK 0
#endif
    if (IN(9) && PROBE_GK == 2) {
        struct SameOrder { __device__ bool next(int i, pg8::Unit& u) const { u.pm = 0; u.pn = 0; return i < 16; } __device__ void a_ready(const pg8::Unit&) const {} __device__ void done(const pg8::Unit&) const {} };
        pg8::Gemm g{(const u16*)F.U1Q(), (const u16*)F.WUP_Q(), M, DFF, DM / 2, DM / 2}; SameOrder S;
        pg8::EpiQF8 E{F.HID8(), DFF, F.SA_U1(), F.SW() + NP_BF + DM};
        pg8::gemm_phase<pg8::EpiQF8, SameOrder, 2, false, PG8_ALIGN, PG8_SP2>(F.lds + RING_OFF, g, S, E, F.wave * 64 + lane_now());
        __syncthreads();
    }
    if (IN(9) && PROBE_GK == 1) {
        pg8::Gemm g{(const u16*)F.U1Q(), (const u16*)F.WUP_Q(), M, DFF, DM / 4, DM / 2}; pg8::StaticOrder S; S.init(M, DFF, F.G, (int)blockIdx.x);
        pg8::EpiQF8 E{F.HID8(), DFF, F.SA_U1(), F.SW() + NP_BF + DM};
        pg8::gemm_phase<pg8::EpiQF8, pg8::StaticOrder, 2, false, PG8_ALIGN, PG8_SP2>(F.lds + RING_OFF, g, S, E, F.wave * 64 + lane_now());
        __syncthreads();
    }
    if (IN(9)) { REP(9) {
        pg8::Gemm g{(const u16*)F.U1Q(), (const u16*)F.WUP_Q(), M, DFF, DM / 2, DM / 2}; pg8::StaticOrder S; S.init(M, DFF, F.G, (int)blockIdx.x);
        pg8::EpiQF8 E{F.HID8(), DFF, F.SA_U1(), F.SW() + NP_BF + DM};
        pg8::gemm_phase<pg8::EpiQF8, pg8::StaticOrder, 2, false, PG8_ALIGN, PG8_SP2>(F.lds + RING_OFF, g, S, E, F.wave * 64 + lane_now()); }
        if (BOTH(9)) GRID_BAR();
    }
    if (IN(10)) {
        pg8::Gemm g{(const u16*)F.HID8(), (const u16*)F.WDOWN8(), M, DM, DFF / 2, DFF / 2}; pg8::StaticOrder S; S.init(M, DM, F.G, (int)blockIdx.x);
        pg8::EpiDown E{F.MOD() + 5 * DM, F.H0B()  , F.ST1(), F.ln1_g(), F.ln1_b(), F.SW() + NP_BF + DM + DFF, F.V1B()};
        pg8::gemm_phase<pg8::EpiDown, pg8::StaticOrder, 3, false, PG8_ALIGN, PG8_SP2>(F.lds + RING_OFF, g, S, E, F.wave * 64 + lane_now());
        if (BOTH(10)) { if (IN(11)) { pre_fill_sync(); p11_fill(F); } GRID_BAR(); }
    }
    if (IN(11)) { p11_rows<!(IN(10) && N_LAUNCHES == 1)>(F); }
#undef IN
#undef BOTH
}

extern "C" void kernel_launch(void* const* d_in, const int* in_sizes, int n_in, void* d_out, int out_size, void* d_ws, size_t ws_size, hipStream_t stream) {
    static int grid = 0;
    if (grid == 0) {
        if (n_in != 19 || in_sizes[0] != M * DM || out_size != M * DM || ws_size < WS_END) { fprintf(stderr, "kernel_launch: unexpected shapes (n_in %d, in0 %d, out %d, ws %zu, need %zu); nothing launched\n", n_in, n_in > 0 ? in_sizes[0] : -1, out_size, ws_size, (size_t)WS_END); grid = -1; return; }
        int dev = 0, cus = 0, per_cu = 0;
        if (hipGetDevice(&dev) != hipSuccess || hipDeviceGetAttribute(&cus, hipDeviceAttributeMultiprocessorCount, dev) != hipSuccess) { fprintf(stderr, "kernel_launch: device query failed\n"); grid = -1; return; }
        if (hipFuncSetAttribute((const void*)hybrid_fwd, hipFuncAttributeMaxDynamicSharedMemorySize, LDS_BYTES) != hipSuccess) { fprintf(stderr, "kernel_launch: hipFuncSetAttribute failed\n"); grid = -1; return; }
        if (hipOccupancyMaxActiveBlocksPerMultiprocessor(&per_cu, (const void*)hybrid_fwd, NWAVES * 64, LDS_BYTES) != hipSuccess || per_cu < 1)
            fprintf(stderr, "kernel_launch: note: occupancy query reports %d workgroups per CU\n", per_cu);
        (void)hipGetLastError();
        grid = cus & ~7;
    }
    if (grid < 0) return;
    if (hipMemsetAsync((char*)d_ws + WS_CTL, 0, CTL_ZERO_BYTES, stream) != hipSuccess) { fprintf(stderr, "kernel_launch: memset failed\n"); return; }
    Args a{};
    for (int i = 0; i < 19; ++i) a.in[i] = (const float*)d_in[i];
    a.out = (float*)d_out; a.ws = (unsigned char*)d_ws;
    for (int li = 0; li < N_LAUNCHES; ++li) {
        a.ph_lo = (N_LAUNCHES == 1) ? 0 : li; a.ph_hi = (N_LAUNCHES == 1) ? N_PHASES : li + 1; a.li = li; a.pad = 0;
        hipLaunchKernelGGL(hybrid_fwd, dim3(grid), dim3(NWAVES * 64), LDS_BYTES, stream, a);
        const hipError_t le = hipPeekAtLastError();
        if (le != hipSuccess) { fprintf(stderr, "kernel_launch: launch %d failed: %s\n", li, hipGetErrorName(le)); break; }
    }
}
```

```cpp
#include <hip/hip_runtime.h>
#include <cstdio>
#include <cstdint>
#include <cmath>
namespace pg8 {
#define PG8_LAS __attribute__((address_space(3)))
typedef unsigned short bf16_t;
typedef short bf16x8 __attribute__((ext_vector_type(8)));
typedef float f32x4 __attribute__((ext_vector_type(4)));
typedef unsigned u32x4 __attribute__((ext_vector_type(4)));
constexpr int BM = 256, BK = 64, HALF = 128, HTB = HALF * BK * 2  , STAGE_BYTES = 8 * HTB, NXCD = 8, WGM = 8;

__host__ __device__ __forceinline__ int lds_byte(int r, int c) { const int st = (r >> 4) * 2 + (c >> 5), rr = r & 15, cc = c & 31, ob = rr * 64 + cc * 2; return st * 1024 + (ob ^ (((ob >> 9) & 1) << 5)); }
__host__ __device__ __forceinline__ void stage_rc(int b, int& R, int& C) { const int st = b / 1024, sb = b % 1024, swz = sb ^ (((sb >> 9) & 1) << 5); R = (st >> 1) * 16 + swz / 64; C = (st & 1) * 32 + (swz % 64) / 2; }
__host__ __device__ __forceinline__ int perm32(int rho) { const int n = rho >> 4, i = rho & 15; return 8 * (i >> 2) + 4 * n + (i & 3); }

struct Unit { int pm, pn; };
struct Gemm { const bf16_t* A; const bf16_t* Bt; int M, N, K, ld; };

struct StaticOrder {
    int nM, nN, nwg, G, c;
    __host__ __device__ void init(int M, int N, int G_, int c_) { nM = M / BM; nN = N / BM; nwg = nM * nN; G = G_; c = c_; }
    __host__ __device__ bool next(int i, Unit& u) const {
        const long L = (long)i * G + c; if (L >= nwg) return false;
        int wgid = (int)L; { const int q = nwg / NXCD, r = nwg % NXCD, xcd = wgid % NXCD, off = wgid / NXCD; wgid = (xcd < r ? xcd * (q + 1) : r * (q + 1) + (xcd - r) * q) + off; }
        const int nig = WGM * nN, gid = wgid / nig, fm = gid * WGM, gsz = (nM - fm) < WGM ? (nM - fm) : WGM;
        u.pm = fm + ((wgid % nig) % gsz); u.pn = (wgid % nig) / gsz; return true;
    }
    __device__ __forceinline__ void a_ready(const Unit&) const {}
    __device__ __forceinline__ void done(const Unit&) const {}
};

typedef float cvt_f2 __attribute__((ext_vector_type(2)));
typedef __bf16 cvt_b2 __attribute__((ext_vector_type(2)));
__device__ __forceinline__ unsigned cvt_pk_bf16(float lo, float hi) { const cvt_f2 v = {lo, hi}; const cvt_b2 r = __builtin_convertvector(v, cvt_b2); return __builtin_bit_cast(unsigned, r); }
constexpr float EPI_ALPHA = 1.189207115002721f;
constexpr long long EPI_BQ_OFF = 640ll << 20, EPI_BK_OFF = -(128ll << 20), EPI_BV_OFF = -(64ll << 20);
constexpr int EPI_SEQ = 8192, EPI_GSTRIDE = 6 * 4096;
typedef _Float16 f16x8 __attribute__((ext_vector_type(8)));
typedef _Float16 f16x2 __attribute__((ext_vector_type(2)));
typedef unsigned u32x2 __attribute__((ext_vector_type(2)));
__device__ __forceinline__ unsigned cvt_pk_f16(float lo, float hi) { f16x2 h; h.x = (_Float16)lo; h.y = (_Float16)hi; return __builtin_bit_cast(unsigned, h); }
typedef int i32x4 __attribute__((ext_vector_type(4)));
template <int MODE> __device__ __forceinline__ f32x4 mma16(bf16x8 a, bf16x8 b, f32x4 c) {
    if constexpr (MODE == 1) return __builtin_amdgcn_mfma_f32_16x16x32_f16(__builtin_bit_cast(f16x8, a), __builtin_bit_cast(f16x8, b), c, 0, 0, 0);
    else if constexpr (MODE == 2) return __builtin_bit_cast(f32x4, __builtin_amdgcn_mfma_i32_16x16x64_i8(__builtin_bit_cast(i32x4, a), __builtin_bit_cast(i32x4, b), __builtin_bit_cast(i32x4, c), 0, 0, 0));
    else return __builtin_amdgcn_mfma_f32_16x16x32_bf16(a, b, c, 0, 0, 0);
}
typedef int i32x8 __attribute__((ext_vector_type(8)));
__device__ __forceinline__ f32x4 mma_f8(bf16x8 a0, bf16x8 a1, bf16x8 b0, bf16x8 b1, f32x4 c) {
    const i32x4 x0 = __builtin_bit_cast(i32x4, a0), x1 = __builtin_bit_cast(i32x4, a1), y0 = __builtin_bit_cast(i32x4, b0), y1 = __builtin_bit_cast(i32x4, b1);
    const i32x8 a = {x0[0], x0[1], x0[2], x0[3], x1[0], x1[1], x1[2], x1[3]}, b = {y0[0], y0[1], y0[2], y0[3], y1[0], y1[1], y1[2], y1[3]};
    const int sc1 = 0x7f7f7f7f;
    asm volatile("v_mfma_scale_f32_16x16x128_f8f6f4 %0, %1, %2, %0, %3, %3 op_sel_hi:[0,0,0]" : "+v"(c) : "v"(a), "v"(b), "v"(sc1));
    return c;
}
__device__ __forceinline__ f32x4 acc_i2f(const f32x4 a) { return __builtin_convertvector(__builtin_bit_cast(i32x4, a), f32x4); }

template <int ACT  > struct EpiBf16 {
    static constexpr bool PERM = true, AFTER_DRAIN = false;
    bf16_t* O; int ldc;
    __device__ __forceinline__ void operator()(const f32x4 (&acc)[2][2][4][2], const Unit& u, int wr, int wc, int fr, int fq) const {
        const int row0 = u.pm * BM + wr * 64 + fr; const int col0 = u.pn * BM + wc * 32 + 8 * fq;
#pragma unroll
        for (int ai = 0; ai < 2; ++ai)
#pragma unroll
            for (int m = 0; m < 4; ++m) { bf16_t* rowp = O + (size_t)(row0 + ai * HALF + m * 16) * ldc + col0;
#pragma unroll
                for (int bj = 0; bj < 2; ++bj) { f32x4 v0 = acc[ai][bj][m][0], v1 = acc[ai][bj][m][1];
                    if (ACT == 1) {
#pragma unroll
                        for (int j = 0; j < 4; ++j) { const float a = fmaxf(v0[j], 0.f), b = fmaxf(v1[j], 0.f); v0[j] = a * a; v1[j] = b * b; } }
                    u32x4 w; w.x = cvt_pk_bf16(v0[0], v0[1]); w.y = cvt_pk_bf16(v0[2], v0[3]); w.z = cvt_pk_bf16(v1[0], v1[1]); w.w = cvt_pk_bf16(v1[2], v1[3]);
                    *(u32x4*)(rowp + bj * HALF) = w; } }
    }
};
struct EpiIdx {
    static constexpr bool PERM = true, AFTER_DRAIN = false;
    bf16_t* IQ;
    __device__ __forceinline__ void operator()(const f32x4 (&acc)[2][2][4][2], const Unit& u, int wr, int wc, int fr, int fq) const {
        const int row0 = u.pm * BM + wr * 64 + fr; const int col0 = u.pn * BM + wc * 32 + 8 * fq;
#pragma unroll
        for (int ai = 0; ai < 2; ++ai)
#pragma unroll
            for (int m = 0; m < 4; ++m) { bf16_t* rowp = IQ + (size_t)(row0 + ai * HALF + m * 16) * 2048 + col0;
#pragma unroll
                for (int bj = 0; bj < 2; ++bj) { const f32x4 v0 = acc[ai][bj][m][0], v1 = acc[ai][bj][m][1];
                    u32x4 w; w.x = cvt_pk_f16(v0[0], v0[1]); w.y = cvt_pk_f16(v0[2], v0[3]); w.z = cvt_pk_f16(v1[0], v1[1]); w.w = cvt_pk_f16(v1[2], v1[3]);
                    *(u32x4*)(rowp + bj * HALF) = w; } }
    }
};
struct EpiTail {
    static constexpr bool PERM = true, AFTER_DRAIN = false;
    float* IKWP; size_t qstride;
    __device__ __forceinline__ void operator()(const f32x4 (&acc)[2][2][4][2], const Unit& u, int wr, int wc, int fr, int fq) const {
        const int row0 = u.pm * BM + wr * 64 + fr; const int col0 = wc * 32 + 8 * fq;
        float* base = IKWP + (size_t)u.pn * qstride;
#pragma unroll
        for (int ai = 0; ai < 2; ++ai)
#pragma unroll
            for (int m = 0; m < 4; ++m) { float* rowp = base + (size_t)(row0 + ai * HALF + m * 16) * 128 + col0;
                *(f32x4*)(rowp) = acc[ai][0][m][0]; *(f32x4*)(rowp + 4) = acc[ai][0][m][1]; }
    }
};
template <int ACT  > struct EpiQBf16 {
    static constexpr bool PERM = true, AFTER_DRAIN = false;
    bf16_t* O; int ldc; const float* sa; const float* sb;
    __device__ __forceinline__ void operator()(const f32x4 (&acc)[2][2][4][2], const Unit& u, int wr, int wc, int fr, int fq) const {
        const int row0 = u.pm * BM + wr * 64 + fr; const int col0 = u.pn * BM + wc * 32 + 8 * fq;
        f32x4 sbv[2][2];
#pragma unroll
        for (int bj = 0; bj < 2; ++bj)
#pragma unroll
            for (int n = 0; n < 2; ++n) sbv[bj][n] = *(const f32x4*)(sb + col0 + bj * HALF + 4 * n);
#pragma unroll
        for (int ai = 0; ai < 2; ++ai)
#pragma unroll
            for (int m = 0; m < 4; ++m) { const int r = row0 + ai * HALF + m * 16; const float sr = sa[r]; bf16_t* rowp = O + (size_t)r * ldc + col0;
                if (u.pn >= 12) {
                    const int cb = u.pn * BM - 3072, wh = cb >> 11, hd = (cb & 2047) >> 7;
                    bf16_t* hbp = (bf16_t*)((char*)O + (wh == 0 ? EPI_BQ_OFF : (wh == 1 ? EPI_BK_OFF : EPI_BV_OFF)));
                    rowp = hbp + ((size_t)((r / EPI_SEQ) * 16 + hd) * EPI_SEQ + (r % EPI_SEQ)) * 128 + (col0 & 127); }
#pragma unroll
                for (int bj = 0; bj < 2; ++bj) { f32x4 v0 = acc_i2f(acc[ai][bj][m][0]) * sr * sbv[bj][0], v1 = acc_i2f(acc[ai][bj][m][1]) * sr * sbv[bj][1];
                    if (ACT == 1) {
#pragma unroll
                        for (int j = 0; j < 4; ++j) { const float a = fmaxf(v0[j], 0.f), b = fmaxf(v1[j], 0.f); v0[j] = a * a; v1[j] = b * b; } }
                    u32x4 w; w.x = cvt_pk_bf16(v0[0], v0[1]); w.y = cvt_pk_bf16(v0[2], v0[3]); w.z = cvt_pk_bf16(v1[0], v1[1]); w.w = cvt_pk_bf16(v1[2], v1[3]);
                    *(u32x4*)(rowp + (u.pn >= 12 ? bj * (EPI_SEQ * 128) : bj * HALF)) = w; } }
    }
};
constexpr float EPI_HSCALE = 8.0f;
struct EpiQF8 {
    static constexpr bool PERM = true, AFTER_DRAIN = false;
    unsigned char* O; int ldc; const float* sa; const float* sb;
    __device__ __forceinline__ void operator()(const f32x4 (&acc)[2][2][4][2], const Unit& u, int wr, int wc, int fr, int fq) const {
        const int row0 = u.pm * BM + wr * 64 + fr; const int col0 = u.pn * BM + wc * 32 + 8 * fq;
        f32x4 sbv[2][2];
#pragma unroll
        for (int bj = 0; bj < 2; ++bj)
#pragma unroll
            for (int n = 0; n < 2; ++n) sbv[bj][n] = *(const f32x4*)(sb + col0 + bj * HALF + 4 * n) * __builtin_sqrtf(EPI_HSCALE);
        const int colw = u.pn * BM + wc * 32 + 8 * (fq & ~1);
#pragma unroll
        for (int ai = 0; ai < 2; ++ai)
#pragma unroll
            for (int mp = 0; mp < 4; mp += 2) { const int ra = row0 + ai * HALF + mp * 16, rb = ra + 16; const float sra = sa[ra], srb = sa[rb];
                unsigned char* rowp = O + (size_t)((fq & 1) ? rb : ra) * ldc + colw;
#pragma unroll
                for (int bj = 0; bj < 2; ++bj) { u32x2 wab[2];
#pragma unroll
                    for (int h = 0; h < 2; ++h) { const float sr = h ? srb : sra;
                        f32x4 v0 = acc_i2f(acc[ai][bj][mp + h][0]) * sr * sbv[bj][0], v1 = acc_i2f(acc[ai][bj][mp + h][1]) * sr * sbv[bj][1];
#pragma unroll
                        for (int j = 0; j < 4; ++j) { v0[j] = __builtin_amdgcn_fmed3f(v0[j], 0.f, 20.976176963403f); v1[j] = __builtin_amdgcn_fmed3f(v1[j], 0.f, 20.976176963403f); }
                        v0 = v0 * v0; v1 = v1 * v1;
                        int w0 = 0, w1 = 0;
                        w0 = __builtin_amdgcn_cvt_pk_fp8_f32(v0[0], v0[1], w0, false); w0 = __builtin_amdgcn_cvt_pk_fp8_f32(v0[2], v0[3], w0, true);
                        w1 = __builtin_amdgcn_cvt_pk_fp8_f32(v1[0], v1[1], w1, false); w1 = __builtin_amdgcn_cvt_pk_fp8_f32(v1[2], v1[3], w1, true);
                        wab[h].x = (unsigned)w0; wab[h].y = (unsigned)w1; }
                    const auto sx = __builtin_amdgcn_permlane16_swap(wab[0].x, wab[1].x, false, false); const auto sy = __builtin_amdgcn_permlane16_swap(wab[0].y, wab[1].y, false, false);
                    const unsigned sx0 = sx[0], sx1 = sx[1], sy0 = sy[0], sy1 = sy[1];
                    u32x4 w; w.x = sx0; w.y = sy0; w.z = sx1; w.w = sy1; *(u32x4*)(rowp + bj * HALF) = w; } }
    }
};
struct EpiOut {
    static constexpr bool PERM = true, AFTER_DRAIN = false;
    const bf16_t* h0; const float* gate; bf16_t* v1; const float* sa; const float* sb;
    __device__ __forceinline__ void operator()(const f32x4 (&acc)[2][2][4][2], const Unit& u, int wr, int wc, int fr, int fq) const {
        const int row0 = u.pm * BM + wr * 64 + fr, col0 = u.pn * BM + wc * 32 + 8 * fq;
        const float* gt = gate + (size_t)((u.pm * BM) / EPI_SEQ) * EPI_GSTRIDE;
        f32x4 gv[2][2];
#pragma unroll
        for (int bj = 0; bj < 2; ++bj)
#pragma unroll
            for (int n = 0; n < 2; ++n) { const int c = col0 + bj * HALF + 4 * n; gv[bj][n] = *(const f32x4*)(gt + c) * *(const f32x4*)(sb + c); }
#pragma unroll
        for (int ai = 0; ai < 2; ++ai)
#pragma unroll
            for (int m = 0; m < 4; ++m) { const int r = row0 + ai * HALF + m * 16; const float sr = sa[r]; const size_t off = (size_t)r * 4096 + col0;
#pragma unroll
                for (int bj = 0; bj < 2; ++bj) { const u32x4 hw = *(const u32x4*)(h0 + off + bj * HALF);
                    const f32x4 ha = {__builtin_bit_cast(float, hw.x << 16), __builtin_bit_cast(float, hw.x & 0xffff0000u), __builtin_bit_cast(float, hw.y << 16), __builtin_bit_cast(float, hw.y & 0xffff0000u)};
                    const f32x4 hb = {__builtin_bit_cast(float, hw.z << 16), __builtin_bit_cast(float, hw.z & 0xffff0000u), __builtin_bit_cast(float, hw.w << 16), __builtin_bit_cast(float, hw.w & 0xffff0000u)};
                    const f32x4 v0 = ha * EPI_ALPHA + gv[bj][0] * (acc_i2f(acc[ai][bj][m][0]) * sr), vb = hb * EPI_ALPHA + gv[bj][1] * (acc_i2f(acc[ai][bj][m][1]) * sr);
                    u32x4 w; w.x = cvt_pk_bf16(v0[0], v0[1]); w.y = cvt_pk_bf16(v0[2], v0[3]); w.z = cvt_pk_bf16(vb[0], vb[1]); w.w = cvt_pk_bf16(vb[2], vb[3]);
                    *(u32x4*)(v1 + off + bj * HALF) = w; }
                if (m == 3) asm volatile("" ::: "memory"); }
    }
};
struct EpiDown {
    static constexpr bool PERM = true, AFTER_DRAIN = false;
    const float* gate; bf16_t* v2; const float* st1; const float* lng; const float* lnb; const float* sb; const bf16_t* v1;
    __device__ __forceinline__ void operator()(const f32x4 (&acc)[2][2][4][2], const Unit& u, int wr, int wc, int fr, int fq) const {
        const int row0 = u.pm * BM + wr * 64 + fr, col0 = u.pn * BM + wc * 32 + 8 * fq;
        const float* gt = gate + (size_t)((u.pm * BM) / EPI_SEQ) * EPI_GSTRIDE;
#pragma unroll
        for (int bj = 0; bj < 2; ++bj) {
            asm volatile("" ::: "memory");
            f32x4 gv[2], lg[2], lb[2];
#pragma unroll
            for (int n = 0; n < 2; ++n) { const int c = col0 + bj * HALF + 4 * n; gv[n] = *(const f32x4*)(gt + c) * *(const f32x4*)(sb + c) * (1.0f / EPI_HSCALE); lg[n] = *(const f32x4*)(lng + c); lb[n] = *(const f32x4*)(lnb + c); }
#pragma unroll
            for (int ai = 0; ai < 2; ++ai)
#pragma unroll
                for (int m = 0; m < 4; ++m) { const int r = row0 + ai * HALF + m * 16; const float mean = st1[2 * r], rstd = st1[2 * r + 1]; const size_t off = (size_t)r * 4096 + col0 + bj * HALF;
                    const u32x4 hw = *(const u32x4*)(v1 + off);
                    const f32x4 ha = {__builtin_bit_cast(float, hw.x << 16), __builtin_bit_cast(float, hw.x & 0xffff0000u), __builtin_bit_cast(float, hw.y << 16), __builtin_bit_cast(float, hw.y & 0xffff0000u)};
                    const f32x4 hb = {__builtin_bit_cast(float, hw.z << 16), __builtin_bit_cast(float, hw.z & 0xffff0000u), __builtin_bit_cast(float, hw.w << 16), __builtin_bit_cast(float, hw.w & 0xffff0000u)};
                    const f32x4 o0 = ((ha - mean) * rstd * lg[0] + lb[0]) * EPI_ALPHA + gv[0] * acc[ai][bj][m][0], o1 = ((hb - mean) * rstd * lg[1] + lb[1]) * EPI_ALPHA + gv[1] * acc[ai][bj][m][1];
                    u32x4 w; w.x = cvt_pk_bf16(o0[0], o0[1]); w.y = cvt_pk_bf16(o0[2], o0[3]); w.z = cvt_pk_bf16(o1[0], o1[1]); w.w = cvt_pk_bf16(o1[2], o1[3]);
                    *(u32x4*)(v2 + off) = w;
                    if (m & 1) asm volatile("" ::: "memory"); }
        }
    }
};

template <class Epi, class Sched, int MODE, bool KS, bool ALIGN_EPI, bool SP2>
__device__ __forceinline__ void gemm_phase(PG8_LAS unsigned char* lds, const Gemm g, const Sched& S, const Epi& E, const int tid  ) {
    const int wid = __builtin_amdgcn_readfirstlane(tid >> 6), lane = tid & 63, wr = wid >> 2, wc = wid & 3, fr = lane & 15, fq = lane >> 4;
    const int K = g.K, nt = K / BK, LD = g.ld;
    unsigned voffA[2], voffB[2];
#pragma unroll
    for (int i = 0; i < 2; ++i) { int R, C; stage_rc(tid * 16 + i * 8192, R, C); const int Rb = Epi::PERM ? ((R & ~31) + perm32(R & 31)) : R;
        voffA[i] = (unsigned)(R * LD + C) * 2u; voffB[i] = (unsigned)(Rb * LD + C) * 2u; }
    const size_t kstep = (size_t)(BK * 2);
    const size_t hstep = (size_t)HALF * LD * 2;
    const size_t tstep = 2 * hstep;
    const unsigned ldsw = (unsigned)wid * 1024u;
    const int aoff = lds_byte(wr * 64 + fr, fq * 8), boff = lds_byte(wc * 32 + fr, fq * 8);
#define PG8_SA(b, h) (((b) * 2 + (h)) * HTB)
#define PG8_SB(b, h) ((4 + (b) * 2 + (h)) * HTB)
#define PG8_STAGE(bufoff, gbase, voff) do { _Pragma("unroll") for (int _i = 0; _i < 2; ++_i) \
        __builtin_amdgcn_global_load_lds((const unsigned*)((const char*)(gbase) + (voff)[_i]), (PG8_LAS unsigned*)(lds + (bufoff) + ldsw + _i * 8192), 16, 0, 0); } while (0)
#define PG8_LDA(dst, b, h) do { _Pragma("unroll") for (int m = 0; m < 4; ++m) _Pragma("unroll") for (int k = 0; k < 2; ++k) dst[m][k] = *(const PG8_LAS bf16x8*)(lds + PG8_SA(b, h) + aoff + m * 2048 + k * 1024); } while (0)
#define PG8_LDB(dst, b, h) do { _Pragma("unroll") for (int n = 0; n < 2; ++n) _Pragma("unroll") for (int k = 0; k < 2; ++k) dst[n][k] = *(const PG8_LAS bf16x8*)(lds + PG8_SB(b, h) + boff + n * 2048 + k * 1024); } while (0)
#define PG8_MMA(ai, bj, At, Bt) do { __builtin_amdgcn_s_setprio(1); \
        if constexpr (MODE == 3) { _Pragma("unroll") for (int m = 0; m < 4; ++m) _Pragma("unroll") for (int n = 0; n < 2; ++n) acc[ai][bj][m][n] = mma_f8(Bt[n][0], Bt[n][1], At[m][0], At[m][1], acc[ai][bj][m][n]); } \
        else { _Pragma("unroll") for (int m = 0; m < 4; ++m) _Pragma("unroll") for (int n = 0; n < 2; ++n) _Pragma("unroll") for (int k = 0; k < 2; ++k) \
        acc[ai][bj][m][n] = mma16<MODE>(Bt[n][k], At[m][k], acc[ai][bj][m][n]); } __builtin_amdgcn_s_setprio(0); } while (0)
#define PG8_WAIT_V(n) asm volatile("s_waitcnt vmcnt(" #n ")" ::: "memory")
#define PG8_WAIT_L(n) asm volatile("s_waitcnt lgkmcnt(" #n ")" ::: "memory")
#define PG8_BAR __builtin_amdgcn_s_barrier()
#define PG8_SCHED __builtin_amdgcn_sched_barrier(0)
    Unit cur, nxt; int ui = 0;
    if (!S.next(0, cur)) return;
    f32x4 acc[2][2][4][2];
#pragma unroll
    for (int a = 0; a < 2; ++a)
#pragma unroll
        for (int b = 0; b < 2; ++b)
#pragma unroll
            for (int m = 0; m < 4; ++m)
#pragma unroll
                for (int n = 0; n < 2; ++n) acc[a][b][m][n] = (f32x4){0.f, 0.f, 0.f, 0.f};
    bf16x8 At[4][2], B0[2][2], B1[2][2];
#define PG8_APTR(u) ((const char*)g.A + (size_t)(u).pm * tstep + (KS ? (size_t)(u).pn * K * 2 : (size_t)0))
#define PG8_BPTR(u) ((const char*)g.Bt + (KS ? (size_t)(u).pn * K * 2 : (size_t)(u).pn * tstep))
    const char* cA = PG8_APTR(cur); const char* cB = PG8_BPTR(cur);
    S.a_ready(cur);
    if constexpr (SP2) {
        PG8_STAGE(PG8_SB(0, 0), cB, voffB); PG8_STAGE(PG8_SB(0, 1), cB + hstep, voffB); PG8_STAGE(PG8_SA(0, 0), cA, voffA); PG8_STAGE(PG8_SA(0, 1), cA + hstep, voffA);
        if (wr == 1) PG8_BAR;
        PG8_WAIT_V(2); PG8_BAR;
        PG8_STAGE(PG8_SB(1, 0), cB + kstep, voffB); PG8_STAGE(PG8_SA(1, 0), cA + kstep, voffA); PG8_STAGE(PG8_SB(1, 1), cB + hstep + kstep, voffB);
        PG8_WAIT_V(6); PG8_BAR;
    } else {
        PG8_STAGE(PG8_SB(0, 0), cB, voffB); PG8_STAGE(PG8_SA(0, 0), cA, voffA); PG8_STAGE(PG8_SB(0, 1), cB + hstep, voffB); PG8_STAGE(PG8_SA(0, 1), cA + hstep, voffA);
        if (wr == 1) PG8_BAR;
        PG8_WAIT_V(4); PG8_BAR;
        PG8_STAGE(PG8_SB(1, 0), cB + kstep, voffB); PG8_STAGE(PG8_SA(1, 0), cA + kstep, voffA); PG8_STAGE(PG8_SB(1, 1), cB + hstep + kstep, voffB);
        PG8_WAIT_V(6); PG8_BAR;
    }
    for (;;) {
        const bool has_next = S.next(ui + 1, nxt);
        const char* nA = has_next ? PG8_APTR(nxt) : cA; const char* nB = has_next ? PG8_BPTR(nxt) : cB;
        for (int t = 0; t < nt; t += 2) {
            const bool last = (t == nt - 2);
            const char* a1 = cA + (size_t)(t + 1) * kstep;
            const char* a2 = last ? nA : cA + (size_t)(t + 2) * kstep; const char* b2 = last ? nB : cB + (size_t)(t + 2) * kstep;
            const char* a3 = a2 + kstep; const char* b3 = b2 + kstep;
            if (last && has_next) S.a_ready(nxt);
            if constexpr (SP2) {
            PG8_LDB(B0, 0, 0); PG8_LDB(B1, 0, 1); PG8_SCHED; PG8_LDA(At, 0, 0); PG8_STAGE(PG8_SA(1, 1), a1 + hstep, voffA);
            PG8_WAIT_V(8); PG8_WAIT_L(0); PG8_BAR; PG8_MMA(0, 0, At, B0); PG8_MMA(0, 1, At, B1); PG8_BAR; PG8_SCHED;
            PG8_LDA(At, 0, 1); PG8_STAGE(PG8_SB(0, 0), b2, voffB); PG8_STAGE(PG8_SB(0, 1), b2 + hstep, voffB); PG8_STAGE(PG8_SA(0, 0), a2, voffA);
            PG8_WAIT_V(8); PG8_WAIT_L(0); PG8_BAR; PG8_MMA(1, 0, At, B0); PG8_MMA(1, 1, At, B1); PG8_BAR; PG8_SCHED;
            PG8_LDB(B0, 1, 0); PG8_LDB(B1, 1, 1); PG8_SCHED; PG8_LDA(At, 1, 0); PG8_STAGE(PG8_SA(0, 1), a2 + hstep, voffA);
            PG8_WAIT_V(8); PG8_WAIT_L(0); PG8_BAR; PG8_MMA(0, 0, At, B0); PG8_MMA(0, 1, At, B1); PG8_BAR; PG8_SCHED;
            PG8_LDA(At, 1, 1); PG8_STAGE(PG8_SB(1, 0), b3, voffB); PG8_STAGE(PG8_SB(1, 1), b3 + hstep, voffB); PG8_STAGE(PG8_SA(1, 0), a3, voffA);
            PG8_WAIT_V(8); PG8_WAIT_L(0); PG8_BAR; PG8_MMA(1, 0, At, B0); PG8_MMA(1, 1, At, B1); PG8_BAR; PG8_SCHED;
            } else {
            PG8_LDB(B0, 0, 0); PG8_SCHED; PG8_LDA(At, 0, 0); PG8_STAGE(PG8_SA(1, 1), a1 + hstep, voffA);
            PG8_WAIT_L(8); PG8_BAR; PG8_WAIT_L(0); PG8_MMA(0, 0, At, B0); PG8_BAR; PG8_SCHED;
            PG8_LDB(B1, 0, 1); PG8_STAGE(PG8_SB(0, 0), b2, voffB);
            PG8_BAR; PG8_WAIT_L(0); PG8_MMA(0, 1, At, B1); PG8_BAR;
            PG8_LDA(At, 0, 1); PG8_STAGE(PG8_SA(0, 0), a2, voffA);
            PG8_BAR; PG8_WAIT_L(0); PG8_MMA(1, 0, At, B0); PG8_BAR; PG8_SCHED;
            PG8_STAGE(PG8_SB(0, 1), b2 + hstep, voffB);
            PG8_WAIT_V(6); PG8_BAR; PG8_MMA(1, 1, At, B1); PG8_BAR;
            PG8_LDB(B0, 1, 0); PG8_SCHED; PG8_LDA(At, 1, 0); PG8_STAGE(PG8_SA(0, 1), a2 + hstep, voffA);
            PG8_WAIT_L(8); PG8_BAR; PG8_WAIT_L(0); PG8_MMA(0, 0, At, B0); PG8_BAR; PG8_SCHED;
            PG8_LDB(B1, 1, 1); PG8_STAGE(PG8_SB(1, 0), b3, voffB);
            PG8_BAR; PG8_WAIT_L(0); PG8_MMA(0, 1, At, B1); PG8_BAR;
            PG8_LDA(At, 1, 1); PG8_STAGE(PG8_SA(1, 0), a3, voffA);
            PG8_BAR; PG8_WAIT_L(0); PG8_MMA(1, 0, At, B0); PG8_BAR; PG8_SCHED;
            PG8_STAGE(PG8_SB(1, 1), b3 + hstep, voffB);
            PG8_WAIT_V(6); PG8_BAR; PG8_MMA(1, 1, At, B1); PG8_BAR;
            }
        }
        if constexpr (ALIGN_EPI) { if (wr == 0) PG8_BAR; }
        if constexpr (!Epi::AFTER_DRAIN) { E(acc, cur, wr, wc, fr, fq); S.done(cur); }
        if (!has_next) break;
#pragma unroll
        for (int a = 0; a < 2; ++a)
#pragma unroll
            for (int b = 0; b < 2; ++b)
#pragma unroll
                for (int m = 0; m < 4; ++m)
#pragma unroll
                    for (int n = 0; n < 2; ++n) acc[a][b][m][n] = (f32x4){0.f, 0.f, 0.f, 0.f};
        cur = nxt; cA = nA; cB = nB; ++ui;
        if constexpr (ALIGN_EPI) { if (wr == 1) PG8_BAR; }
    }
    PG8_WAIT_V(0);
    if constexpr (!ALIGN_EPI) { if (wr == 0) PG8_BAR; }
    PG8_BAR;
    if constexpr (Epi::AFTER_DRAIN) { E.fused(acc, cur, wr, wc, fr, fq, lds, wid, lane); S.done(cur); }
#undef PG8_APTR
#undef PG8_BPTR
#undef PG8_SA
#undef PG8_SB
#undef PG8_STAGE
#undef PG8_LDA
#undef PG8_LDB
#undef PG8_MMA
#undef PG8_WAIT_V
#undef PG8_WAIT_L
#undef PG8_BAR
#undef PG8_SCHED
}
}
#ifndef PG8_SP2
#define PG8_SP2 true
#endif
#ifndef PG8_ALIGN
#define PG8_ALIGN true
#endif
constexpr int NWAVES = 8;
#ifndef MK_N_LAUNCHES
#define MK_N_LAUNCHES 1
#endif
constexpr int N_PHASES = 12;
constexpr int N_LAUNCHES = MK_N_LAUNCHES;

constexpr int BATCH = 2, SEQ = 8192, DM = 4096, M = BATCH * SEQ, HD = 128, DFF = 16384, TOPK = 256;
constexpr int C_AQ = 0, C_AK = 2048, C_AV = 2560, C_BQ = 3072, C_BK = 5120, C_BV = 7168, C_IQ = 9216, C_IK = 11264, C_IW = 11328, IN_COLS = 11360;
constexpr int NP_BF = 9216;
constexpr int NP_H = 2304;
constexpr float LN_EPS = 1e-5f;
constexpr float ALPHA = 1.189207115002721f;

constexpr size_t MiB = 1u << 20;
constexpr size_t WS_CTL = 0, CTL_ZERO_BYTES = 64 * 1024;
constexpr size_t WS_MOD = 2 * MiB;
constexpr size_t WS_XST = 2 * MiB + 512 * 1024;
constexpr size_t WS_SSQ = 3 * MiB;
constexpr size_t WS_SCL = 5 * MiB;
constexpr size_t WS_WIN_Q = 6 * MiB;
constexpr size_t WS_WIN_H = 42 * MiB;
constexpr size_t WS_WOUT_Q = 60 * MiB;
constexpr size_t WS_WUP_Q = 76 * MiB;
constexpr size_t WS_WDOWN = 140 * MiB;
constexpr size_t WS_UQ = 268 * MiB;
constexpr size_t WS_Q8 = 268 * MiB;
constexpr size_t WS_QS = 300 * MiB;
constexpr size_t WS_UH = 332 * MiB;
constexpr size_t WS_O = 460 * MiB;
constexpr size_t WS_ONQ = 588 * MiB;
constexpr size_t WS_U1Q = 652 * MiB;
constexpr size_t WS_PROJ = 716 * MiB;
constexpr size_t WS_IQ = 1004 * MiB;
constexpr size_t WS_IKWP = 1068 * MiB;
constexpr size_t WS_IKN = 1100 * MiB;
constexpr size_t WS_IWS = 1102 * MiB;
constexpr size_t WS_LIST = 1104 * MiB;
constexpr size_t WS_HID = 716 * MiB;
constexpr size_t WS_H0B = 1228 * MiB;
constexpr size_t WS_V1B = 1356 * MiB;
constexpr size_t WS_KQ8 = 1492 * MiB;
constexpr size_t WS_KS = 1500 * MiB;
constexpr size_t WS_VQ8 = 1501 * MiB;
constexpr size_t WS_VS = 1509 * MiB;
constexpr size_t WS_MODP = 1484 * MiB;
constexpr size_t WS_BQ = WS_V1B, WS_BK = WS_ONQ, WS_BV = WS_U1Q;
static_assert((long long)WS_BQ - (long long)WS_PROJ == pg8::EPI_BQ_OFF && (long long)WS_BK - (long long)WS_PROJ == pg8::EPI_BK_OFF && (long long)WS_BV - (long long)WS_PROJ == pg8::EPI_BV_OFF, "head-major buffer offsets");
constexpr size_t WS_END = 1510 * MiB;
constexpr int CW_TMO = 0, CW_CODE = 1, CW_BAR = 4096;
constexpr int NQ_COLS = NP_BF + DM + DFF + DM;
constexpr int CW_QHEAD = 2048;
static_assert((CW_BAR + 3456) * 4 <= (int)CTL_ZERO_BYTES && (CW_QHEAD + 64) * 4 <= CW_BAR * 4, "control words inside the memset region");

constexpr int RING_OFF = 0, RING_BYTES = 131072;
constexpr int LDSCTL_OFF = RING_BYTES, MISC_OFF = LDSCTL_OFF + 320;
constexpr int LDS_BYTES = 155648;
constexpr int TAIL_OFF = LDSCTL_OFF + 1024;

#define GAS __attribute__((address_space(1)))
#define LAS __attribute__((address_space(3)))
typedef unsigned short u16;
typedef unsigned v4u __attribute__((ext_vector_type(4)));
typedef unsigned v2u __attribute__((ext_vector_type(2)));
typedef float f32x4 __attribute__((ext_vector_type(4)));
typedef GAS unsigned gu32;
#define RLX_AGENT __ATOMIC_RELAXED, __HIP_MEMORY_SCOPE_AGENT
#define LDS_WAIT() asm volatile("s_waitcnt lgkmcnt(0)" ::: "memory")
#define VM_WAIT() asm volatile("s_waitcnt vmcnt(0)" ::: "memory")
__device__ __forceinline__ unsigned f2bf(float f) { unsigned u = __builtin_bit_cast(unsigned, f); return (u + 0x7fffu + ((u >> 16) & 1u)) >> 16; }
__device__ __forceinline__ unsigned pk2(float lo, float hi) { return pg8::cvt_pk_bf16(lo, hi); }
__device__ __forceinline__ unsigned pkh2(float lo, float hi) { return pg8::cvt_pk_f16(lo, hi); }
__device__ __forceinline__ float bflo(unsigned w) { return __builtin_bit_cast(float, w << 16); }
__device__ __forceinline__ float bfhi(unsigned w) { return __builtin_bit_cast(float, w & 0xffff0000u); }
__device__ __forceinline__ float hlo(unsigned w) { return (float)__builtin_bit_cast(pg8::f16x2, w).x; }
__device__ __forceinline__ float hhi(unsigned w) { return (float)__builtin_bit_cast(pg8::f16x2, w).y; }

#define XB_TMO      128
#define XB_XCNT(j)  (256  + 64 * (j))
#define XB_XSUB(j)  (1280 + 64 * (j))
#define XB_XGEN(j)  (2304 + 64 * (j))
#define XB_TOP      3328
#define XB_TOPGEN   3392
#define XCD_BAR_WORDS 3456
#define XB_SPIN_CAP (1u << 18)

__device__ __forceinline__ unsigned xb_ld(unsigned* p)              { return __hip_atomic_load(p, __ATOMIC_RELAXED, __HIP_MEMORY_SCOPE_AGENT); }
__device__ __forceinline__ unsigned xb_add(unsigned* p, unsigned v) { return __hip_atomic_fetch_add(p, v, __ATOMIC_RELAXED, __HIP_MEMORY_SCOPE_AGENT); }
__device__ __forceinline__ unsigned xb_xcc_id() { return (unsigned)__builtin_amdgcn_s_getreg((3 << 11) | 20) & 0xFu; }
#define XB_SPIN(cond, bar) do { unsigned _sp = 0; while (cond) { __builtin_amdgcn_s_sleep(1); \
    if ((++_sp & 255u) == 0u) { if (xb_ld(&(bar)[XB_TMO])) break; if (_sp > XB_SPIN_CAP) { atomicAdd(&(bar)[XB_TMO], 1u); break; } } } } while (0)

struct XcdBarrier {
    unsigned* bar; unsigned x;
    volatile LAS unsigned* st;
};

__device__ __forceinline__ XcdBarrier xcd_barrier_post(unsigned* bar, volatile LAS unsigned* st, bool t0  ) {
    XcdBarrier b; b.bar = bar; b.x = xb_xcc_id(); b.st = st;
    if (t0) (void)xb_add(&bar[XB_XCNT(b.x)], 1u);
    return b;
}
__device__ __forceinline__ void xcd_barrier_complete(unsigned* bar, unsigned x, unsigned& nloc, unsigned& nx) {
    const unsigned G = gridDim.x * gridDim.y * gridDim.z;
    unsigned sum, cnt, mine, sp = 0u;
    for (;;) {
        sum = 0u; cnt = 0u; mine = 0u;
#pragma unroll
        for (unsigned j = 0; j < 16; ++j) { const unsigned c = xb_ld(&bar[XB_XCNT(j)]); sum += c; cnt += (c > 0u) ? 1u : 0u; mine = (j == x) ? c : mine; }
        if (sum == G) break;
        __builtin_amdgcn_s_sleep(1);
        if ((++sp & 255u) == 0u) { if (xb_ld(&bar[XB_TMO])) break; if (sp > XB_SPIN_CAP) { atomicAdd(&bar[XB_TMO], 1u); break; } }
    }
    nloc = mine > 0u ? mine : 1u; nx = cnt > 0u ? cnt : 1u;
}

__device__ __forceinline__ void xcd_barrier(const XcdBarrier& b, bool t0  ) {
    asm volatile("s_waitcnt vmcnt(0)" ::: "memory");
    __syncthreads();
    if (t0) {
        unsigned* bar = b.bar;
        __builtin_amdgcn_s_waitcnt(0);
        unsigned nloc = b.st[0], nx = b.st[1];
        if (nloc == 0u) { xcd_barrier_complete(bar, b.x, nloc, nx); b.st[0] = nloc; b.st[1] = nx; }
        const unsigned old = xb_add(&bar[XB_XSUB(b.x)], 1u);
        const unsigned gen = old / nloc;
        if (old + 1u == (gen + 1u) * nloc) {
            __builtin_amdgcn_fence(__ATOMIC_RELEASE, "agent");
            asm volatile("s_waitcnt vmcnt(0)" ::: "memory");
            const unsigned og = xb_add(&bar[XB_TOP], 1u);
            const unsigned tg = og / nx;
            if (og + 1u == (tg + 1u) * nx) xb_add(&bar[XB_TOPGEN], 1u);
            else XB_SPIN(xb_ld(&bar[XB_TOPGEN]) == tg, bar);
            __builtin_amdgcn_fence(__ATOMIC_ACQUIRE, "agent");
            xb_add(&bar[XB_XGEN(b.x)], 1u);
            asm volatile("s_waitcnt vmcnt(0)" ::: "memory");
        } else {
            XB_SPIN(xb_ld(&bar[XB_XGEN(b.x)]) == gen, bar);
            __builtin_amdgcn_fence(__ATOMIC_ACQUIRE, "agent");
            asm volatile("s_waitcnt vmcnt(0)" ::: "memory");
        }
    }
    __syncthreads();
}
struct Args { const float* in[19]; float* out; unsigned char* ws; int ph_lo, ph_hi, li, pad; };
#define CAS __attribute__((address_space(4)))
__device__ __forceinline__ const unsigned char CAS* karg_base() { const unsigned char CAS* p = (const unsigned char CAS*)__builtin_amdgcn_kernarg_segment_ptr(); asm volatile("" : "+s"(p)); return p; }
__device__ __forceinline__ const float* karg_in(int k) { return ((const float* const CAS*)karg_base())[k]; }
__device__ __forceinline__ float* karg_out() { return ((float* const CAS*)karg_base())[19]; }
struct Frame {
    LAS unsigned char* lds;
    volatile LAS unsigned* MISC;
    gu32* ctl;
    int tid, lane, wave;
    int vcu, G;
    __device__ __forceinline__ const float* x() const { return karg_in(0); }
    __device__ __forceinline__ const float* c() const { return karg_in(1); }
    __device__ __forceinline__ const float* in_g() const { return karg_in(2); }
    __device__ __forceinline__ const float* in_b() const { return karg_in(3); }
    __device__ __forceinline__ const float* relb() const { return karg_in(4); }
    __device__ __forceinline__ const float* w_ada() const { return karg_in(5); }
    __device__ __forceinline__ const float* b_ada() const { return karg_in(6); }
    __device__ __forceinline__ const float* w_in() const { return karg_in(7); }
    __device__ __forceinline__ const float* kn_g() const { return karg_in(8); }
    __device__ __forceinline__ const float* kn_b() const { return karg_in(9); }
    __device__ __forceinline__ const float* gn_a() const { return karg_in(10); }
    __device__ __forceinline__ const float* gn_b() const { return karg_in(11); }
    __device__ __forceinline__ const float* w_out() const { return karg_in(12); }
    __device__ __forceinline__ const float* ln1_g() const { return karg_in(13); }
    __device__ __forceinline__ const float* ln1_b() const { return karg_in(14); }
    __device__ __forceinline__ const float* w_up() const { return karg_in(15); }
    __device__ __forceinline__ const float* w_down() const { return karg_in(16); }
    __device__ __forceinline__ const float* ln2_g() const { return karg_in(17); }
    __device__ __forceinline__ const float* ln2_b() const { return karg_in(18); }
    __device__ __forceinline__ float* out() const { return karg_out(); }
    unsigned char* ws;
    __device__ __forceinline__ float* MOD() const { return (float*)(ws + WS_MOD); }
    __device__ __forceinline__ float* XST() const { return (float*)(ws + WS_XST); }
    __device__ __forceinline__ float* SSQ() const { return (float*)(ws + WS_SSQ); }
    __device__ __forceinline__ float* IKWP() const { return (float*)(ws + WS_IKWP); }
    __device__ __forceinline__ float* IWS() const { return (float*)(ws + WS_IWS); }
    __device__ __forceinline__ float* SA_U() const { return (float*)(ws + WS_SCL); }
    __device__ __forceinline__ float* SA_ON() const { return (float*)(ws + WS_SCL + (size_t)M * 4); }
    __device__ __forceinline__ float* SA_U1() const { return (float*)(ws + WS_SCL + (size_t)M * 8); }
    __device__ __forceinline__ float* ST1() const { return (float*)(ws + WS_SCL + (size_t)M * 12); }
    __device__ __forceinline__ float* SW() const { return (float*)(ws + WS_SCL + (size_t)M * 20); }
    __device__ __forceinline__ u16* WIN_H() const { return (u16*)(ws + WS_WIN_H); }
    __device__ __forceinline__ unsigned char* WDOWN8() const { return (unsigned char*)(ws + WS_WDOWN); }
    __device__ __forceinline__ u16* UH() const { return (u16*)(ws + WS_UH); }
    __device__ __forceinline__ u16* O() const { return (u16*)(ws + WS_O); }
    __device__ __forceinline__ u16* PROJ() const { return (u16*)(ws + WS_PROJ); }
    __device__ __forceinline__ u16* IQ() const { return (u16*)(ws + WS_IQ); }
    __device__ __forceinline__ u16* IKN() const { return (u16*)(ws + WS_IKN); }
    __device__ __forceinline__ unsigned char* HID8() const { return (unsigned char*)(ws + WS_HID); }
    __device__ __forceinline__ unsigned char* WIN_Q() const { return (unsigned char*)(ws + WS_WIN_Q); }
    __device__ __forceinline__ unsigned char* WOUT_Q() const { return (unsigned char*)(ws + WS_WOUT_Q); }
    __device__ __forceinline__ unsigned char* WUP_Q() const { return (unsigned char*)(ws + WS_WUP_Q); }
    __device__ __forceinline__ unsigned char* UQ() const { return (unsigned char*)(ws + WS_UQ); }
    __device__ __forceinline__ unsigned char* Q8() const { return (unsigned char*)(ws + WS_Q8); }
    __device__ __forceinline__ float* QS() const { return (float*)(ws + WS_QS); }
    __device__ __forceinline__ u16* BQ() const { return (u16*)(ws + WS_BQ); }
    __device__ __forceinline__ u16* BK() const { return (u16*)(ws + WS_BK); }
    __device__ __forceinline__ u16* BV() const { return (u16*)(ws + WS_BV); }
    __device__ __forceinline__ unsigned char* ONQ() const { return (unsigned char*)(ws + WS_ONQ); }
    __device__ __forceinline__ unsigned char* U1Q() const { return (unsigned char*)(ws + WS_U1Q); }
    __device__ __forceinline__ unsigned char* KQ8() const { return (unsigned char*)(ws + WS_KQ8); }
    __device__ __forceinline__ u16* KS() const { return (u16*)(ws + WS_KS); }
    __device__ __forceinline__ unsigned char* VQ8() const { return (unsigned char*)(ws + WS_VQ8); }
    __device__ __forceinline__ u16* VS() const { return (u16*)(ws + WS_VS); }
    __device__ __forceinline__ float* MODP() const { return (float*)(ws + WS_MODP); }
    __device__ __forceinline__ u16* H0B() const { return (u16*)(ws + WS_H0B); }
    __device__ __forceinline__ u16* V1B() const { return (u16*)(ws + WS_V1B); }
    __device__ __forceinline__ unsigned* LIST() const { return (unsigned*)(ws + WS_LIST); }
};

__device__ __forceinline__ int lane_now() { unsigned ones = ~0u; asm volatile("" : "+v"(ones)); return (int)__builtin_amdgcn_mbcnt_hi(ones, __builtin_amdgcn_mbcnt_lo(ones, 0u)); }
__device__ __forceinline__ void rethread(Frame& F) { F.lane = lane_now(); F.tid = F.wave * 64 + F.lane; }
template <int K> __device__ __forceinline__ float xshf(float v) {
    if constexpr (K == 32) { auto r = __builtin_amdgcn_permlane32_swap(__float_as_uint(v), __float_as_uint(v), false, false); const unsigned a = r[0], b = r[1];
        return __uint_as_float(a ^ b ^ __float_as_uint(v)); }
    else return __int_as_float(__builtin_amdgcn_ds_swizzle(__float_as_int(v), (K << 10) | 0x1f));
}
__device__ __forceinline__ float wave_sum(float v) {
    v += xshf<1>(v); v += xshf<2>(v); v += xshf<4>(v); v += xshf<8>(v); v += xshf<16>(v); v += xshf<32>(v);
    return v;
}
__device__ __forceinline__ float wave_max(float v) {
    v = fmaxf(v, xshf<1>(v)); v = fmaxf(v, xshf<2>(v)); v = fmaxf(v, xshf<4>(v)); v = fmaxf(v, xshf<8>(v)); v = fmaxf(v, xshf<16>(v)); v = fmaxf(v, xshf<32>(v));
    return v;
}
__device__ __forceinline__ unsigned q4(const f32x4 v, float inv) {
    const int a = __float2int_rn(v.x * inv), b = __float2int_rn(v.y * inv), c = __float2int_rn(v.z * inv), d = __float2int_rn(v.w * inv);
    return (unsigned)(a & 255) | ((unsigned)(b & 255) << 8) | ((unsigned)(c & 255) << 16) | ((unsigned)d << 24);
}
__device__ __forceinline__ float amax4(const f32x4 v) { return fmaxf(fmaxf(fabsf(v.x), fabsf(v.y)), fmaxf(fabsf(v.z), fabsf(v.w))); }
__device__ __forceinline__ unsigned wave_max_u(unsigned v) {
    unsigned t;
    t = __float_as_uint(xshf<1>(__uint_as_float(v))); v = t > v ? t : v; t = __float_as_uint(xshf<2>(__uint_as_float(v))); v = t > v ? t : v; t = __float_as_uint(xshf<4>(__uint_as_float(v))); v = t > v ? t : v;
    t = __float_as_uint(xshf<8>(__uint_as_float(v))); v = t > v ? t : v; t = __float_as_uint(xshf<16>(__uint_as_float(v))); v = t > v ? t : v; t = __float_as_uint(xshf<32>(__uint_as_float(v))); v = t > v ? t : v;
    return v;
}
__device__ __forceinline__ int wave_sum_i(int v) {
    v += __float_as_int(xshf<1>(__int_as_float(v))); v += __float_as_int(xshf<2>(__int_as_float(v))); v += __float_as_int(xshf<4>(__int_as_float(v))); v += __float_as_int(xshf<8>(__int_as_float(v))); v += __float_as_int(xshf<16>(__int_as_float(v))); v += __float_as_int(xshf<32>(__int_as_float(v)));
    return v;
}
__device__ __forceinline__ unsigned t5_bucket(int n) {
    if (n < 16) return (unsigned)n;
    const float nf = (float)n;
    int large = 16 + (int)(logf(nf / 16.0f) / 2.0794415416798357f * 16.0f);
    return (unsigned)(large < 31 ? large : 31);
}

__device__ __forceinline__ f32x4 ldp(const float* base, unsigned lane_bytes, int const_floats) { return *(const f32x4*)((const char*)(base + const_floats) + lane_bytes); }
__device__ __forceinline__ f32x4 ldl(LAS float* base, unsigned lane_bytes, int const_floats) { return *(const LAS f32x4*)((const LAS char*)(base + const_floats) + lane_bytes); }
__device__ __forceinline__ void lds_fill(LAS float* dst, const float* src, int nfloats, int tid) {
    for (int i = 4 * tid; i < nfloats; i += 4 * NWAVES * 64) *(LAS f32x4*)(dst + i) = *(const GAS f32x4*)(src + i);
}
__device__ __forceinline__ void p0_transpose_item(const float* W, int K, int ldw, int k0, int n0, u16* WT, int drow, bool f16, LAS float* scr, int lane) {
#pragma unroll 8
    for (int i = 0; i < 32; ++i) { const int kk = 2 * i + (lane >> 5); scr[kk * 33 + (lane & 31)] = W[(size_t)(k0 + kk) * ldw + n0 + (lane & 31)]; }
    LDS_WAIT(); asm volatile("" ::: "memory");
    const int c = lane & 7;
#pragma unroll
    for (int j = 0; j < 4; ++j) { const int n = (lane >> 3) + 8 * j; const LAS float* s = scr + (8 * c) * 33 + n;
        v4u o;
        if (f16) { o.x = pkh2(s[0 * 33], s[1 * 33]); o.y = pkh2(s[2 * 33], s[3 * 33]); o.z = pkh2(s[4 * 33], s[5 * 33]); o.w = pkh2(s[6 * 33], s[7 * 33]); }
        else     { o.x = pk2(s[0 * 33], s[1 * 33]);  o.y = pk2(s[2 * 33], s[3 * 33]);  o.z = pk2(s[4 * 33], s[5 * 33]);  o.w = pk2(s[6 * 33], s[7 * 33]); }
        *(GAS v4u*)(WT + (size_t)(drow + n) * K + k0 + 8 * c) = o; }
    LDS_WAIT(); asm volatile("" ::: "memory");
}
__device__ __forceinline__ void p0_absmax_item(const float* W, int ldw, int k0, int n0, unsigned* colmax, int lane) {
    float mx = 0.f;
    const float* wp = W + (size_t)(k0 + (lane >> 5)) * ldw + n0 + (lane & 31);
#pragma unroll 1
    for (int i = 0; i < 128; i += 8) {
        float t[8];
#pragma unroll
        for (int j = 0; j < 8; ++j) t[j] = wp[(size_t)(2 * j) * ldw];
#pragma unroll
        for (int j = 0; j < 8; ++j) mx = fmaxf(mx, fabsf(t[j]));
        wp += (size_t)16 * ldw; }
    mx = fmaxf(mx, xshf<32>(mx));
    if (lane < 32) atomicMax(colmax + lane, __float_as_uint(mx));
}
__device__ __forceinline__ unsigned f8x4(const f32x4 v, float inv) {
    int w = 0; w = __builtin_amdgcn_cvt_pk_fp8_f32(v.x * inv, v.y * inv, w, false); w = __builtin_amdgcn_cvt_pk_fp8_f32(v.z * inv, v.w * inv, w, true); return (unsigned)w;
}
template <bool FP8> __device__ __forceinline__ void p1_quant_item(const float* W, int K, int ldw, int k0, int n0, unsigned char* WT, const float am  , float* sw, LAS float* scr, int lane) {
    constexpr float QMAX = FP8 ? 224.0f : 127.0f;
#pragma unroll 16
    for (int i = 0; i < 32; ++i) { const int kk = 2 * i + (lane >> 5); scr[kk * 33 + (lane & 31)] = W[(size_t)(k0 + kk) * ldw + n0 + (lane & 31)]; }
    LDS_WAIT(); asm volatile("" ::: "memory");
    const int n = lane >> 1, hf = lane & 1;
    const float inv = am > 0.f ? QMAX / am : 0.f;
    if (k0 == 0 && hf == 0) sw[n] = am * (1.0f / QMAX);
    const LAS float* sp = scr + (32 * hf) * 33 + n;
    v4u o0, o1;
#pragma unroll
    for (int j = 0; j < 4; ++j) { const f32x4 a = {sp[(4 * j) * 33], sp[(4 * j + 1) * 33], sp[(4 * j + 2) * 33], sp[(4 * j + 3) * 33]}; o0[j] = FP8 ? f8x4(a, inv) : q4(a, inv);
        const f32x4 b = {sp[(16 + 4 * j) * 33], sp[(16 + 4 * j + 1) * 33], sp[(16 + 4 * j + 2) * 33], sp[(16 + 4 * j + 3) * 33]}; o1[j] = FP8 ? f8x4(b, inv) : q4(b, inv); }
    GAS v4u* dst = (GAS v4u*)(WT + (size_t)(n0 + n) * K + k0 + 32 * hf);
    dst[0] = o0; dst[1] = o1;
    LDS_WAIT(); asm volatile("" ::: "memory");
}
__device__ __forceinline__ void p0_prologue(Frame& F0) {
    Frame F = F0; rethread(F);
    const float* const c_p = F.c();
    const float* const w_ada_p = F.w_ada();
    const float* const b_ada_p = F.b_ada();
    const float* const w_in_p = F.w_in();
    const float* const w_out_p = F.w_out();
    const float* const w_up_p = F.w_up();
    const float* const w_down_p = F.w_down();
#ifndef PROBE_SUB
#define PROBE_SUB 0
#endif
    for (int ps_ = 0; ps_ < (PROBE_SUB == 1 ? 2 : 1); ++ps_)
    {
        LAS float* cs = (LAS float*)(F.lds + RING_OFF);
        for (int i = F.tid; i < 2 * DM; i += NWAVES * 64) { const float v = c_p[i]; cs[i] = v / (1.0f + __expf(-v)); }
        __syncthreads();
        for (int it = blockIdx.x; it < 256; it += F.G) {
            const int kg = it >> 3, cp = it & 7;
            if (F.tid < 384) {
                const float* wp = w_ada_p + (size_t)(128 * kg) * (6 * DM) + 3072 * cp + 4 * F.tid;
                f32x4 a0 = {0.f, 0.f, 0.f, 0.f}, a1 = a0, b0 = a0, b1 = a0;
#pragma unroll 8
                for (int k = 0; k < 128; ++k) { const f32x4 wa = *(const GAS f32x4*)(wp + (size_t)k * (6 * DM)), wb = *(const GAS f32x4*)(wp + (size_t)k * (6 * DM) + 1536);
                    const float s0 = cs[128 * kg + k], s1 = cs[DM + 128 * kg + k]; a0 += wa * s0; a1 += wa * s1; b0 += wb * s0; b1 += wb * s1; }
                float* pp = F.MODP() + (size_t)kg * (2 * 6 * DM) + 3072 * cp + 4 * F.tid;
                *(f32x4*)(pp) = a0; *(f32x4*)(pp + 1536) = b0; *(f32x4*)(pp + 6 * DM) = a1; *(f32x4*)(pp + 6 * DM + 1536) = b1;
            }
        }
        __syncthreads();
    }
    for (int ps2_ = 0; ps2_ < (PROBE_SUB == 2 ? 2 : 1); ++ps2_)
    {
        LAS float* scr = (LAS float*)(F.lds + RING_OFF + F.wave * 16384);
        const int gw = F.vcu * NWAVES + F.wave, NGW = F.G * NWAVES;
        constexpr int NB_H = (IN_COLS - NP_BF) / 32;
        constexpr int I_H = (DM / 64) * NB_H;
        for (int it = gw; it < I_H; it += NGW) { const int kb = it / NB_H, nb = it % NB_H; p0_transpose_item(w_in_p, DM, IN_COLS, 64 * kb, NP_BF + 32 * nb, F.WIN_H(), 32 * nb, true, scr, F.lane); }
        { constexpr int R0 = IN_COLS - NP_BF; GAS v4u* z = (GAS v4u*)(F.WIN_H() + (size_t)R0 * DM); const size_t n16 = (size_t)(NP_H - R0) * DM * 2 / 16;
          for (size_t i = (size_t)gw * 64 + F.lane; i < n16; i += (size_t)NGW * 64) z[i] = (v4u){0u, 0u, 0u, 0u}; }
    }
    {
        LAS float* scr = (LAS float*)(F.lds + RING_OFF + F.wave * 16384);
        LAS float* cmx = (LAS float*)(F.lds + RING_OFF + 12288);
        volatile LAS int* qslot = (volatile LAS int*)(cmx + 256);
        constexpr int S_DN = DM / 32, S_UP = DFF / 32, S_IN = NP_BF / 32, S_OUT = DM / 32, NSTRIPS = S_DN + S_UP + S_IN + S_OUT;
        unsigned* qhead = (unsigned*)F.ctl + CW_QHEAD;
        for (;;) {
            __syncthreads();
            if (F.tid == 0) *qslot = (int)atomicAdd(qhead, 1u);
            __syncthreads();
            int r = *qslot; if (r >= NSTRIPS) break;
            const float* W; int K, ldw, n0; unsigned char* WT; float* sw; bool fp8 = false;
            if (r < S_DN) { W = w_down_p; K = DFF; ldw = DM; n0 = 32 * r; WT = F.WDOWN8(); sw = F.SW() + NP_BF + DM + DFF; fp8 = true; }
            else if ((r -= S_DN) < S_UP) { W = w_up_p; K = DM; ldw = DFF; n0 = 32 * r; WT = F.WUP_Q(); sw = F.SW() + NP_BF + DM; }
            else if ((r -= S_UP) < S_IN) { W = w_in_p; K = DM; ldw = IN_COLS; n0 = 32 * r; WT = F.WIN_Q(); sw = F.SW(); }
            else { r -= S_IN; W = w_out_p; K = DM; ldw = DM; n0 = 32 * r; WT = F.WOUT_Q(); sw = F.SW() + NP_BF; }
            const int ntile = K / 64;
            float mx = 0.f;
            for (int kb = F.wave; kb < ntile; kb += NWAVES) {
                const float* wp = W + (size_t)(64 * kb + (F.lane >> 5)) * ldw + n0 + (F.lane & 31);
#pragma unroll 1
                for (int i = 0; i < 32; i += 16) { float t[16];
#pragma unroll
                    for (int q = 0; q < 16; ++q) t[q] = wp[(size_t)(2 * q) * ldw];
#pragma unroll
                    for (int q = 0; q < 16; ++q) mx = fmaxf(mx, fabsf(t[q]));
                    wp += (size_t)32 * ldw; } }
            mx = fmaxf(mx, xshf<32>(mx));
            if (F.lane < 32) cmx[F.wave * 32 + F.lane] = mx;
            __syncthreads();
            float am = 0.f;
#pragma unroll
            for (int w = 0; w < NWAVES; ++w) am = fmaxf(am, cmx[w * 32 + (F.lane >> 1)]);
            for (int kb = ntile - NWAVES + F.wave; kb >= 0; kb -= NWAVES) {
                if (fp8) p1_quant_item<true>(W, K, ldw, 64 * kb, n0, WT, am, sw + n0, scr, F.lane);
                else p1_quant_item<false>(W, K, ldw, 64 * kb, n0, WT, am, sw + n0, scr, F.lane);
            }
        }
    }
}
__device__ __forceinline__ void p1a_modsum(Frame& F0) {
    Frame F = F0; rethread(F);
    const float* const b_ada_p = F.b_ada();
    const int gt = (F.vcu * NWAVES + F.wave) * 64 + F.lane, NGT = F.G * NWAVES * 64;
    for (int j = gt; j < 2 * (2 * 6 * DM); j += NGT) { const int i = j >> 1, hf = j & 1;
        float s = 0.f;
#pragma unroll 8
        for (int g = 0; g < 16; ++g) s += F.MODP()[(size_t)(16 * hf + g) * (2 * 6 * DM) + i];
        s += xshf<1>(s);
        if (hf == 0) F.MOD()[i] = s + b_ada_p[i % (6 * DM)]; }
}
template <bool FILL_LN> __device__ __forceinline__ void p1_rows(Frame& F0) {
    Frame F = F0; rethread(F);
    const float* const x_p = F.x();
    const float* const in_g_p = F.in_g();
    const float* const in_b_p = F.in_b();
    const int gw = F.vcu * NWAVES + F.wave, NGW = F.G * NWAVES;
    LAS float* pl = (LAS float*)(F.lds + RING_OFF);
    if (FILL_LN) { lds_fill(pl, in_g_p, DM, F.tid); lds_fill(pl + DM, in_b_p, DM, F.tid); }
    lds_fill(pl + 2 * DM, F.MOD(), 2 * DM, F.tid); lds_fill(pl + 4 * DM, F.MOD() + 6 * DM, 2 * DM, F.tid);
    __syncthreads();
    for (int m = gw; m < M; m += NGW) {
        const GAS f32x4* xr = (const GAS f32x4*)(x_p + (size_t)m * DM) + F.lane;
        f32x4 v[16]; float s = 0.f;
#pragma unroll
        for (int j = 0; j < 16; ++j) { v[j] = xr[64 * j]; s += (v[j].x + v[j].y) + (v[j].z + v[j].w); }
        const float mean = wave_sum(s) * (1.f / DM); float s2 = 0.f;
#pragma unroll
        for (int j = 0; j < 16; ++j) { v[j] = v[j] - mean; s2 += (v[j].x * v[j].x + v[j].y * v[j].y) + (v[j].z * v[j].z + v[j].w * v[j].w); }
        const float rstd = 1.f / sqrtf(wave_sum(s2) * (1.f / DM) + LN_EPS);
        if (F.lane == 0) { F.XST()[2 * m] = mean; F.XST()[2 * m + 1] = rstd; }
        LAS float* mod = pl + 2 * DM + (m / SEQ) * (2 * DM);
        GAS v2u* oh = (GAS v2u*)(F.UH() + (size_t)m * DM) + F.lane; GAS v2u* o0 = (GAS v2u*)(F.H0B() + (size_t)m * DM) + F.lane;
        float am = 0.f;
#pragma unroll
        for (int j = 0; j < 16; ++j) { if ((j & 3) == 0) asm volatile("" ::: "memory");
            const unsigned lb = 16u * (unsigned)F.lane; const int cj = 256 * j;
            const f32x4 g = ldl(pl, lb, cj), bb = ldl(pl, lb, DM + cj), sh = ldl(mod, lb, cj), sc = ldl(mod, lb, DM + cj);
            const f32x4 h0 = v[j] * rstd * g + bb; const f32x4 u = h0 * (sc + 1.0f) + sh; v[j] = u; am = fmaxf(am, amax4(u));
            v2u wh; wh.x = pkh2(u.x, u.y); wh.y = pkh2(u.z, u.w); oh[64 * j] = wh;
            v2u w0; w0.x = pk2(h0.x, h0.y); w0.y = pk2(h0.z, h0.w); o0[64 * j] = w0; }
        am = wave_max(am); const float inv = am > 0.f ? 127.0f / am : 0.f;
        if (F.lane == 0) F.SA_U()[m] = am * (1.0f / 127.0f);
        GAS unsigned* oq = (GAS unsigned*)(F.UQ() + (size_t)m * DM) + F.lane;
#pragma unroll
        for (int j = 0; j < 16; ++j) oq[64 * j] = q4(v[j], inv);
    }
}
__device__ __forceinline__ void p3_kq8(Frame& F0) {
    Frame F = F0; rethread(F);
    const int gw = F.vcu * NWAVES + F.wave, NGW = F.G * NWAVES;
#define KQ8_LOAD(wv, mm) do { const u16* pr_ = F.PROJ() + (size_t)(mm) * NP_BF + 8 * F.lane; wv[0] = *(const GAS v4u*)(pr_ + C_AK); wv[1] = *(const GAS v4u*)(pr_ + C_AV); \
        _Pragma("unroll") for (int j_ = 0; j_ < 4; ++j_) wv[2 + j_] = *(const GAS v4u*)(pr_ + C_AQ + 512 * j_); } while (0)
    v4u nw[6];
    if (gw < M) KQ8_LOAD(nw, gw);
    for (int m = gw; m < M; m += NGW) {
        v4u cw[6];
#pragma unroll
        for (int i = 0; i < 6; ++i) cw[i] = nw[i];
        if (m + NGW < M) KQ8_LOAD(nw, m + NGW);
#pragma unroll
        for (int i = 0; i < 6; ++i) {
            const v4u w = cw[i];
            const f32x4 a = {bflo(w.x), bfhi(w.x), bflo(w.y), bfhi(w.y)}, c = {bflo(w.z), bfhi(w.z), bflo(w.w), bfhi(w.w)};
            float am = fmaxf(amax4(a), amax4(c));
            am = fmaxf(am, xshf<1>(am)); am = fmaxf(am, xshf<2>(am)); am = fmaxf(am, xshf<4>(am)); am = fmaxf(am, xshf<8>(am));
            const float inv = am > 0.f ? 127.0f / am : 0.f;
            v2u o; o.x = q4(a, inv); o.y = q4(c, inv);
            if (i < 2) { *(GAS v2u*)((i == 0 ? F.KQ8() : F.VQ8()) + (size_t)m * 512 + 8 * F.lane) = o;
                if ((F.lane & 15) == 0) (i == 0 ? F.KS() : F.VS())[(size_t)((m / SEQ) * 4 + (F.lane >> 4)) * SEQ + (m % SEQ)] = (u16)pkh2(am * (1.0f / 127.0f), 0.f); }
            else { *(GAS v2u*)(F.Q8() + (size_t)m * 2048 + 512 * (i - 2) + 8 * F.lane) = o;
                if ((F.lane & 15) == 0) F.QS()[(size_t)m * 16 + 4 * (i - 2) + (F.lane >> 4)] = am * (1.0f / 127.0f); }
        }
    }
#undef KQ8_LOAD
}
__device__ __forceinline__ void p3_ikn(Frame& F0) {
    Frame F = F0; rethread(F);
    const float* const kn_g_p = F.kn_g();
    const float* const kn_b_p = F.kn_b();
    const int gw = F.vcu * NWAVES + F.wave, NGW = F.G * NWAVES, sub = F.lane & 15;
    const size_t qs = (size_t)M * 128 / 4;
    for (int m4 = gw; m4 < M / 4; m4 += NGW) {
        const int m = 4 * m4 + (F.lane >> 4);
        const GAS f32x4* r0 = (const GAS f32x4*)(F.IKWP() + (size_t)m * 128);
        f32x4 v = r0[sub], wv = r0[16 + (sub & 7)];
#pragma unroll
        for (int q = 1; q < 4; ++q) { v += r0[(size_t)q * qs + sub]; wv += r0[(size_t)q * qs + 16 + (sub & 7)]; }
        float s = (v.x + v.y) + (v.z + v.w);
        s += xshf<1>(s); s += xshf<2>(s); s += xshf<4>(s); s += xshf<8>(s);
        const float mean = s * (1.f / 64.f); v = v - mean;
        float s2 = (v.x * v.x + v.y * v.y) + (v.z * v.z + v.w * v.w);
        s2 += xshf<1>(s2); s2 += xshf<2>(s2); s2 += xshf<4>(s2); s2 += xshf<8>(s2);
        const float rstd = 1.f / sqrtf(s2 * (1.f / 64.f) + LN_EPS);
        const f32x4 g = *(const f32x4*)(kn_g_p + 4 * sub), bb = *(const f32x4*)(kn_b_p + 4 * sub); const f32x4 y = v * rstd * g + bb;
        v2u w; w.x = pkh2(y.x, y.y); w.y = pkh2(y.z, y.w); *(GAS v2u*)(F.IKN() + (size_t)m * 64 + 4 * sub) = w;
        if (sub < 8) *(GAS f32x4*)(F.IWS() + (size_t)m * 32 + 4 * sub) = wv;
    }
}
constexpr float SB_EXIT = -40.0f * 1.4426950408889634f;
typedef short bf8v __attribute__((ext_vector_type(8)));
typedef float f32x16 __attribute__((ext_vector_type(16)));
template <int O1, int O2> __device__ __forceinline__ void tr_read2(v2u& a, v2u& b, unsigned addr) {
    asm volatile("ds_read_b64_tr_b16 %0, %2 offset:%3\n\tds_read_b64_tr_b16 %1, %2 offset:%4" : "=&v"(a), "=&v"(b) : "v"(addr), "i"(O1), "i"(O2) : "memory");
}
constexpr int SB_VST = 320;
constexpr int SB_WAVE_LDS = 32 * SB_VST;
__device__ __forceinline__ void sb_fast(Frame& F0) {
    Frame F = F0; rethread(F);
    LAS unsigned char* vimg = F.lds + RING_OFF + F.wave * SB_WAVE_LDS;
    const int lane = F.lane, c = lane & 31, hi = lane >> 5;
    const unsigned tr_base = (unsigned)(size_t)vimg + (unsigned)((4 * hi + ((lane & 15) >> 2)) * SB_VST + (16 * ((lane >> 4) & 1) + 4 * (lane & 3)) * 2);
    const int gw = F.vcu * NWAVES + F.wave, NGW = F.G * NWAVES;
    for (int task = gw; task < BATCH * 16 * (SEQ / 32); task += NGW) {
        const int qt = task % (SEQ / 32), bh = task / (SEQ / 32), h = bh & 15, b = bh >> 4;
        const int q0 = 32 * qt;
        const size_t hoff = (size_t)(b * 16 + h) * SEQ * HD;
        const u16* const qb = F.BQ() + hoff; const u16* const kb = F.BK() + hoff; const u16* const vb = F.BV() + hoff;
        bf8v qf[8];
        { const u16* qp = qb + (size_t)(q0 + c) * HD + 8 * hi;
#pragma unroll
          for (int st = 0; st < 8; ++st) qf[st] = __builtin_bit_cast(bf8v, *(const v4u*)(qp + 16 * st)); }
        f32x16 oacc[4];
#pragma unroll
        for (int dt = 0; dt < 4; ++dt)
#pragma unroll
            for (int r = 0; r < 16; ++r) oacc[dt][r] = 0.f;
        float carry = 0.f;
        v4u kf[8];
        { const u16* kp = kb + (size_t)(q0 + c) * HD + 8 * hi;
#pragma unroll
          for (int st = 0; st < 8; ++st) kf[st] = *(const v4u*)(kp + 16 * st); }
        for (int k0 = q0; k0 >= 0; k0 -= 32) {
            f32x16 acc;
#pragma unroll
            for (int r = 0; r < 16; ++r) acc[r] = 0.f;
#pragma unroll
            for (int st = 0; st < 8; ++st) acc = __builtin_amdgcn_mfma_f32_32x32x16_bf16(__builtin_bit_cast(bf8v, kf[st]), qf[st], acc, 0, 0, 0);
            __builtin_amdgcn_sched_barrier(0);
            if (k0 >= 32) { const u16* kp = kb + (size_t)(k0 - 32 + c) * HD + 8 * hi;
#pragma unroll
                for (int st = 0; st < 8; ++st) kf[st] = *(const v4u*)(kp + 16 * st); }
            __builtin_amdgcn_sched_barrier(0);
            { v4u vr[8];
              const u16* vp = vb + (size_t)(k0 + (lane >> 4)) * HD + 8 * (lane & 15);
#pragma unroll
              for (int i = 0; i < 8; ++i) vr[i] = *(const v4u*)(vp + (size_t)(4 * i) * HD);
#pragma unroll
              for (int i = 0; i < 8; ++i) *(LAS v4u*)(vimg + (4 * i + (lane >> 4)) * SB_VST + (lane & 15) * 16) = vr[i]; }
            float lk[16], lb[16]; float tot = 0.f;
#pragma unroll
            for (int r = 0; r < 16; ++r) { const int kap = 8 * (r >> 2) + 4 * hi + (r & 3);
                const float z = acc[r] * (0.08838834764831845f * 1.4426950408889634f);
                const float sp = fmaxf(z, 0.f) + __builtin_amdgcn_logf(1.0f + __builtin_amdgcn_exp2f(-fabsf(z)));
                const bool valid = (k0 + kap) < (q0 + c);
                lk[r] = valid ? -sp : 0.f; lb[r] = valid ? (z - sp) : -INFINITY; tot += lk[r]; }
            tot += xshf<32>(tot);
            bf8v tm[2];
            { int cc = c; asm volatile("" : "+v"(cc));
#pragma unroll
              for (int j = 0; j < 2; ++j) { v4u w;
#pragma unroll
                for (int i2 = 0; i2 < 4; ++i2) { const int ia = 2 * i2, ib = 2 * i2 + 1; const int ka = 16 * j + 8 * (ia >> 2) + 4 * hi + (ia & 3), kb = 16 * j + 8 * (ib >> 2) + 4 * hi + (ib & 3);
                    w[i2] = (ka > cc ? 0x3f80u : 0u) | (kb > cc ? 0x3f800000u : 0u); }
                tm[j] = __builtin_bit_cast(bf8v, w); } }
            f32x16 lat;
#pragma unroll
            for (int r = 0; r < 16; ++r) lat[r] = 0.f;
#pragma unroll
            for (int j = 0; j < 2; ++j) { v4u whi, wlo;
#pragma unroll
                for (int i2 = 0; i2 < 4; ++i2) { const float x0 = lk[8 * j + 2 * i2], x1 = lk[8 * j + 2 * i2 + 1];
                    const unsigned ph = pg8::cvt_pk_bf16(x0, x1); whi[i2] = ph;
                    wlo[i2] = pg8::cvt_pk_bf16(x0 - bflo(ph), x1 - bfhi(ph)); }
                lat = __builtin_amdgcn_mfma_f32_32x32x16_bf16(tm[j], __builtin_bit_cast(bf8v, whi), lat, 0, 0, 0);
                lat = __builtin_amdgcn_mfma_f32_32x32x16_bf16(tm[j], __builtin_bit_cast(bf8v, wlo), lat, 0, 0, 0); }
            v4u pw[2];
#pragma unroll
            for (int j = 0; j < 2; ++j)
#pragma unroll
                for (int i2 = 0; i2 < 4; ++i2) { const int ra = 8 * j + 2 * i2;
                    const float pa = __builtin_amdgcn_exp2f(lb[ra] + lat[ra] + carry), pb = __builtin_amdgcn_exp2f(lb[ra + 1] + lat[ra + 1] + carry);
                    pw[j][i2] = pg8::cvt_pk_bf16(pa, pb); }
            carry += tot;
#pragma unroll
            for (int j = 0; j < 2; ++j) {
                v2u fa[4], fb[4];
                if (j == 0) { tr_read2<0, 8 * SB_VST>(fa[0], fb[0], tr_base); tr_read2<64, 8 * SB_VST + 64>(fa[1], fb[1], tr_base);
                              tr_read2<128, 8 * SB_VST + 128>(fa[2], fb[2], tr_base); tr_read2<192, 8 * SB_VST + 192>(fa[3], fb[3], tr_base); }
                else { tr_read2<16 * SB_VST, 24 * SB_VST>(fa[0], fb[0], tr_base); tr_read2<16 * SB_VST + 64, 24 * SB_VST + 64>(fa[1], fb[1], tr_base);
                       tr_read2<16 * SB_VST + 128, 24 * SB_VST + 128>(fa[2], fb[2], tr_base); tr_read2<16 * SB_VST + 192, 24 * SB_VST + 192>(fa[3], fb[3], tr_base); }
                asm volatile("s_waitcnt lgkmcnt(0)" : "+v"(fa[0]), "+v"(fb[0]), "+v"(fa[1]), "+v"(fb[1]), "+v"(fa[2]), "+v"(fb[2]), "+v"(fa[3]), "+v"(fb[3]) :: "memory");
#pragma unroll
                for (int dt = 0; dt < 4; ++dt) { v4u vw; vw.x = fa[dt].x; vw.y = fa[dt].y; vw.z = fb[dt].x; vw.w = fb[dt].y;
                    oacc[dt] = __builtin_amdgcn_mfma_f32_32x32x16_bf16(__builtin_bit_cast(bf8v, vw), __builtin_bit_cast(bf8v, pw[j]), oacc[dt], 0, 0, 0); }
            }
            if (__all(carry < SB_EXIT)) break;
        }
        float ss = 0.f;
        u16* orow = F.O() + (size_t)(b * SEQ + q0 + c) * DM + 2048 + h * HD + 4 * hi;
#pragma unroll
        for (int dt = 0; dt < 4; ++dt)
#pragma unroll
            for (int r4 = 0; r4 < 4; ++r4) { const float o0 = oacc[dt][4 * r4], o1 = oacc[dt][4 * r4 + 1], o2 = oacc[dt][4 * r4 + 2], o3 = oacc[dt][4 * r4 + 3];
                ss += (o0 * o0 + o1 * o1) + (o2 * o2 + o3 * o3);
                v2u w; w.x = pk2(o0, o1); w.y = pk2(o2, o3); *(v2u*)(orow + 32 * dt + 8 * r4) = w; }
        ss += xshf<32>(ss);
        if (hi == 0) F.SSQ()[(b * SEQ + q0 + c) * 32 + 16 + h] = ss;
    }
}
__device__ __forceinline__ unsigned mono_key(float f) { const unsigned u = __builtin_bit_cast(unsigned, f); return (u & 0x80000000u) ? ~u : (u | 0x80000000u); }
typedef unsigned u32x16 __attribute__((ext_vector_type(16)));
typedef float f32x2 __attribute__((ext_vector_type(2)));
typedef _Float16 h8v __attribute__((ext_vector_type(8)));
__device__ __forceinline__ int mbcnt64(unsigned long long m) { return (int)__builtin_amdgcn_mbcnt_hi((unsigned)(m >> 32), __builtin_amdgcn_mbcnt_lo((unsigned)m, 0u)); }
__device__ __forceinline__ float relu_i(float x) { const int i = __float_as_int(x); return __int_as_float(i > 0 ? i : 0); }
constexpr int IDX_CMAX = 1024;
constexpr int IDX_KST = 144, IDX_RK = 128, IDX_BUFB = IDX_RK * IDX_KST;
#define IDX_LDF(f, base, tt, k) do { f = *(const LAS h8v*)((base) + (tt) * 32 * IDX_KST + 32 * (k)); asm volatile("" ::: "memory"); } while (0)
#define IDX_MF(acc, a, f) acc = __builtin_amdgcn_mfma_f32_32x32x16_f16(a, f, acc, 0, 0, 0)
#define IDX_Z(acc) acc = (f32x16){0.f, 0.f, 0.f, 0.f, 0.f, 0.f, 0.f, 0.f, 0.f, 0.f, 0.f, 0.f, 0.f, 0.f, 0.f, 0.f}
#define IDX_RED(acc, pp) do { f32x2 sA_ = {0.f, 0.f}, sB_ = {0.f, 0.f}; \
        _Pragma("unroll") for (int q2 = 0; q2 < 8; q2 += 2) { \
            const f32x2 ra_ = {relu_i(acc[2 * q2]), relu_i(acc[2 * q2 + 1])}, rb_ = {relu_i(acc[2 * q2 + 2]), relu_i(acc[2 * q2 + 3])}; \
            sA_ = __builtin_elementwise_fma(wrp[q2], ra_, sA_); sB_ = __builtin_elementwise_fma(wrp[q2 + 1], rb_, sB_); } \
        const f32x2 st_ = sA_ + sB_; pp = st_.x + st_.y; } while (0)
#define IDX_OUT(kc, el, koff) do { auto sw = __builtin_amdgcn_permlane32_swap(__float_as_uint(pp0), __float_as_uint(pp1), false, false); \
        const unsigned sw0 = sw[0], sw1 = sw[1]; const float sc = __uint_as_float(sw0) + __uint_as_float(sw1); \
        const unsigned su_ = __float_as_uint(sc); const unsigned mk_ = su_ ^ ((unsigned)((int)su_ >> 31) | 0x80000000u);     \
        kc[el] = lane <= (t - (koff)) ? mk_ : 0u; } while (0)
#define IDX_CHUNK(kc, kp, ch) \
    if (8 * (ch) < nr) { \
        _Pragma("unroll") for (int rr_ = 0; rr_ < 8; ++rr_) { const int r = 8 * (ch) + rr_; \
            if (r < nr) { \
                const LAS unsigned char* curl = kl0 + (r & 1) * IDX_BUFB; LAS unsigned char* nxt = kbuf + ((r + 1) & 1) * IDX_BUFB; \
                const bool more = (r + 1) < nr; \
                if (more && stg) { pf0 = *(const GAS v4u*)(pfp); pf1 = *(const GAS v4u*)(pfp + 64 * 64); pfp += IDX_RK * 64; asm volatile("" : "+v"(pfp)); } \
                IDX_Z(accA); \
                IDX_LDF(fC, curl, 0, 2); IDX_MF(accA, a0, fA); \
                IDX_LDF(fA, curl, 0, 3); IDX_MF(accA, a1, fB); \
                if (r > 0) { IDX_RED(accB, pp1); if (rr_ > 0) IDX_OUT(kc, (rr_ > 0 ? 2 * rr_ - 1 : 0), (r - 1) * IDX_RK + 64); else IDX_OUT(kp, 15, (r - 1) * IDX_RK + 64); } \
                IDX_LDF(fB, curl, 1, 0); IDX_MF(accA, a2, fC); \
                IDX_LDF(fC, curl, 1, 1); IDX_MF(accA, a3, fA); \
                IDX_Z(accB); \
                IDX_LDF(fA, curl, 1, 2); IDX_MF(accB, a0, fB); \
                IDX_LDF(fB, curl, 1, 3); IDX_MF(accB, a1, fC); \
                IDX_RED(accA, pp0); \
                IDX_LDF(fC, curl, 2, 0); IDX_MF(accB, a2, fA); \
                IDX_LDF(fA, curl, 2, 1); IDX_MF(accB, a3, fB); \
                IDX_Z(accA); \
                IDX_LDF(fB, curl, 2, 2); IDX_MF(accA, a0, fC); \
                IDX_LDF(fC, curl, 2, 3); IDX_MF(accA, a1, fA); \
                IDX_RED(accB, pp1); IDX_OUT(kc, 2 * rr_, r * IDX_RK); \
                IDX_LDF(fA, curl, 3, 0); IDX_MF(accA, a2, fB); \
                IDX_LDF(fB, curl, 3, 1); IDX_MF(accA, a3, fC); \
                IDX_Z(accB); \
                IDX_LDF(fC, curl, 3, 2); IDX_MF(accB, a0, fA); \
                IDX_LDF(fA, curl, 3, 3); IDX_MF(accB, a1, fB); \
                IDX_RED(accA, pp0); \
                IDX_MF(accB, a2, fC); IDX_MF(accB, a3, fA); \
                if (more && stg) { *(LAS v4u*)(nxt + srow * IDX_KST + sch * 16) = pf0; *(LAS v4u*)(nxt + (srow + 64) * IDX_KST + sch * 16) = pf1; } \
                if (stg) __syncthreads(); \
                if (more) { const LAS unsigned char* nl_ = kl0 + ((r + 1) & 1) * IDX_BUFB; IDX_LDF(fA, nl_, 0, 0); IDX_LDF(fB, nl_, 0, 1); } \
                else { IDX_RED(accB, pp1); IDX_OUT(kc, 2 * rr_ + 1, r * IDX_RK + 64); } \
            } } }
#define IDX_COUNT_GE(kc, ch) if (16 * (ch) < nreg) { _Pragma("unroll") for (int i_ = 0; i_ < 16; ++i_) cv += kc[i_] >= cand ? 1 : 0; }
#define IDX_MAX(kc, ch) if (16 * (ch) < nreg) { _Pragma("unroll") for (int i_ = 0; i_ < 16; ++i_) km = kc[i_] > km ? kc[i_] : km; }
#define IDX_COMPACT(kc, ch) if (16 * (ch) < nreg) { _Pragma("unroll") for (int i_ = 0; i_ < 16; ++i_) { const unsigned kk_ = kc[i_]; const bool f_ = kk_ >= T; const unsigned long long mf_ = __ballot(f_); \
                if (mf_ != 0ull) { const int p_ = cb + mbcnt64(mf_); int ln_ = lane; asm volatile("" : "+v"(ln_)); if (f_ && p_ < IDX_CMAX) { cmk[p_] = kk_; cmi[p_] = (unsigned)(64 * (16 * (ch) + i_) + ln_); } cb += (int)__popcll(mf_); } } }
#define IDX_COUNT_GT(kc, ch) if (16 * (ch) < nreg) { _Pragma("unroll") for (int i_ = 0; i_ < 16; ++i_) cv += kc[i_] > T ? 1 : 0; }
#define IDX_EMIT(kc, ch) if (16 * (ch) < nreg) { _Pragma("unroll") for (int i_ = 0; i_ < 16; ++i_) { \
                const int rg = 16 * (ch) + i_; const unsigned kk = kc[i_]; \
                const bool gt = kk > T, eq = kk == T; \
                const unsigned long long meq = __ballot(eq); \
                const bool sel = gt || (eq && (eqbase + mbcnt64(meq)) < need); \
                const unsigned long long ms = __ballot(sel); \
                if (ms != 0ull) { \
                    const int pos = base + mbcnt64(ms); \
                    int ln_ = lane; asm volatile("" : "+v"(ln_));     \
                    const int s = 64 * rg + ln_, d = t - s; \
                    const unsigned bk = d < 128 ? tbl[d < 0 ? 0 : d] : 31u; \
                    if (sel && pos < TOPK) list[pos] = (unsigned)s | (bk << 16); \
                    base += (int)__popcll(ms); \
                } \
                eqbase += (int)__popcll(meq); } }
__device__ __forceinline__ void idx_fast(Frame& F0) {
    Frame F = F0; rethread(F);
    LAS unsigned char* kbuf = F.lds + RING_OFF;
    LAS unsigned* tbl = (LAS unsigned*)(F.lds + RING_OFF + 2 * IDX_BUFB);
    LAS unsigned* cmk = (LAS unsigned*)(F.lds + RING_OFF + 40960 + F.wave * 8192);
    LAS unsigned* cmi = cmk + IDX_CMAX;
    const int tid = F.tid, lane = F.lane, wave = F.wave, hi = lane >> 5, c32 = lane & 31;
    if (tid < 128) tbl[tid] = t5_bucket(tid);
    __syncthreads();
    const int srow = tid >> 3, sch = tid & 7;
    for (int item = F.vcu; item < 2048; item += F.G) {
        const int kq = item >> 8, w = item & 255, b = kq & 1, q = kq >> 1;
        const int gi = q == 0 ? w : (q == 1 ? 511 - w : (q == 2 ? 512 + w : 1023 - w));
        const int t0 = gi * 8, t = t0 + wave, m = b * SEQ + t;
        unsigned* list = F.LIST() + (size_t)m * TOPK;
        if (t0 + 8 <= TOPK) {
#pragma unroll
            for (int j = 0; j < 4; ++j) { const int i = lane + 64 * j; const int d = t - i; list[i] = i <= t ? ((unsigned)i | (t5_bucket(d < 0 ? 0 : d) << 16)) : 0u; }
            continue;
        }
        const u16* iqp = F.IQ() + (size_t)m * 2048 + c32 * 64 + hi * 8;
        const h8v a0 = *(const h8v*)(iqp), a1 = *(const h8v*)(iqp + 16), a2 = *(const h8v*)(iqp + 32), a3 = *(const h8v*)(iqp + 48);
        f32x16 wr;
#pragma unroll
        for (int r = 0; r < 16; ++r) wr[r] = F.IWS()[(size_t)m * 32 + 8 * (r >> 2) + 4 * hi + (r & 3)] * (0.17677669529663687f * 0.125f);
        f32x2 wrp[8];
#pragma unroll
        for (int r = 0; r < 8; ++r) wrp[r] = (f32x2){wr[2 * r], wr[2 * r + 1]};
        const u32x16 kz = {0u, 0u, 0u, 0u, 0u, 0u, 0u, 0u, 0u, 0u, 0u, 0u, 0u, 0u, 0u, 0u};
        u32x16 k0 = kz, k1 = kz, k2 = kz, k3 = kz, k4 = kz, k5 = kz, k6 = kz, k7 = kz;
        const int nr = (t0 + 8 + IDX_RK - 1) / IDX_RK;
        const u16* kg = F.IKN() + (size_t)b * SEQ * 64;
#if defined(PROBE_IDX) && (PROBE_IDX == 4 || PROBE_IDX == 5)
        { const LAS unsigned char* kl0p = kbuf + c32 * IDX_KST + hi * 16; float dm = 0.f;
          for (int r = 0; r < nr; ++r) {
#pragma unroll
              for (int tt = 0; tt < 4; ++tt) { const LAS unsigned char* kp = kl0p + (r & 1) * IDX_BUFB + tt * 32 * IDX_KST;
                  f32x16 acc = {0.f, 0.f, 0.f, 0.f, 0.f, 0.f, 0.f, 0.f, 0.f, 0.f, 0.f, 0.f, 0.f, 0.f, 0.f, 0.f};
                  acc = __builtin_amdgcn_mfma_f32_32x32x16_f16(a0, *(const LAS h8v*)(kp), acc, 0, 0, 0); acc = __builtin_amdgcn_mfma_f32_32x32x16_f16(a1, *(const LAS h8v*)(kp + 32), acc, 0, 0, 0);
                  acc = __builtin_amdgcn_mfma_f32_32x32x16_f16(a2, *(const LAS h8v*)(kp + 64), acc, 0, 0, 0); acc = __builtin_amdgcn_mfma_f32_32x32x16_f16(a3, *(const LAS h8v*)(kp + 96), acc, 0, 0, 0);
                  if (PROBE_IDX == 5) { float s0 = 0.f, s1 = 0.f, s2 = 0.f, s3 = 0.f;
#pragma unroll
                      for (int q4 = 0; q4 < 16; q4 += 4) { s0 += wr[q4] * relu_i(acc[q4]); s1 += wr[q4 + 1] * relu_i(acc[q4 + 1]); s2 += wr[q4 + 2] * relu_i(acc[q4 + 2]); s3 += wr[q4 + 3] * relu_i(acc[q4 + 3]); }
                      dm += (s0 + s1) + (s2 + s3); }
                  else dm += acc[0] + acc[5]; } }
          if (dm == 123.456f) F.IWS()[(size_t)m * 32] = dm; }
#endif
#if defined(PROBE_IDX) && PROBE_IDX == 3
        { const GAS u16* dp = (const GAS u16*)kg + (size_t)srow * 64 + sch * 8;
          for (int r = 0; r < nr; ++r) { const v4u d0 = *(const GAS v4u*)(dp), d1 = *(const GAS v4u*)(dp + 64 * 64); dp += IDX_RK * 64; asm volatile("" : "+v"(dp));
              LAS unsigned char* nb_ = kbuf + (r & 1) * IDX_BUFB; *(LAS v4u*)(nb_ + srow * IDX_KST + sch * 16) = d0; *(LAS v4u*)(nb_ + (srow + 64) * IDX_KST + sch * 16) = d1; __syncthreads(); } }
#endif
        const GAS u16* pfp = (const GAS u16*)kg + (size_t)srow * 64 + sch * 8;
        v4u pf0 = *(const GAS v4u*)(pfp), pf1 = *(const GAS v4u*)(pfp + 64 * 64); pfp += IDX_RK * 64; asm volatile("" : "+v"(pfp));
        *(LAS v4u*)(kbuf + srow * IDX_KST + sch * 16) = pf0; *(LAS v4u*)(kbuf + (srow + 64) * IDX_KST + sch * 16) = pf1;
        __syncthreads();
        const LAS unsigned char* kl0 = kbuf + c32 * IDX_KST + hi * 16;
        h8v fA, fB, fC; f32x16 accA, accB; float pp0 = 0.f, pp1 = 0.f;
        IDX_LDF(fA, kl0, 0, 0); IDX_LDF(fB, kl0, 0, 1);
#ifndef PROBE_IDX
#define PROBE_IDX 0
#endif
        for (int prb_ = 0; prb_ < ((PROBE_IDX == 1 || PROBE_IDX == 2) ? 2 : 1); ++prb_) {
        const bool stg = !(PROBE_IDX == 2 && prb_ == 0);
        if (prb_ == 1) { pfp = (const GAS u16*)kg + (size_t)srow * 64 + sch * 8; pf0 = *(const GAS v4u*)(pfp); pf1 = *(const GAS v4u*)(pfp + 64 * 64); pfp += IDX_RK * 64; asm volatile("" : "+v"(pfp));
            *(LAS v4u*)(kbuf + srow * IDX_KST + sch * 16) = pf0; *(LAS v4u*)(kbuf + (srow + 64) * IDX_KST + sch * 16) = pf1; __syncthreads(); IDX_LDF(fA, kl0, 0, 0); IDX_LDF(fB, kl0, 0, 1); }
        IDX_CHUNK(k0, k0, 0) IDX_CHUNK(k1, k0, 1) IDX_CHUNK(k2, k1, 2) IDX_CHUNK(k3, k2, 3) IDX_CHUNK(k4, k3, 4) IDX_CHUNK(k5, k4, 5) IDX_CHUNK(k6, k5, 6) IDX_CHUNK(k7, k6, 7)
        }
        const int nreg = 2 * nr;
        unsigned T = 0u; int cT = 1 << 30, bit = 31; bool done = false;
        { unsigned km = 0u;
          IDX_MAX(k0, 0) IDX_MAX(k1, 1) IDX_MAX(k2, 2) IDX_MAX(k3, 3) IDX_MAX(k4, 4) IDX_MAX(k5, 5) IDX_MAX(k6, 6) IDX_MAX(k7, 7)
          km = (unsigned)__builtin_amdgcn_readfirstlane(wave_max_u(km));
          for (unsigned e = km >> 23, tries = 0u; tries < 3u; --e, ++tries) {
              const unsigned cand = e << 23; int cv = 0;
              IDX_COUNT_GE(k0, 0) IDX_COUNT_GE(k1, 1) IDX_COUNT_GE(k2, 2) IDX_COUNT_GE(k3, 3) IDX_COUNT_GE(k4, 4) IDX_COUNT_GE(k5, 5) IDX_COUNT_GE(k6, 6) IDX_COUNT_GE(k7, 7)
              const int c = __builtin_amdgcn_readfirstlane(wave_sum_i(cv));
              if (c >= TOPK) { T = cand; cT = c; done = (c == TOPK); bit = 22; break; }
              if (e == 0u) break; } }
        while (!done && bit >= 0 && cT > IDX_CMAX) {
            const unsigned cand = T | (1u << bit); int cv = 0;
            IDX_COUNT_GE(k0, 0) IDX_COUNT_GE(k1, 1) IDX_COUNT_GE(k2, 2) IDX_COUNT_GE(k3, 3) IDX_COUNT_GE(k4, 4) IDX_COUNT_GE(k5, 5) IDX_COUNT_GE(k6, 6) IDX_COUNT_GE(k7, 7)
            const int c = __builtin_amdgcn_readfirstlane(wave_sum_i(cv));
            if (c >= TOPK) { T = cand; cT = c; }
            done = (c == TOPK); --bit;
        }
        if (done || bit < 0) {
            int cv = 0;
            IDX_COUNT_GT(k0, 0) IDX_COUNT_GT(k1, 1) IDX_COUNT_GT(k2, 2) IDX_COUNT_GT(k3, 3) IDX_COUNT_GT(k4, 4) IDX_COUNT_GT(k5, 5) IDX_COUNT_GT(k6, 6) IDX_COUNT_GT(k7, 7)
            const int need = TOPK - __builtin_amdgcn_readfirstlane(wave_sum_i(cv));
            int base = 0, eqbase = 0;
            IDX_EMIT(k0, 0) IDX_EMIT(k1, 1) IDX_EMIT(k2, 2) IDX_EMIT(k3, 3) IDX_EMIT(k4, 4) IDX_EMIT(k5, 5) IDX_EMIT(k6, 6) IDX_EMIT(k7, 7)
        } else {
            int cb = 0;
            IDX_COMPACT(k0, 0) IDX_COMPACT(k1, 1) IDX_COMPACT(k2, 2) IDX_COMPACT(k3, 3) IDX_COMPACT(k4, 4) IDX_COMPACT(k5, 5) IDX_COMPACT(k6, 6) IDX_COMPACT(k7, 7)
            u32x16 kq;
#pragma unroll
            for (int q = 0; q < 16; ++q) kq[q] = (64 * q + lane) < cb ? cmk[64 * q + lane] : 0u;
            for (; bit >= 0; --bit) {
                const unsigned cand = T | (1u << bit); int cv = 0;
#pragma unroll
                for (int q = 0; q < 16; ++q) cv += kq[q] >= cand ? 1 : 0;
                const int c = __builtin_amdgcn_readfirstlane(wave_sum_i(cv));
                if (c >= TOPK) T = cand;
                if (c == TOPK) break;
            }
            int cv = 0;
#pragma unroll
            for (int q = 0; q < 16; ++q) cv += kq[q] > T ? 1 : 0;
            const int need = TOPK - __builtin_amdgcn_readfirstlane(wave_sum_i(cv));
            int base = 0, eqbase = 0;
#pragma unroll
            for (int q = 0; q < 16; ++q) if (64 * q < cb) {
                const unsigned kk = kq[q];
                const bool gt = kk > T, eq = kk == T && (64 * q + lane) < cb;
                const unsigned long long meq = __ballot(eq);
                const bool sel = gt || (eq && (eqbase + mbcnt64(meq)) < need);
                const unsigned long long ms = __ballot(sel);
                if (ms != 0ull) {
                    const int pos = base + mbcnt64(ms);
                    const int sidx = (int)cmi[64 * q + lane], d = t - sidx;
                    const unsigned bk = d < 128 ? tbl[d < 0 ? 0 : d] : 31u;
                    if (sel && pos < TOPK) list[pos] = (unsigned)sidx | (bk << 16);
                    base += (int)__popcll(ms);
                }
                eqbase += (int)__popcll(meq);
            }
        }
    }
}
template <int O1, int O2> __device__ __forceinline__ void tr8_read2(v2u& a, v2u& b, unsigned addr) {
    asm volatile("ds_read_b64_tr_b8 %0, %2 offset:%3\n\tds_read_b64_tr_b8 %1, %2 offset:%4" : "=&v"(a), "=&v"(b) : "v"(addr), "i"(O1), "i"(O2) : "memory");
}
constexpr int SPA_VST = 288;
constexpr int SPA_V8ST = 144;
constexpr int SPA_WAVE_LDS = 2048 + 64 * SPA_V8ST + 1024 + 64;
template <bool FILL> __device__ __forceinline__ void sparse_fast(Frame& F0) {
    Frame F = F0; rethread(F);
    const float* const relb_p = F.relb();
    LAS float* rb = (LAS float*)(F.lds + RING_OFF + NWAVES * SPA_WAVE_LDS);
    if (FILL) for (int i = F.tid; i < 512; i += NWAVES * 64) rb[i] = relb_p[i] * 1.4426950408889634f;
    LAS unsigned char* wl = F.lds + RING_OFF + F.wave * SPA_WAVE_LDS;
    LAS unsigned* le = (LAS unsigned*)wl;
    LAS unsigned char* vst = wl + 2048;
    LAS float* lgb = (LAS float*)vst;
    LAS unsigned* pbb = (LAS unsigned*)(wl + 2048 + 64 * SPA_V8ST);
    LAS float* psb = (LAS float*)(wl + 2048 + 64 * SPA_V8ST + 1024);
    LAS u16* ktab = (LAS u16*)(F.lds + RING_OFF + NWAVES * SPA_WAVE_LDS + 2048);
    LAS u16* vtab = (LAS u16*)(F.lds + TAIL_OFF);
    const unsigned vst_addr = (unsigned)(size_t)vst;
    const int lane = F.lane, hh = lane & 15, qd = lane >> 4;
    const int gw = F.vcu * NWAVES + F.wave, NGW = F.G * NWAVES, per = NGW / 8;
    const int bg = gw / per, r0 = gw % per;
    if (FILL) { const int bgc = bg < 8 ? bg : 7; const GAS v4u* ksrc = (const GAS v4u*)(F.KS() + (size_t)bgc * SEQ); const GAS v4u* vsrc = (const GAS v4u*)(F.VS() + (size_t)bgc * SEQ);
      for (int i = F.tid; i < SEQ / 8; i += NWAVES * 64) { ((LAS v4u*)ktab)[i] = ksrc[i]; ((LAS v4u*)vtab)[i] = vsrc[i]; } }
    __syncthreads();
    if (bg < 8) {
    const int b = bg >> 2, g = bg & 3;
    const unsigned tr_base = vst_addr + (unsigned)((16 * qd + (hh >> 1)) * SPA_V8ST + 8 * (hh & 1));
    constexpr int KD = 8;
    unsigned en[4];
    v4u kf[KD + 1][2]; v4u qraw[2]; float sqn = 0.f;
    const unsigned char* const kbase = F.KQ8() + ((size_t)(b * SEQ) * 4 + g) * 128;
    const unsigned klo = 16u * (unsigned)qd, vlo = 16u * (unsigned)(lane & 7);
    const unsigned char* const vbase = F.VQ8() + ((size_t)(b * SEQ) * 4 + g) * 128;
#define SPA_STAGE(tt, leb) do { const int cnt_ = ((tt) + 1) < TOPK ? ((tt) + 1) : TOPK; \
        _Pragma("unroll") for (int j_ = 0; j_ < 4; ++j_) { const int pos_ = 64 * j_ + lane; (leb)[pos_] = pos_ < cnt_ ? en[j_] : 0u; } \
        _Pragma("unroll") for (int pt_ = 0; pt_ < KD; ++pt_) { const unsigned idx_ = (leb)[16 * pt_ + hh] & 0xffffu; const unsigned char* kp_ = kbase + (idx_ * 512u + klo); \
            kf[pt_][0] = *(const v4u*)(kp_); kf[pt_][1] = *(const v4u*)(kp_ + 64); } \
        { const unsigned char* qp_ = F.Q8() + (size_t)(b * SEQ + (tt)) * 2048 + (4 * g + (hh & 3)) * HD + 16 * qd; \
          qraw[0] = __builtin_nontemporal_load((const v4u*)(qp_)); qraw[1] = __builtin_nontemporal_load((const v4u*)(qp_ + 64)); \
          sqn = F.QS()[(size_t)(b * SEQ + (tt)) * 16 + 4 * g + (lane >> 4)]; } } while (0)
    if (r0 < SEQ) {
#pragma unroll
        for (int j = 0; j < 4; ++j) en[j] = __builtin_nontemporal_load(F.LIST() + (size_t)(b * SEQ + r0) * TOPK + 64 * j + lane);
        SPA_STAGE(r0, le);
        { const int tn = (r0 + per) < SEQ ? (r0 + per) : r0;
#pragma unroll
          for (int j = 0; j < 4; ++j) en[j] = __builtin_nontemporal_load(F.LIST() + (size_t)(b * SEQ + tn) * TOPK + 64 * j + lane); }
    }
    int par = 0;
    for (int t = r0; t < SEQ; t += per, par ^= 1) {
        const int m = b * SEQ + t;
        const int cnt = (t + 1) < TOPK ? (t + 1) : TOPK;
        LAS unsigned* lec = le + 256 * par;
        LAS unsigned* len = le + 256 * (par ^ 1);
        v4u vr[2][8];
#pragma unroll
        for (int pt = 0; pt < 2; ++pt)
#pragma unroll
            for (int i = 0; i < 8; ++i) { const int R = 8 * i + (lane >> 3); const int kp = 16 * (R & 3) + 4 * (R >> 4) + ((R >> 2) & 3);
                const unsigned idx = lec[64 * pt + kp] & 0xffffu; vr[pt][i] = *(const v4u*)(vbase + (idx * 512u + vlo)); }
        pg8::i32x4 qf[2]; const float sqs = sqn * (0.08838834764831845f * 1.4426950408889634f);
#pragma unroll
        for (int st = 0; st < 2; ++st) qf[st] = hh < 4 ? __builtin_bit_cast(pg8::i32x4, qraw[st]) : (pg8::i32x4){0, 0, 0, 0};
        float cl[16];
#pragma unroll
        for (int tile = 0; tile < 16; ++tile) {
            if (tile + KD < 16) { const unsigned idx = lec[16 * (tile + KD) + hh] & 0xffffu; const unsigned char* kp = kbase + (idx * 512u + klo);
#pragma unroll
                for (int st = 0; st < 2; ++st) kf[(tile + KD) % (KD + 1)][st] = *(const v4u*)(kp + 64 * st); }
            pg8::i32x4 acc = {0, 0, 0, 0};
#pragma unroll
            for (int st = 0; st < 2; ++st) acc = __builtin_amdgcn_mfma_i32_16x16x64_i8(__builtin_bit_cast(pg8::i32x4, kf[tile % (KD + 1)][st]), qf[st], acc, 0, 0, 0);
            if (hh < 4) *(LAS pg8::i32x4*)(lgb + 64 * tile + 16 * hh + 4 * qd) = acc;
        }
#pragma unroll
        for (int tile = 0; tile < 16; ++tile) cl[tile] = (float)((const LAS int*)lgb)[64 * tile + lane];
        const int ch = lane >> 4, ck = lane & 15;
        float mx = -INFINITY;
#pragma unroll
        for (int tile = 0; tile < 16; ++tile) { const int pos = 16 * tile + ck; const unsigned e = lec[pos];
            const float bias = rb[((e >> 16) & 31u) * 16 + 4 * g + ch];
            const float lgv = cl[tile] * (hlo((unsigned)ktab[e & 0xffffu]) * sqs) + bias; const float lg = pos < cnt ? lgv : -INFINITY;
            cl[tile] = lg; mx = fmaxf(mx, lg); }
        mx = fmaxf(mx, xshf<1>(mx)); mx = fmaxf(mx, xshf<2>(mx)); mx = fmaxf(mx, xshf<4>(mx)); mx = fmaxf(mx, xshf<8>(mx));
        float ps = 0.f;
#pragma unroll
        for (int tile = 0; tile < 16; ++tile) { const float p = __builtin_amdgcn_exp2f(cl[tile] - mx); cl[tile] = p; ps += p; }
        ps += xshf<1>(ps); ps += xshf<2>(ps); ps += xshf<4>(ps); ps += xshf<8>(ps);
        float pm = 0.f;
#pragma unroll
        for (int tile = 0; tile < 16; ++tile) { cl[tile] *= hlo((unsigned)vtab[lec[16 * tile + ck] & 0xffffu]); pm = fmaxf(pm, cl[tile]); }
        pm = fmaxf(pm, xshf<1>(pm)); pm = fmaxf(pm, xshf<2>(pm)); pm = fmaxf(pm, xshf<4>(pm)); pm = fmaxf(pm, xshf<8>(pm));
        { const float pinv = pm > 0.f ? 127.0f / pm : 0.f;
#pragma unroll
          for (int T = 0; T < 4; ++T) pbb[ch * 64 + T * 16 + ck] = q4((f32x4){cl[4 * T], cl[4 * T + 1], cl[4 * T + 2], cl[4 * T + 3]}, pinv); }
        if (ck == 0) { psb[2 * ch] = pm * (1.0f / 127.0f) / ps; }
        const float oscale = psb[2 * (hh & 3)];
        { const int tn = (t + per) < SEQ ? (t + per) : t;
          SPA_STAGE(tn, len);
          const int tnn = (tn + per) < SEQ ? (tn + per) : tn;
#pragma unroll
          for (int j = 0; j < 4; ++j) en[j] = __builtin_nontemporal_load(F.LIST() + (size_t)(b * SEQ + tnn) * TOPK + 64 * j + lane); }
        pg8::i32x4 oacc[8];
#pragma unroll
        for (int dt = 0; dt < 8; ++dt) oacc[dt] = (pg8::i32x4){0, 0, 0, 0};
#pragma unroll
        for (int T = 0; T < 4; ++T) {
#pragma unroll
            for (int i = 0; i < 8; ++i) *(LAS v4u*)(vst + (8 * i + (lane >> 3)) * SPA_V8ST + (lane & 7) * 16) = vr[T & 1][i];
            if (T + 2 < 4) {
#pragma unroll
                for (int i = 0; i < 8; ++i) { const int R = 8 * i + (lane >> 3); const int kp = 16 * (R & 3) + 4 * (R >> 4) + ((R >> 2) & 3);
                    const unsigned idx = lec[64 * (T + 2) + kp] & 0xffffu; vr[T & 1][i] = *(const v4u*)(vbase + (idx * 512u + vlo)); } }
            const pg8::i32x4 pq = __builtin_bit_cast(pg8::i32x4, *(const LAS v4u*)(pbb + (hh & 3) * 64 + T * 16 + 4 * qd));
            v2u fa[8], fb[8];
            tr8_read2<0, 8 * SPA_V8ST>(fa[0], fb[0], tr_base); tr8_read2<16, 8 * SPA_V8ST + 16>(fa[1], fb[1], tr_base);
            tr8_read2<32, 8 * SPA_V8ST + 32>(fa[2], fb[2], tr_base); tr8_read2<48, 8 * SPA_V8ST + 48>(fa[3], fb[3], tr_base);
            tr8_read2<64, 8 * SPA_V8ST + 64>(fa[4], fb[4], tr_base); tr8_read2<80, 8 * SPA_V8ST + 80>(fa[5], fb[5], tr_base);
            tr8_read2<96, 8 * SPA_V8ST + 96>(fa[6], fb[6], tr_base); tr8_read2<112, 8 * SPA_V8ST + 112>(fa[7], fb[7], tr_base);
            asm volatile("s_waitcnt lgkmcnt(0)" : "+v"(fa[0]), "+v"(fb[0]), "+v"(fa[1]), "+v"(fb[1]), "+v"(fa[2]), "+v"(fb[2]), "+v"(fa[3]), "+v"(fb[3]),
                         "+v"(fa[4]), "+v"(fb[4]), "+v"(fa[5]), "+v"(fb[5]), "+v"(fa[6]), "+v"(fb[6]), "+v"(fa[7]), "+v"(fb[7]) :: "memory");
#pragma unroll
            for (int dt = 0; dt < 8; ++dt) { pg8::i32x4 vw; vw[0] = (int)fa[dt].x; vw[1] = (int)fa[dt].y; vw[2] = (int)fb[dt].x; vw[3] = (int)fb[dt].y;
                oacc[dt] = __builtin_amdgcn_mfma_i32_16x16x64_i8(vw, pq, oacc[dt], 0, 0, 0); }
        }
        float ss = 0.f;
        u16* orow = F.O() + (size_t)m * DM + (4 * g + (hh & 3)) * HD + 4 * qd;
#pragma unroll
        for (int dt = 0; dt < 8; ++dt) { const f32x4 o = __builtin_convertvector(oacc[dt], f32x4) * oscale; ss += (o.x * o.x + o.y * o.y) + (o.z * o.z + o.w * o.w);
            if (hh < 4) { v2u w; w.x = pk2(o.x, o.y); w.y = pk2(o.z, o.w); __builtin_nontemporal_store(w, (v2u*)(orow + 16 * dt)); } }
        ss += xshf<16>(ss); ss += xshf<32>(ss);
        if (lane < 4) F.SSQ()[m * 32 + 4 * g + lane] = ss;
    }
    }
}
template <bool FILL> __device__ __forceinline__ void p6_norm(Frame& F0) {
    Frame F = F0; rethread(F);
    const float* const gn_a_p = F.gn_a();
    const float* const gn_b_p = F.gn_b();
    const int gw = F.vcu * NWAVES + F.wave, NGW = F.G * NWAVES;
    LAS float* pl = (LAS float*)(F.lds + RING_OFF);
    if (FILL) { lds_fill(pl, gn_a_p, 2048, F.tid); lds_fill(pl + 2048, gn_b_p, 2048, F.tid); }
    __syncthreads();
    for (int m = gw; m < M; m += NGW) {
        const float sv = F.lane < 32 ? F.SSQ()[m * 32 + F.lane] : 0.f;
        float sa = F.lane < 16 ? sv : 0.f, sb = (F.lane >= 16 && F.lane < 32) ? sv : 0.f;
        sa = wave_sum(sa); sb = wave_sum(sb);
        const float ra = 1.f / sqrtf(sa * (1.f / 2048.f) + LN_EPS), rb = 1.f / sqrtf(sb * (1.f / 2048.f) + LN_EPS);
        const GAS v4u* src = (const GAS v4u*)(F.O() + (size_t)m * DM) + F.lane;
        f32x4 y[16]; float am = 0.f;
#pragma unroll
        for (int j = 0; j < 8; ++j) { const int col = 8 * (F.lane + 64 * j); const v4u w = src[64 * j];
            const float r = col < 2048 ? ra : rb;
            const f32x4 g0 = ldl(pl, 32u * (unsigned)F.lane, 512 * j), g1 = ldl(pl, 32u * (unsigned)F.lane, 512 * j + 4);
            y[2 * j] = (f32x4){bflo(w.x), bfhi(w.x), bflo(w.y), bfhi(w.y)} * r * g0; y[2 * j + 1] = (f32x4){bflo(w.z), bfhi(w.z), bflo(w.w), bfhi(w.w)} * r * g1;
            am = fmaxf(am, fmaxf(amax4(y[2 * j]), amax4(y[2 * j + 1]))); }
        am = wave_max(am); const float inv = am > 0.f ? 127.0f / am : 0.f;
        if (F.lane == 0) F.SA_ON()[m] = am * (1.0f / 127.0f);
        GAS v2u* dst = (GAS v2u*)(F.ONQ() + (size_t)m * DM) + F.lane;
#pragma unroll
        for (int j = 0; j < 8; ++j) { v2u o; o.x = q4(y[2 * j], inv); o.y = q4(y[2 * j + 1], inv); dst[64 * j] = o; }
    }
}
template <bool FILL> __device__ __forceinline__ void p8_rows(Frame& F0) {
    Frame F = F0; rethread(F);
    const float* const ln1_g_p = F.ln1_g();
    const float* const ln1_b_p = F.ln1_b();
    const int gw = F.vcu * NWAVES + F.wave, NGW = F.G * NWAVES;
    LAS float* pl = (LAS float*)(F.lds + RING_OFF);
    if (FILL) { lds_fill(pl, ln1_g_p, DM, F.tid); lds_fill(pl + DM, ln1_b_p, DM, F.tid);
        lds_fill(pl + 2 * DM, F.MOD() + 3 * DM, 2 * DM, F.tid); lds_fill(pl + 4 * DM, F.MOD() + 9 * DM, 2 * DM, F.tid); }
    __syncthreads();
    for (int m = gw; m < M; m += NGW) {
        const GAS v4u* xr = (const GAS v4u*)(F.V1B() + (size_t)m * DM) + F.lane;
        f32x4 v[16]; float s = 0.f;
#pragma unroll
        for (int j = 0; j < 8; ++j) { const v4u w = xr[64 * j]; v[2 * j] = (f32x4){bflo(w.x), bfhi(w.x), bflo(w.y), bfhi(w.y)}; v[2 * j + 1] = (f32x4){bflo(w.z), bfhi(w.z), bflo(w.w), bfhi(w.w)}; }
#pragma unroll
        for (int j = 0; j < 16; ++j) s += (v[j].x + v[j].y) + (v[j].z + v[j].w);
        const float mean = wave_sum(s) * (1.f / DM); float s2 = 0.f;
#pragma unroll
        for (int j = 0; j < 16; ++j) { v[j] = v[j] - mean; s2 += (v[j].x * v[j].x + v[j].y * v[j].y) + (v[j].z * v[j].z + v[j].w * v[j].w); }
        const float rstd = 1.f / sqrtf(wave_sum(s2) * (1.f / DM) + LN_EPS);
        if (F.lane == 0) { F.ST1()[2 * m] = mean; F.ST1()[2 * m + 1] = rstd; }
        LAS float* mod = pl + 2 * DM + (m / SEQ) * (2 * DM);
        float am = 0.f;
#pragma unroll
        for (int j = 0; j < 16; ++j) { if ((j & 3) == 0) asm volatile("" ::: "memory");
            const unsigned lb = 32u * (unsigned)F.lane; const int cj = 512 * (j >> 1) + 4 * (j & 1);
            const f32x4 gg = ldl(pl, lb, cj), bb = ldl(pl, lb, DM + cj), sh = ldl(mod, lb, cj), sc = ldl(mod, lb, DM + cj);
            const f32x4 h = v[j] * rstd * gg + bb; const f32x4 u = h * (sc + 1.0f) + sh; v[j] = u; am = fmaxf(am, amax4(u)); }
        am = wave_max(am); const float inv = am > 0.f ? 127.0f / am : 0.f;
        if (F.lane == 0) F.SA_U1()[m] = am * (1.0f / 127.0f);
        GAS v2u* oq = (GAS v2u*)(F.U1Q() + (size_t)m * DM) + F.lane;
#pragma unroll
        for (int j = 0; j < 8; ++j) { v2u o; o.x = q4(v[2 * j], inv); o.y = q4(v[2 * j + 1], inv); oq[64 * j] = o; }
    }
}
template <bool FILL> __device__ __forceinline__ void p11_rows(Frame& F0) {
    Frame F = F0; rethread(F);
    const float* const ln2_g_p = F.ln2_g();
    const float* const ln2_b_p = F.ln2_b();
    float* const out_p = F.out();
    const int gw = F.vcu * NWAVES + F.wave, NGW = F.G * NWAVES;
    LAS float* pl = (LAS float*)(F.lds + RING_OFF);
    if (FILL) { lds_fill(pl, ln2_g_p, DM, F.tid); lds_fill(pl + DM, ln2_b_p, DM, F.tid); }
    __syncthreads();
    for (int m = gw; m < M; m += NGW) {
        const GAS v4u* xr = (const GAS v4u*)(F.H0B() + (size_t)m * DM) + F.lane;
        f32x4 v[16]; float s = 0.f;
#pragma unroll
        for (int j = 0; j < 8; ++j) { const v4u w = xr[64 * j]; v[2 * j] = (f32x4){bflo(w.x), bfhi(w.x), bflo(w.y), bfhi(w.y)}; v[2 * j + 1] = (f32x4){bflo(w.z), bfhi(w.z), bflo(w.w), bfhi(w.w)}; }
#pragma unroll
        for (int j = 0; j < 16; ++j) s += (v[j].x + v[j].y) + (v[j].z + v[j].w);
        const float mean = wave_sum(s) * (1.f / DM); float s2 = 0.f;
#pragma unroll
        for (int j = 0; j < 16; ++j) { v[j] = v[j] - mean; s2 += (v[j].x * v[j].x + v[j].y * v[j].y) + (v[j].z * v[j].z + v[j].w * v[j].w); }
        const float rstd = 1.f / sqrtf(wave_sum(s2) * (1.f / DM) + LN_EPS);
        GAS f32x4* orow = (GAS f32x4*)(out_p + (size_t)m * DM) + 2 * F.lane;
#pragma unroll
        for (int j = 0; j < 16; ++j) { if ((j & 3) == 0) asm volatile("" ::: "memory");
            const unsigned lb = 32u * (unsigned)F.lane; const int cj = 512 * (j >> 1) + 4 * (j & 1);
            const f32x4 gg = ldl(pl, lb, cj), bb = ldl(pl, lb, DM + cj);
            orow[128 * (j >> 1) + (j & 1)] = v[j] * rstd * gg + bb; }
    }
}

__device__ __forceinline__ void pre_fill_sync() { asm volatile("s_waitcnt vmcnt(0) lgkmcnt(0)" ::: "memory"); __syncthreads(); }
__device__ __forceinline__ void sparse_prefill(Frame& F0) {
    Frame F = F0; rethread(F);
    LAS float* rb = (LAS float*)(F.lds + RING_OFF + NWAVES * SPA_WAVE_LDS); const float* relb_p = F.relb();
    for (int i = F.tid; i < 512; i += NWAVES * 64) rb[i] = relb_p[i] * 1.4426950408889634f;
    LAS u16* ktab = (LAS u16*)(F.lds + RING_OFF + NWAVES * SPA_WAVE_LDS + 2048); LAS u16* vtab = (LAS u16*)(F.lds + TAIL_OFF);
    const int gw = F.vcu * NWAVES + F.wave, per = F.G * NWAVES / 8, bg = gw / per, bgc = bg < 8 ? bg : 7;
    const GAS v4u* ksrc = (const GAS v4u*)(F.KS() + (size_t)bgc * SEQ); const GAS v4u* vsrc = (const GAS v4u*)(F.VS() + (size_t)bgc * SEQ);
    for (int i = F.tid; i < SEQ / 8; i += NWAVES * 64) { ((LAS v4u*)ktab)[i] = ksrc[i]; ((LAS v4u*)vtab)[i] = vsrc[i]; }
}
__device__ __forceinline__ void p1_fill_ln(Frame& F0) { Frame F = F0; rethread(F); LAS float* pl = (LAS float*)(F.lds + RING_OFF); lds_fill(pl, F.in_g(), DM, F.tid); lds_fill(pl + DM, F.in_b(), DM, F.tid); }
__device__ __forceinline__ void p6_fill(Frame& F0) { Frame F = F0; rethread(F); LAS float* pl = (LAS float*)(F.lds + RING_OFF); lds_fill(pl, F.gn_a(), 2048, F.tid); lds_fill(pl + 2048, F.gn_b(), 2048, F.tid); }
__device__ __forceinline__ void p8_fill(Frame& F0) { Frame F = F0; rethread(F); LAS float* pl = (LAS float*)(F.lds + RING_OFF); lds_fill(pl, F.ln1_g(), DM, F.tid); lds_fill(pl + DM, F.ln1_b(), DM, F.tid);
    lds_fill(pl + 2 * DM, F.MOD() + 3 * DM, 2 * DM, F.tid); lds_fill(pl + 4 * DM, F.MOD() + 9 * DM, 2 * DM, F.tid); }
__device__ __forceinline__ void p11_fill(Frame& F0) { Frame F = F0; rethread(F); LAS float* pl = (LAS float*)(F.lds + RING_OFF); lds_fill(pl, F.ln2_g(), DM, F.tid); lds_fill(pl + DM, F.ln2_b(), DM, F.tid); }

__global__ void __launch_bounds__(NWAVES * 64, 2) hybrid_fwd(Args args) {
    extern __shared__ __attribute__((aligned(16))) unsigned char lds[];
    Frame F;
    F.lds = (LAS unsigned char*)lds;
    F.MISC = (volatile LAS unsigned*)(F.lds + MISC_OFF);
    F.wave = __builtin_amdgcn_readfirstlane((int)threadIdx.x >> 6); rethread(F);
#define REFRAME() do { const unsigned char CAS* kp_ = (const unsigned char CAS*)__builtin_amdgcn_kernarg_segment_ptr(); asm volatile("" : "+s"(kp_)); \
        F.ws = *(unsigned char* const CAS*)(kp_ + 160); F.ctl = (gu32*)(F.ws + WS_CTL); \
        unsigned gd_ = gridDim.x; asm volatile("" : "+s"(gd_)); F.G = (int)gd_; \
        { const int bx = blockIdx.x; F.vcu = (F.G % 8 == 0) ? (bx % 8) * (F.G / 8) + bx / 8 : bx; } } while (0)
    REFRAME();
    for (int u = F.tid; u < (LDS_BYTES - LDSCTL_OFF) / 4; u += NWAVES * 64) ((LAS unsigned*)(F.lds + LDSCTL_OFF))[u] = 0u;
    __syncthreads();
    if (N_LAUNCHES == 1) (void)xcd_barrier_post((unsigned*)(F.ctl + CW_BAR), F.MISC + 8, F.tid == 0);
#define GRID_BAR() do { if (N_LAUNCHES == 1) { REFRAME(); XcdBarrier bar_; bar_.bar = (unsigned*)(F.ctl + CW_BAR); bar_.x = xb_xcc_id(); bar_.st = F.MISC + 8; xcd_barrier(bar_, F.wave == 0 && lane_now() == 0); REFRAME(); } } while (0)
#ifndef PH_MASK
#define PH_MASK 0xfff
#endif
#if MK_N_LAUNCHES == 1
#define IN(k) (((PH_MASK) >> (k)) & 1)
#else
    const int lo = args.ph_lo, hi = args.ph_hi;
#define IN(k) ((((PH_MASK) >> (k)) & 1) && lo <= (k) && (k) < hi)
#endif
#define BOTH(k) (IN(k) && IN((k) + 1))
#ifndef PROBE_PH
#define PROBE_PH -1
#endif
#define REP(k) for (int rep_ = 0; rep_ < ((PROBE_PH == (k)) ? 2 : 1); ++rep_)

    if (IN(0)) { REP(0) { p0_prologue(F); __syncthreads(); } if (BOTH(0)) GRID_BAR(); }
    if (IN(1)) { p1a_modsum(F); p1_fill_ln(F); GRID_BAR(); REP(1) p1_rows<(PROBE_PH == 1)>(F); if (BOTH(1)) GRID_BAR(); }
    if (IN(2)) { REP(2) {
        { pg8::Gemm g{(const u16*)F.UQ(), (const u16*)F.WIN_Q(), M, NP_BF, DM / 2, DM / 2}; pg8::StaticOrder S; S.init(M, NP_BF, F.G, (int)blockIdx.x);
          pg8::EpiQBf16<0> E{F.PROJ(), NP_BF, F.SA_U(), F.SW()};
          pg8::gemm_phase<pg8::EpiQBf16<0>, pg8::StaticOrder, 2, false, PG8_ALIGN, PG8_SP2>(F.lds + RING_OFF, g, S, E, F.wave * 64 + lane_now()); }
        { pg8::Gemm g{F.UH(), F.WIN_H(), M, 2048, DM, DM}; pg8::StaticOrder S; S.init(M, 2048, F.G, (int)blockIdx.x);
          pg8::EpiIdx E{F.IQ()};
          pg8::gemm_phase<pg8::EpiIdx, pg8::StaticOrder, 1, false, PG8_ALIGN, PG8_SP2>(F.lds + RING_OFF, g, S, E, F.wave * 64 + lane_now()); }
        { pg8::Gemm g{F.UH(), F.WIN_H() + (size_t)2048 * DM, M, 4 * 256, DM / 4, DM}; pg8::StaticOrder S; S.init(M, 4 * 256, F.G, (int)blockIdx.x);
          pg8::EpiTail E{F.IKWP(), (size_t)M * 128};
          pg8::gemm_phase<pg8::EpiTail, pg8::StaticOrder, 1, true, PG8_ALIGN, PG8_SP2>(F.lds + RING_OFF, g, S, E, F.wave * 64 + lane_now()); } }
        if (BOTH(2)) GRID_BAR();
    }
    if (IN(3)) { p3_kq8(F); p3_ikn(F); REP(3) sb_fast(F); if (BOTH(3)) GRID_BAR(); }
    if (IN(4)) { REP(4) { idx_fast(F); __syncthreads(); } if (BOTH(4)) { sparse_prefill(F); GRID_BAR(); } }
    if (IN(5)) { REP(5) { sparse_fast<!(IN(4) && N_LAUNCHES == 1 && PROBE_PH != 5)>(F); __syncthreads(); } if (BOTH(5)) { if (IN(6)) p6_fill(F); GRID_BAR(); } }
    if (IN(6)) { REP(6) p6_norm<!(IN(5) && N_LAUNCHES == 1 && PROBE_PH != 6)>(F); if (BOTH(6)) GRID_BAR(); }
    if (IN(7)) { REP(7) {
        pg8::Gemm g{(const u16*)F.ONQ(), (const u16*)F.WOUT_Q(), M, DM, DM / 2, DM / 2}; pg8::StaticOrder S; S.init(M, DM, F.G, (int)blockIdx.x);
        pg8::EpiOut E{F.H0B(), F.MOD() + 2 * DM, F.V1B(), F.SA_ON(), F.SW() + NP_BF};
        pg8::gemm_phase<pg8::EpiOut, pg8::StaticOrder, 2, false, PG8_ALIGN, PG8_SP2>(F.lds + RING_OFF, g, S, E, F.wave * 64 + lane_now()); }
        if (BOTH(7)) { if (IN(8)) { pre_fill_sync(); p8_fill(F); } GRID_BAR(); }
    }
    if (IN(8)) { REP(8) p8_rows<!(IN(7) && N_LAUNCHES == 1 && PROBE_PH != 8)>(F); if (BOTH(8)) GRID_BAR(); }
#ifndef PROBE_GK
#define PROBE_GK 0
#endif
    if (IN(9) && PROBE_GK == 2) {
        struct SameOrder { __device__ bool next(int i, pg8::Unit& u) const { u.pm = 0; u.pn = 0; return i < 16; } __device__ void a_ready(const pg8::Unit&) const {} __device__ void done(const pg8::Unit&) const {} };
        pg8::Gemm g{(const u16*)F.U1Q(), (const u16*)F.WUP_Q(), M, DFF, DM / 2, DM / 2}; SameOrder S;
        pg8::EpiQF8 E{F.HID8(), DFF, F.SA_U1(), F.SW() + NP_BF + DM};
        pg8::gemm_phase<pg8::EpiQF8, SameOrder, 2, false, PG8_ALIGN, PG8_SP2>(F.lds + RING_OFF, g, S, E, F.wave * 64 + lane_now());
        __syncthreads();
    }
    if (IN(9) && PROBE_GK == 1) {
        pg8::Gemm g{(const u16*)F.U1Q(), (const u16*)F.WUP_Q(), M, DFF, DM / 4, DM / 2}; pg8::StaticOrder S; S.init(M, DFF, F.G, (int)blockIdx.x);
        pg8::EpiQF8 E{F.HID8(), DFF, F.SA_U1(), F.SW() + NP_BF + DM};
        pg8::gemm_phase<pg8::EpiQF8, pg8::StaticOrder, 2, false, PG8_ALIGN, PG8_SP2>(F.lds + RING_OFF, g, S, E, F.wave * 64 + lane_now());
        __syncthreads();
    }
    if (IN(9)) { REP(9) {
        pg8::Gemm g{(const u16*)F.U1Q(), (const u16*)F.WUP_Q(), M, DFF, DM / 2, DM / 2}; pg8::StaticOrder S; S.init(M, DFF, F.G, (int)blockIdx.x);
        pg8::EpiQF8 E{F.HID8(), DFF, F.SA_U1(), F.SW() + NP_BF + DM};
        pg8::gemm_phase<pg8::EpiQF8, pg8::StaticOrder, 2, false, PG8_ALIGN, PG8_SP2>(F.lds + RING_OFF, g, S, E, F.wave * 64 + lane_now()); }
        if (BOTH(9)) GRID_BAR();
    }
    if (IN(10)) {
        pg8::Gemm g{(const u16*)F.HID8(), (const u16*)F.WDOWN8(), M, DM, DFF / 2, DFF / 2}; pg8::StaticOrder S; S.init(M, DM, F.G, (int)blockIdx.x);
        pg8::EpiDown E{F.MOD() + 5 * DM, F.H0B()  , F.ST1(), F.ln1_g(), F.ln1_b(), F.SW() + NP_BF + DM + DFF, F.V1B()};
        pg8::gemm_phase<pg8::EpiDown, pg8::StaticOrder, 3, false, PG8_ALIGN, PG8_SP2>(F.lds + RING_OFF, g, S, E, F.wave * 64 + lane_now());
        if (BOTH(10)) { if (IN(11)) { pre_fill_sync(); p11_fill(F); } GRID_BAR(); }
    }
    if (IN(11)) { p11_rows<!(IN(10) && N_LAUNCHES == 1)>(F); }
#undef IN
#undef BOTH
}

extern "C" void kernel_launch(void* const* d_in, const int* in_sizes, int n_in, void* d_out, int out_size, void* d_ws, size_t ws_size, hipStream_t stream) {
    static int grid = 0;
    if (grid == 0) {
        if (n_in != 19 || in_sizes[0] != M * DM || out_size != M * DM || ws_size < WS_END) { fprintf(stderr, "kernel_launch: unexpected shapes (n_in %d, in0 %d, out %d, ws %zu, need %zu); nothing launched\n", n_in, n_in > 0 ? in_sizes[0] : -1, out_size, ws_size, (size_t)WS_END); grid = -1; return; }
        int dev = 0, cus = 0, per_cu = 0;
        if (hipGetDevice(&dev) != hipSuccess || hipDeviceGetAttribute(&cus, hipDeviceAttributeMultiprocessorCount, dev) != hipSuccess) { fprintf(stderr, "kernel_launch: device query failed\n"); grid = -1; return; }
        if (hipFuncSetAttribute((const void*)hybrid_fwd, hipFuncAttributeMaxDynamicSharedMemorySize, LDS_BYTES) != hipSuccess) { fprintf(stderr, "kernel_launch: hipFuncSetAttribute failed\n"); grid = -1; return; }
        if (hipOccupancyMaxActiveBlocksPerMultiprocessor(&per_cu, (const void*)hybrid_fwd, NWAVES * 64, LDS_BYTES) != hipSuccess || per_cu < 1)
            fprintf(stderr, "kernel_launch: note: occupancy query reports %d workgroups per CU\n", per_cu);
        (void)hipGetLastError();
        grid = cus & ~7;
    }
    if (grid < 0) return;
    if (hipMemsetAsync((char*)d_ws + WS_CTL, 0, CTL_ZERO_BYTES, stream) != hipSuccess) { fprintf(stderr, "kernel_launch: memset failed\n"); return; }
    Args a{};
    for (int i = 0; i < 19; ++i) a.in[i] = (const float*)d_in[i];
    a.out = (float*)d_out; a.ws = (unsigned char*)d_ws;
    for (int li = 0; li < N_LAUNCHES; ++li) {
        a.ph_lo = (N_LAUNCHES == 1) ? 0 : li; a.ph_hi = (N_LAUNCHES == 1) ? N_PHASES : li + 1; a.li = li; a.pad = 0;
        hipLaunchKernelGGL(hybrid_fwd, dim3(grid), dim3(NWAVES * 64), LDS_BYTES, stream, a);
        const hipError_t le = hipPeekAtLastError();
        if (le != hipSuccess) { fprintf(stderr, "kernel_launch: launch %d failed: %s\n", li, hipGetErrorName(le)); break; }
    }
}
```
